# Optimizing an MI355X kernel written in HIP

```python
import jax
import jax.numpy as jnp
from jax import lax
import numpy as np

D_MODEL = 2048
BATCH = 2
SEQ = 8192
DEPTH = 2

HEAD_DIM = 128
ROPE_THETA = 10000.0
NORM_EPS = 1e-6
Q_BLOCK = 128
GATHER_Q_BLOCK = 64

MLA_HEADS = 8
MLA_Q_RANK = 512
MLA_KV_RANK = 256
MLA_NOPE = 128
MLA_ROPE = 64
MLA_V = 128

DSA_HEADS = 8
IDX_HEADS = 16
IDX_DIM = 64
DSA_TOPK_MAX = 256

MOBA_HEADS = 8
MOBA_BLOCK = 256
MOBA_TOPK = 3
MOBA_Q_BLOCK = 32

DIL_HEADS = 8
DIL_PATTERNS = ((128, 1), (512, 4), (2048, 16))

D_FF = 4 * D_MODEL

EVEN_SPLITS = (MLA_Q_RANK, MLA_KV_RANK, MLA_ROPE, DSA_HEADS * HEAD_DIM, DSA_HEADS * HEAD_DIM, DSA_HEADS * HEAD_DIM, IDX_HEADS * IDX_DIM, IDX_DIM, IDX_HEADS)
EVEN_IN = sum(EVEN_SPLITS)
EVEN_OUT = MLA_HEADS * MLA_V + DSA_HEADS * HEAD_DIM
ODD_SPLITS = (MOBA_HEADS * HEAD_DIM,) * 3 + (DIL_HEADS * HEAD_DIM,) * 3
ODD_IN = sum(ODD_SPLITS)
ODD_OUT = (MOBA_HEADS + DIL_HEADS) * HEAD_DIM
N_EVEN = (DEPTH + 1) // 2
N_ODD = DEPTH // 2

kernel_name = 'hybrid_mla_dsa_moba_dilated'


def rmsnorm(x, g):
    xf = x.astype(jnp.float32)
    y = xf * lax.rsqrt(jnp.mean(xf * xf, axis=-1, keepdims=True) + NORM_EPS)
    return (y * g.astype(jnp.float32)).astype(x.dtype)


def rope_tables(seq, dim):
    inv = ROPE_THETA ** (-jnp.arange(0, dim, 2, dtype=jnp.float32) / dim)
    ang = jnp.arange(seq, dtype=jnp.float32)[:, None] * inv[None, :]
    return (jnp.cos(ang), jnp.sin(ang))


def apply_rope(x, rope):
    cos, sin = rope
    c = cos[None, :, None, :].astype(x.dtype)
    s = sin[None, :, None, :].astype(x.dtype)
    x1, x2 = jnp.split(x, 2, axis=-1)
    return jnp.concatenate([x1 * c - x2 * s, x1 * s + x2 * c], axis=-1)


def masked_softmax(scores, mask):
    return jax.nn.softmax(jnp.where(mask, scores.astype(jnp.float32), -jnp.inf), axis=-1)


def split_cols(x, sizes):
    offs = [int(o) for o in np.cumsum(sizes)[:-1]]
    return jnp.split(x, offs, axis=-1)


def sweep_query_blocks(fn, seq, block):
    n = seq // block
    out = jnp.moveaxis(lax.map(fn, jnp.arange(n)), 0, 1)
    return out.reshape((out.shape[0], n * block) + out.shape[3:])


def mla_attention(c_q, c_kv, k_pe, g_q, g_kv, w_uq, w_ukv, rope64):
    B, S, _ = c_q.shape
    q = (rmsnorm(c_q, g_q) @ w_uq).reshape(B, S, MLA_HEADS, MLA_NOPE + MLA_ROPE)
    kv = (rmsnorm(c_kv, g_kv) @ w_ukv).reshape(B, S, MLA_HEADS, MLA_NOPE + MLA_V)
    q_nope, q_pe = q[..., :MLA_NOPE], apply_rope(q[..., MLA_NOPE:], rope64)
    k_nope, v = kv[..., :MLA_NOPE], kv[..., MLA_NOPE:]
    k_pe = apply_rope(k_pe[:, :, None, :], rope64)[:, :, 0]
    scale = (MLA_NOPE + MLA_ROPE) ** -0.5
    pos = jnp.arange(S)

    def block(i):
        qs = i * Q_BLOCK
        qn = lax.dynamic_slice_in_dim(q_nope, qs, Q_BLOCK, axis=1)
        qp = lax.dynamic_slice_in_dim(q_pe, qs, Q_BLOCK, axis=1)
        s = jnp.einsum('bqhd,bkhd->bhqk', qn, k_nope) + jnp.einsum('bqhr,bkr->bhqk', qp, k_pe)
        qpos = qs + jnp.arange(Q_BLOCK)
        p = masked_softmax(s * scale, pos[None, :] <= qpos[:, None])
        return jnp.einsum('bhqk,bkhd->bqhd', p.astype(v.dtype), v)

    return sweep_query_blocks(block, S, Q_BLOCK)


def dsa_attention(q, k, v, q_idx, k_idx, w_idx, rope128, rope64):
    B, S = q.shape[:2]
    topk = min(DSA_TOPK_MAX, S // 4)
    q = apply_rope(q, rope128)
    k = apply_rope(k, rope128)
    q_idx = apply_rope(q_idx, rope64)
    k_idx = apply_rope(k_idx[:, :, None, :], rope64)[:, :, 0]
    w = w_idx.astype(jnp.float32) * IDX_HEADS ** -0.5
    pos = jnp.arange(S)
    gather = jax.vmap(lambda kb, ib: kb[ib])

    def block(i):
        qs = i * GATHER_Q_BLOCK
        qpos = qs + jnp.arange(GATHER_Q_BLOCK)
        qi = lax.dynamic_slice_in_dim(q_idx, qs, GATHER_Q_BLOCK, axis=1)
        wi = lax.dynamic_slice_in_dim(w, qs, GATHER_Q_BLOCK, axis=1)
        dots = jnp.einsum('bqhd,bsd->bqhs', qi, k_idx).astype(jnp.float32) * IDX_DIM ** -0.5
        score = jnp.einsum('bqh,bqhs->bqs', wi, jax.nn.relu(dots))
        causal = pos[None, :] <= qpos[:, None]
        score = jnp.where(causal[None], score, -jnp.inf)
        _, sel = lax.top_k(score, topk)
        valid = sel <= qpos[None, :, None]
        k_sel = gather(k, sel)
        v_sel = gather(v, sel)
        qb = lax.dynamic_slice_in_dim(q, qs, GATHER_Q_BLOCK, axis=1)
        s = jnp.einsum('bqhd,bqkhd->bhqk', qb, k_sel) * HEAD_DIM ** -0.5
        p = masked_softmax(s, valid[:, None])
        return jnp.einsum('bhqk,bqkhd->bqhd', p.astype(v.dtype), v_sel)

    return sweep_query_blocks(block, S, GATHER_Q_BLOCK)


def moba_attention(q, k, v, rope128):
    B, S, H, Dh = q.shape
    q = apply_rope(q, rope128)
    k = apply_rope(k, rope128)
    n_blk = -(-S // MOBA_BLOCK)
    s_pad = n_blk * MOBA_BLOCK
    pad = ((0, 0), (0, s_pad - S), (0, 0), (0, 0))
    q = jnp.transpose(jnp.pad(q, pad), (0, 2, 1, 3))
    k_blk = jnp.transpose(jnp.pad(k, pad), (0, 2, 1, 3)).reshape(B, H, n_blk, MOBA_BLOCK, Dh)
    v_blk = jnp.transpose(jnp.pad(v, pad), (0, 2, 1, 3)).reshape(B, H, n_blk, MOBA_BLOCK, Dh)
    k_mean = jnp.mean(k_blk, axis=3)
    n_sel = min(MOBA_TOPK, n_blk - 1)
    scale = Dh ** -0.5
    gather = jax.vmap(jax.vmap(lambda kb, ib: kb[ib]))

    def block(i):
        qs = i * MOBA_Q_BLOCK
        qpos = qs + jnp.arange(MOBA_Q_BLOCK)
        own = qs // MOBA_BLOCK
        qb = lax.dynamic_slice_in_dim(q, qs, MOBA_Q_BLOCK, axis=2)
        k_own = lax.dynamic_index_in_dim(k_blk, own, axis=2, keepdims=False)
        v_own = lax.dynamic_index_in_dim(v_blk, own, axis=2, keepdims=False)
        s_own = jnp.einsum('bhqd,bhkd->bhqk', qb, k_own) * scale
        own_mask = (own * MOBA_BLOCK + jnp.arange(MOBA_BLOCK))[None, :] <= qpos[:, None]
        own_mask = jnp.broadcast_to(own_mask, s_own.shape)
        if n_sel == 0:
            p = masked_softmax(s_own, own_mask)
            return jnp.einsum('bhqk,bhkd->bqhd', p.astype(v.dtype), v_own)
        gate = jnp.einsum('bhqd,bhnd->bhqn', qb, k_mean).astype(jnp.float32)
        gate = jnp.where(jnp.arange(n_blk) < own, gate, -jnp.inf)
        _, sel = lax.top_k(gate, n_sel)
        valid = jnp.repeat(sel < own, MOBA_BLOCK, axis=-1)
        k_sel = gather(k_blk, sel).reshape(B, H, MOBA_Q_BLOCK, n_sel * MOBA_BLOCK, Dh)
        v_sel = gather(v_blk, sel).reshape(B, H, MOBA_Q_BLOCK, n_sel * MOBA_BLOCK, Dh)
        s_sel = jnp.einsum('bhqd,bhqkd->bhqk', qb, k_sel) * scale
        p = masked_softmax(jnp.concatenate([s_sel, s_own], -1), jnp.concatenate([valid, own_mask], -1))
        p = p.astype(v.dtype)
        n_s = n_sel * MOBA_BLOCK
        return (jnp.einsum('bhqk,bhqkd->bqhd', p[..., :n_s], v_sel)
                + jnp.einsum('bhqk,bhkd->bqhd', p[..., n_s:], v_own))

    return sweep_query_blocks(block, s_pad, MOBA_Q_BLOCK)[:, :S]


def dilated_attention(q, k, v, rope128):
    B, S, H, Dh = q.shape
    q = apply_rope(q, rope128)
    k = apply_rope(k, rope128)
    scale = Dh ** -0.5

    def block(i):
        qs = i * GATHER_Q_BLOCK
        qpos = qs + jnp.arange(GATHER_Q_BLOCK)
        qb = lax.dynamic_slice_in_dim(q, qs, GATHER_Q_BLOCK, axis=1)
        outs, lses = [], []
        for window, dil in DIL_PATTERNS:
            idx = qpos[:, None] - dil * jnp.arange(window // dil + 1)[None, :]
            valid = idx >= 0
            idx = jnp.maximum(idx, 0)
            k_sel = k[:, idx]
            v_sel = v[:, idx]
            s = jnp.einsum('bqhd,bqnhd->bhqn', qb, k_sel).astype(jnp.float32) * scale
            s = jnp.where(valid[None, None], s, -jnp.inf)
            lse = jax.nn.logsumexp(s, axis=-1)
            p = jnp.exp(s - lse[..., None]).astype(v.dtype)
            outs.append(jnp.einsum('bhqn,bqnhd->bqhd', p, v_sel))
            lses.append(lse)
        wts = jax.nn.softmax(jnp.stack(lses, 0), axis=0)
        out = jnp.einsum('gbhq,gbqhd->bqhd', wts, jnp.stack(outs, 0).astype(jnp.float32))
        return out.astype(q.dtype)

    return sweep_query_blocks(block, S, GATHER_Q_BLOCK)


def even_mixer(h, w_in, g_q, g_kv, w_uq, w_ukv, w_out, rope128, rope64):
    B, S, _ = h.shape
    c_q, c_kv, k_pe, q, k, v, q_idx, k_idx, w_idx = split_cols(h @ w_in, EVEN_SPLITS)
    a = mla_attention(c_q, c_kv, k_pe, g_q, g_kv, w_uq, w_ukv, rope64)
    shp = (B, S, DSA_HEADS, HEAD_DIM)
    b = dsa_attention(q.reshape(shp), k.reshape(shp), v.reshape(shp),
                      q_idx.reshape(B, S, IDX_HEADS, IDX_DIM), k_idx, w_idx, rope128, rope64)
    o = jnp.concatenate([a.reshape(B, S, -1), b.reshape(B, S, -1)], axis=-1)
    return o @ w_out


def odd_mixer(h, w_in, w_out, rope128):
    B, S, _ = h.shape
    qc, kc, vc, qd, kd, vd = split_cols(h @ w_in, ODD_SPLITS)
    sc = (B, S, MOBA_HEADS, HEAD_DIM)
    sd = (B, S, DIL_HEADS, HEAD_DIM)
    c = moba_attention(qc.reshape(sc), kc.reshape(sc), vc.reshape(sc), rope128)
    d = dilated_attention(qd.reshape(sd), kd.reshape(sd), vd.reshape(sd), rope128)
    o = jnp.concatenate([c.reshape(B, S, -1), d.reshape(B, S, -1)], axis=-1)
    return o @ w_out


def squared_relu_mlp(h, w1, w2):
    return jnp.square(jax.nn.relu(h @ w1)) @ w2


def setup_inputs(seed: int = 0) -> dict:
    key = jax.random.key(seed)
    ks = jax.random.split(key, 14)

    def nrm(k, shape, fan_in):
        return jax.random.normal(k, shape, jnp.float32) * fan_in ** -0.5

    def gain(k, shape):
        return 1.0 + 0.02 * jax.random.normal(k, shape, jnp.float32)

    return {
        'x': jax.random.normal(ks[0], (BATCH, SEQ, D_MODEL), jnp.float32),
        'ln_mix': gain(ks[1], (DEPTH, D_MODEL)),
        'ln_mlp': gain(ks[2], (DEPTH, D_MODEL)),
        'ln_final': gain(ks[3], (D_MODEL,)),
        'e_w_in': nrm(ks[4], (N_EVEN, D_MODEL, EVEN_IN), D_MODEL),
        'e_g_q': gain(ks[5], (N_EVEN, MLA_Q_RANK)),
        'e_g_kv': gain(ks[6], (N_EVEN, MLA_KV_RANK)),
        'e_w_uq': nrm(ks[7], (N_EVEN, MLA_Q_RANK, MLA_HEADS * (MLA_NOPE + MLA_ROPE)), MLA_Q_RANK),
        'e_w_ukv': nrm(ks[8], (N_EVEN, MLA_KV_RANK, MLA_HEADS * (MLA_NOPE + MLA_V)), MLA_KV_RANK),
        'e_w_out': nrm(ks[9], (N_EVEN, EVEN_OUT, D_MODEL), EVEN_OUT),
        'o_w_in': nrm(ks[10], (N_ODD, D_MODEL, ODD_IN), D_MODEL),
        'o_w_out': nrm(ks[11], (N_ODD, ODD_OUT, D_MODEL), ODD_OUT),
        'mlp_w1': nrm(ks[12], (DEPTH, D_MODEL, D_FF), D_MODEL),
        'mlp_w2': nrm(ks[13], (DEPTH, D_FF, D_MODEL), D_FF),
    }


def reference(x, ln_mix, ln_mlp, ln_final, e_w_in, e_g_q, e_g_kv, e_w_uq, e_w_ukv, e_w_out,
              o_w_in, o_w_out, mlp_w1, mlp_w2):
    S = x.shape[1]
    rope128 = rope_tables(S, HEAD_DIM)
    rope64 = rope_tables(S, MLA_ROPE)
    for layer in range(DEPTH):
        j = layer // 2
        h = rmsnorm(x, ln_mix[layer])
        if layer % 2 == 0:
            x = x + even_mixer(h, e_w_in[j], e_g_q[j], e_g_kv[j], e_w_uq[j], e_w_ukv[j], e_w_out[j], rope128, rope64)
        else:
            x = x + odd_mixer(h, o_w_in[j], o_w_out[j], rope128)
        h = rmsnorm(x, ln_mlp[layer])
        x = x + squared_relu_mlp(h, mlp_w1[layer], mlp_w2[layer])
    return rmsnorm(x, ln_final)
```

```cpp
#include <hip/hip_runtime.h>
#include <cstdio>
#include <cstdint>

#define GAS __attribute__((address_space(1)))
#define LAS __attribute__((address_space(3)))
typedef unsigned short bf16;
typedef short bf16x8 __attribute__((ext_vector_type(8)));
typedef short s16x4 __attribute__((ext_vector_type(4)));
typedef float f32x4 __attribute__((ext_vector_type(4)));
typedef float f32x2 __attribute__((ext_vector_type(2)));
typedef float f32x16 __attribute__((ext_vector_type(16)));
typedef unsigned u32x4 __attribute__((ext_vector_type(4)));
typedef unsigned u32x2 __attribute__((ext_vector_type(2)));

constexpr int DM = 2048, BATCH = 2, SEQ = 8192, T = BATCH * SEQ, DFF = 8192;
constexpr int EVEN_IN = 5008, EVEN_INP = 5120, ODD_IN = 6144;
constexpr float NORM_EPS = 1e-6f;
constexpr int EC_CQ = 0, EC_CKV = 512, EC_KPE = 768, EC_Q = 832, EC_K = 1856, EC_V = 2880, EC_QI = 3904, EC_KI = 4928, EC_WI = 4992;
constexpr int OC_QC = 0, OC_KC = 1024, OC_VC = 2048, OC_QD = 3072, OC_KD = 4096, OC_VD = 5120;

constexpr size_t MiB = 1u << 20;
constexpr size_t WS_CTL = 0, CTL_ZERO_BYTES = 1 * MiB;
constexpr size_t WS_COS128 = 1 * MiB, WS_SIN128 = 3 * MiB, WS_COS64 = 5 * MiB, WS_SIN64 = 6 * MiB;
constexpr size_t WS_KM = 7 * MiB;
constexpr size_t WS_WIN_E = 8 * MiB, WS_WUQ = 28 * MiB, WS_WUKV = 30 * MiB, WS_WOUT_E = 31 * MiB, WS_WIN_O = 39 * MiB, WS_WOUT_O = 63 * MiB;
constexpr size_t WS_BM = 71 * MiB;
constexpr size_t WS_PROJ = 87 * MiB;
constexpr size_t WS_H0 = 247 * MiB;
constexpr size_t WS_SC = 247 * MiB;
constexpr size_t WS_Q = 311 * MiB, WS_KV = 359 * MiB;
constexpr size_t WS_H2 = 87 * MiB, WS_HID = 151 * MiB, WS_W1B = 407 * MiB, WS_W2B = 439 * MiB;
constexpr size_t WS_XB = 87 * MiB;
constexpr size_t WS_PROJ2 = 151 * MiB;
constexpr size_t WS_H1 = 343 * MiB;
constexpr size_t WS_SSQ = 509 * MiB;
constexpr size_t WS_OG = 87 * MiB;
constexpr size_t WS_MPO = 407 * MiB;
constexpr size_t WS_LSE = 503 * MiB;
constexpr size_t WS_MLSE = 505 * MiB;
constexpr size_t WS_SEL = 507 * MiB;
constexpr size_t WS_CNT = 508 * MiB;
constexpr size_t WS_END = 512 * MiB;
constexpr int CW_TMO = 0, CW_BAR = 4096;

constexpr int RING_BYTES = 131072;
constexpr int MISC_OFF = 147200;
constexpr int LDS_BYTES = 147456;
constexpr int NWAVES = 8;

__device__ __forceinline__ unsigned cvt_pk_bf16(float lo, float hi) { unsigned r; asm volatile("v_cvt_pk_bf16_f32 %0, %1, %2" : "=v"(r) : "v"(lo), "v"(hi)); return r; }
__device__ __forceinline__ float bf2f(unsigned short b) { return __builtin_bit_cast(float, ((unsigned)b) << 16); }
__device__ __forceinline__ float wave_sum(float v) {
#pragma unroll
    for (int o = 1; o < 64; o <<= 1) v += __shfl_xor(v, o);
    return v;
}
#define LDS_WAIT() asm volatile("s_waitcnt lgkmcnt(0)" ::: "memory")
#define VM_WAIT() asm volatile("s_waitcnt vmcnt(0)" ::: "memory")

namespace pg8 {
constexpr int BM = 256, BK = 64, HALF = 128, HTB = HALF * BK * 2, STAGE_BYTES = 8 * HTB, NXCD = 8, WGM = 8;
__host__ __device__ __forceinline__ int lds_byte(int r, int c) { const int st = (r >> 4) * 2 + (c >> 5), rr = r & 15, cc = c & 31, ob = rr * 64 + cc * 2; return st * 1024 + (ob ^ (((ob >> 9) & 1) << 5)); }
__host__ __device__ __forceinline__ void stage_rc(int b, int& R, int& C) { const int st = b / 1024, sb = b % 1024, swz = sb ^ (((sb >> 9) & 1) << 5); R = (st >> 1) * 16 + swz / 64; C = (st & 1) * 32 + (swz % 64) / 2; }
__host__ __device__ __forceinline__ int perm32(int rho) { const int n = rho >> 4, i = rho & 15; return 8 * (i >> 2) + 4 * n + (i & 3); }

struct Unit { int pm, pn; };
struct Gemm { const bf16* A; const bf16* Bt; int M, N, K, lda, ldb; };

struct StaticOrder {
    int nM, nN, nwg, G, c;
    __host__ __device__ void init(int M, int N, int G_, int c_) { nM = M / BM; nN = N / BM; nwg = nM * nN; G = G_; c = c_; }
    __host__ __device__ bool next(int i, Unit& u) const {
        const long L = (long)i * G + c; if (L >= nwg) return false;
        int wgid = (int)L; { const int q = nwg / NXCD, r = nwg % NXCD, xcd = wgid % NXCD, off = wgid / NXCD; wgid = (xcd < r ? xcd * (q + 1) : r * (q + 1) + (xcd - r) * q) + off; }
        const int nig = WGM * nN, gid = wgid / nig, fm = gid * WGM, gsz = (nM - fm) < WGM ? (nM - fm) : WGM;
        u.pm = fm + ((wgid % nig) % gsz); u.pn = (wgid % nig) / gsz; return true;
    }
};

template <int ACT  , bool SCALED = false> struct EpiBf16 {
    static constexpr bool PERM = true;
    bf16* O; int ldc; const float* ssq;
    __device__ __forceinline__ void operator()(const f32x4 (&acc)[2][2][4][2], const Unit& u, int wr, int wc, int fr, int fq) const {
        const int row0 = u.pm * BM + wr * 64 + fr; const int col0 = u.pn * BM + wc * 32 + 8 * fq;
        float rs[2][4];
        if constexpr (SCALED) {
#pragma unroll
            for (int ai = 0; ai < 2; ++ai)
#pragma unroll
                for (int m = 0; m < 4; ++m) { const float* sp = ssq + (size_t)(row0 + ai * HALF + m * 16) * 32 + fq * 8;
                    const f32x4 a = *(const f32x4*)sp, b = *(const f32x4*)(sp + 4);
                    float s = ((a[0] + a[1]) + (a[2] + a[3])) + ((b[0] + b[1]) + (b[2] + b[3]));
                    s += __shfl_xor(s, 16); s += __shfl_xor(s, 32);
                    rs[ai][m] = __builtin_amdgcn_rsqf(s * (1.f / DM) + NORM_EPS); }
        }
#pragma unroll
        for (int ai = 0; ai < 2; ++ai)
#pragma unroll
            for (int m = 0; m < 4; ++m) { bf16* rowp = O + (size_t)(row0 + ai * HALF + m * 16) * ldc + col0;
#pragma unroll
                for (int bj = 0; bj < 2; ++bj) { f32x4 v0 = acc[ai][bj][m][0], v1 = acc[ai][bj][m][1];
                    if constexpr (SCALED) { v0 = v0 * rs[ai][m]; v1 = v1 * rs[ai][m]; }
                    if (ACT == 1) {
#pragma unroll
                        for (int j = 0; j < 4; ++j) { const float a = fmaxf(v0[j], 0.f), b = fmaxf(v1[j], 0.f); v0[j] = a * a; v1[j] = b * b; } }
                    u32x4 w; w.x = cvt_pk_bf16(v0[0], v0[1]); w.y = cvt_pk_bf16(v0[2], v0[3]); w.z = cvt_pk_bf16(v1[0], v1[1]); w.w = cvt_pk_bf16(v1[2], v1[3]);
                    *(u32x4*)(rowp + bj * HALF) = w; } }
    }
};
struct EpiResF32 {
    static constexpr bool PERM = false;
    const float* base; float* out; int ldc;
    __device__ __forceinline__ void operator()(const f32x4 (&acc)[2][2][4][2], const Unit& u, int wr, int wc, int fr, int fq) const {
        const int row0 = u.pm * BM + wr * 64 + fr, col0 = u.pn * BM + wc * 32 + 4 * fq;
#pragma unroll
        for (int ai = 0; ai < 2; ++ai)
#pragma unroll
            for (int m = 0; m < 4; ++m) { const size_t off = (size_t)(row0 + ai * HALF + m * 16) * ldc + col0;
                f32x4 bs[2][2];
#pragma unroll
                for (int bj = 0; bj < 2; ++bj)
#pragma unroll
                    for (int n = 0; n < 2; ++n) bs[bj][n] = *(const f32x4*)(base + off + bj * HALF + n * 16);
#pragma unroll
                for (int bj = 0; bj < 2; ++bj)
#pragma unroll
                    for (int n = 0; n < 2; ++n) *(f32x4*)(out + off + bj * HALF + n * 16) = acc[ai][bj][m][n] + bs[bj][n];
                asm volatile("" ::: "memory"); }
    }
};

template <bool XB> struct EpiResF32X {
    static constexpr bool PERM = true;
    const float* base; float* out; bf16* xb; float* ssq; int ldc;
    __device__ __forceinline__ void operator()(const f32x4 (&acc)[2][2][4][2], const Unit& u, int wr, int wc, int fr, int fq) const {
        const int row0 = u.pm * BM + wr * 64 + fr, col0 = u.pn * BM + wc * 32 + 8 * fq;
        f32x4 vn[2][2];
#define ERX_LOAD(g_) do { const size_t off_ = (size_t)(row0 + ((g_) >> 2) * HALF + ((g_) & 3) * 16) * ldc + col0; \
            _Pragma("unroll") for (int bj = 0; bj < 2; ++bj) _Pragma("unroll") for (int n = 0; n < 2; ++n) vn[bj][n] = *(const f32x4*)(base + off_ + bj * HALF + n * 4); } while (0)
        ERX_LOAD(0);
#pragma unroll
        for (int g = 0; g < 8; ++g) { const int ai = g >> 2, m = g & 3; const int row = row0 + ai * HALF + m * 16; const size_t off = (size_t)row * ldc + col0;
            f32x4 v[2][2];
#pragma unroll
            for (int bj = 0; bj < 2; ++bj)
#pragma unroll
                for (int n = 0; n < 2; ++n) v[bj][n] = vn[bj][n];
            if (g < 7) ERX_LOAD(g + 1);
            asm volatile("" ::: "memory");
            float ss = 0.f;
#pragma unroll
            for (int bj = 0; bj < 2; ++bj) { const f32x4 o0 = acc[ai][bj][m][0] + v[bj][0], o1 = acc[ai][bj][m][1] + v[bj][1];
                *(f32x4*)(out + off + bj * HALF) = o0; *(f32x4*)(out + off + bj * HALF + 4) = o1;
                if constexpr (XB) { u32x4 w; w.x = cvt_pk_bf16(o0[0], o0[1]); w.y = cvt_pk_bf16(o0[2], o0[3]); w.z = cvt_pk_bf16(o1[0], o1[1]); w.w = cvt_pk_bf16(o1[2], o1[3]);
                    *(u32x4*)(xb + off + bj * HALF) = w;
                    ss += ((o0[0] * o0[0] + o0[1] * o0[1]) + (o0[2] * o0[2] + o0[3] * o0[3])) + ((o1[0] * o1[0] + o1[1] * o1[1]) + (o1[2] * o1[2] + o1[3] * o1[3])); } }
            if constexpr (XB) { ss += __shfl_xor(ss, 16); ss += __shfl_xor(ss, 32);
                if (fq == 0) ssq[(size_t)row * 32 + u.pn * 4 + wc] = ss; }
        }
#undef ERX_LOAD
    }
};

template <class Epi>
__device__ __forceinline__ void gemm_phase(LAS unsigned char* lds, const Gemm g, const StaticOrder& S, const Epi& E) {
    const int tid = threadIdx.x, wid = __builtin_amdgcn_readfirstlane(tid >> 6), lane = tid & 63, wr = wid >> 2, wc = wid & 3, fr = lane & 15, fq = lane >> 4;
    const int K = g.K, nt = K / BK;
    unsigned voffA[2], voffB[2];
#pragma unroll
    for (int i = 0; i < 2; ++i) { int R, C; stage_rc(tid * 16 + i * 8192, R, C); const int Rb = Epi::PERM ? ((R & ~31) + perm32(R & 31)) : R;
        voffA[i] = (unsigned)(R * g.lda + C) * 2u; voffB[i] = (unsigned)(Rb * g.ldb + C) * 2u; }
    const size_t kstep = (size_t)(BK * 2);
    const size_t hA = (size_t)HALF * g.lda * 2, hB = (size_t)HALF * g.ldb * 2;
    const size_t tA = 2 * hA, tB = 2 * hB;
    const unsigned ldsw = (unsigned)wid * 1024u;
    const int aoff = lds_byte(wr * 64 + fr, fq * 8), boff = lds_byte(wc * 32 + fr, fq * 8);
#define PG8_SA(b, h) (((b) * 2 + (h)) * HTB)
#define PG8_SB(b, h) ((4 + (b) * 2 + (h)) * HTB)
#define PG8_STAGE(bufoff, gbase, voff) do { _Pragma("unroll") for (int _i = 0; _i < 2; ++_i) \
        __builtin_amdgcn_global_load_lds((const unsigned*)((const char*)(gbase) + (voff)[_i]), (LAS unsigned*)(lds + (bufoff) + ldsw + _i * 8192), 16, 0, 0); } while (0)
#define PG8_LDA(dst, b, h) do { _Pragma("unroll") for (int m = 0; m < 4; ++m) _Pragma("unroll") for (int k = 0; k < 2; ++k) dst[m][k] = *(const LAS bf16x8*)(lds + PG8_SA(b, h) + aoff + m * 2048 + k * 1024); } while (0)
#define PG8_LDB(dst, b, h) do { _Pragma("unroll") for (int n = 0; n < 2; ++n) _Pragma("unroll") for (int k = 0; k < 2; ++k) dst[n][k] = *(const LAS bf16x8*)(lds + PG8_SB(b, h) + boff + n * 2048 + k * 1024); } while (0)
#define PG8_MMA(ai, bj, At, Bt) do { __builtin_amdgcn_s_setprio(1); _Pragma("unroll") for (int m = 0; m < 4; ++m) _Pragma("unroll") for (int n = 0; n < 2; ++n) _Pragma("unroll") for (int k = 0; k < 2; ++k) \
        acc[ai][bj][m][n] = __builtin_amdgcn_mfma_f32_16x16x32_bf16(Bt[n][k], At[m][k], acc[ai][bj][m][n], 0, 0, 0); __builtin_amdgcn_s_setprio(0); } while (0)
#define PG8_WAIT_V(n) asm volatile("s_waitcnt vmcnt(" #n ")" ::: "memory")
#define PG8_WAIT_L(n) asm volatile("s_waitcnt lgkmcnt(" #n ")" ::: "memory")
#define PG8_BAR __builtin_amdgcn_s_barrier()
#define PG8_SCHED __builtin_amdgcn_sched_barrier(0)
    Unit cur, nxt; int ui = 0;
    if (!S.next(0, cur)) return;
    f32x4 acc[2][2][4][2];
#pragma unroll
    for (int a = 0; a < 2; ++a)
#pragma unroll
        for (int b = 0; b < 2; ++b)
#pragma unroll
            for (int m = 0; m < 4; ++m)
#pragma unroll
                for (int n = 0; n < 2; ++n) acc[a][b][m][n] = (f32x4){0.f, 0.f, 0.f, 0.f};
    bf16x8 At[4][2], B0[2][2], B1[2][2];
    const char* cA = (const char*)g.A + (size_t)cur.pm * tA; const char* cB = (const char*)g.Bt + (size_t)cur.pn * tB;
    PG8_STAGE(PG8_SB(0, 0), cB, voffB); PG8_STAGE(PG8_SB(0, 1), cB + hB, voffB); PG8_STAGE(PG8_SA(0, 0), cA, voffA); PG8_STAGE(PG8_SA(0, 1), cA + hA, voffA);
    if (wr == 1) PG8_BAR;
    PG8_WAIT_V(2); PG8_BAR;
    PG8_STAGE(PG8_SB(1, 0), cB + kstep, voffB); PG8_STAGE(PG8_SA(1, 0), cA + kstep, voffA); PG8_STAGE(PG8_SB(1, 1), cB + hB + kstep, voffB);
    PG8_WAIT_V(6); PG8_BAR;
    for (;;) {
        const bool has_next = S.next(ui + 1, nxt);
        const char* nA = has_next ? (const char*)g.A + (size_t)nxt.pm * tA : cA; const char* nB = has_next ? (const char*)g.Bt + (size_t)nxt.pn * tB : cB;
        for (int t = 0; t < nt; t += 2) {
            const bool last = (t == nt - 2);
            const char* a1 = cA + (size_t)(t + 1) * kstep;
            const char* a2 = last ? nA : cA + (size_t)(t + 2) * kstep; const char* b2 = last ? nB : cB + (size_t)(t + 2) * kstep;
            const char* a3 = a2 + kstep; const char* b3 = b2 + kstep;
            PG8_LDB(B0, 0, 0); PG8_LDB(B1, 0, 1); PG8_SCHED; PG8_LDA(At, 0, 0); PG8_STAGE(PG8_SA(1, 1), a1 + hA, voffA);
            PG8_WAIT_V(8); PG8_WAIT_L(0); PG8_BAR; PG8_MMA(0, 0, At, B0); PG8_MMA(0, 1, At, B1); PG8_BAR; PG8_SCHED;
            PG8_LDA(At, 0, 1); PG8_STAGE(PG8_SB(0, 0), b2, voffB); PG8_STAGE(PG8_SB(0, 1), b2 + hB, voffB); PG8_STAGE(PG8_SA(0, 0), a2, voffA);
            PG8_WAIT_V(8); PG8_WAIT_L(0); PG8_BAR; PG8_MMA(1, 0, At, B0); PG8_MMA(1, 1, At, B1); PG8_BAR; PG8_SCHED;
            PG8_LDB(B0, 1, 0); PG8_LDB(B1, 1, 1); PG8_SCHED; PG8_LDA(At, 1, 0); PG8_STAGE(PG8_SA(0, 1), a2 + hA, voffA);
            PG8_WAIT_V(8); PG8_WAIT_L(0); PG8_BAR; PG8_MMA(0, 0, At, B0); PG8_MMA(0, 1, At, B1); PG8_BAR; PG8_SCHED;
            PG8_LDA(At, 1, 1); PG8_STAGE(PG8_SB(1, 0), b3, voffB); PG8_STAGE(PG8_SB(1, 1), b3 + hB, voffB); PG8_STAGE(PG8_SA(1, 0), a3, voffA);
            PG8_WAIT_V(8); PG8_WAIT_L(0); PG8_BAR; PG8_MMA(1, 0, At, B0); PG8_MMA(1, 1, At, B1); PG8_BAR; PG8_SCHED;
        }
        if (wr == 0) PG8_BAR;
        E(acc, cur, wr, wc, fr, fq);
        if (!has_next) break;
#pragma unroll
        for (int a = 0; a < 2; ++a)
#pragma unroll
            for (int b = 0; b < 2; ++b)
#pragma unroll
                for (int m = 0; m < 4; ++m)
#pragma unroll
                    for (int n = 0; n < 2; ++n) acc[a][b][m][n] = (f32x4){0.f, 0.f, 0.f, 0.f};
        cur = nxt; cA = nA; cB = nB; ++ui;
        if (wr == 1) PG8_BAR;
    }
    PG8_WAIT_V(0);
    PG8_BAR;
#undef PG8_SA
#undef PG8_SB
#undef PG8_STAGE
#undef PG8_LDA
#undef PG8_LDB
#undef PG8_MMA
#undef PG8_WAIT_V
#undef PG8_WAIT_L
#undef PG8_BAR
#undef PG8_SCHED
}
}

#define XB_TMO      128
#define XB_XCNT(j)  (256  + 64 * (j))
#define XB_XSUB(j)  (1280 + 64 * (j))
#define XB_XGEN(j)  (2304 + 64 * (j))
#define XB_TOP      3328
#define XB_TOPGEN   3392
#define XCD_BAR_WORDS 3456
#define XB_SPIN_CAP (1u << 18)

__device__ __forceinline__ unsigned xb_ld(unsigned* p)              { return __hip_atomic_load(p, __ATOMIC_RELAXED, __HIP_MEMORY_SCOPE_AGENT); }
__device__ __forceinline__ unsigned xb_add(unsigned* p, unsigned v) { return __hip_atomic_fetch_add(p, v, __ATOMIC_RELAXED, __HIP_MEMORY_SCOPE_AGENT); }
__device__ __forceinline__ unsigned xb_xcc_id() { return (unsigned)__builtin_amdgcn_s_getreg((3 << 11) | 20) & 0xFu; }
#define XB_SPIN(cond, bar) do { unsigned _sp = 0; while (cond) { __builtin_amdgcn_s_sleep(1); \
    if ((++_sp & 255u) == 0u) { if (xb_ld(&(bar)[XB_TMO])) break; if (_sp > XB_SPIN_CAP) { atomicAdd(&(bar)[XB_TMO], 1u); break; } } } } while (0)

struct XcdBarrier { unsigned* bar; unsigned x; volatile LAS unsigned* st; };

__device__ __forceinline__ XcdBarrier xcd_barrier_post(unsigned* bar, volatile LAS unsigned* st) {
    XcdBarrier b; b.bar = bar; b.x = xb_xcc_id(); b.st = st;
    if (threadIdx.x == 0) (void)xb_add(&bar[XB_XCNT(b.x)], 1u);
    return b;
}
__device__ __forceinline__ void xcd_barrier_complete(unsigned* bar, unsigned x, unsigned& nloc, unsigned& nx) {
    const unsigned G = gridDim.x * gridDim.y * gridDim.z;
    unsigned sum, cnt, mine, sp = 0u;
    for (;;) {
        sum = 0u; cnt = 0u; mine = 0u;
#pragma unroll
        for (unsigned j = 0; j < 16; ++j) { const unsigned c = xb_ld(&bar[XB_XCNT(j)]); sum += c; cnt += (c > 0u) ? 1u : 0u; mine = (j == x) ? c : mine; }
        if (sum == G) break;
        __builtin_amdgcn_s_sleep(1);
        if ((++sp & 255u) == 0u) { if (xb_ld(&bar[XB_TMO])) break; if (sp > XB_SPIN_CAP) { atomicAdd(&bar[XB_TMO], 1u); break; } }
    }
    nloc = mine > 0u ? mine : 1u; nx = cnt > 0u ? cnt : 1u;
}
__device__ __forceinline__ void xcd_barrier(const XcdBarrier& b) {
    asm volatile("s_waitcnt vmcnt(0)" ::: "memory");
    __syncthreads();
    if (threadIdx.x == 0) {
        unsigned* bar = b.bar;
        __builtin_amdgcn_s_waitcnt(0);
        unsigned nloc = b.st[0], nx = b.st[1];
        if (nloc == 0u) { xcd_barrier_complete(bar, b.x, nloc, nx); b.st[0] = nloc; b.st[1] = nx; }
        const unsigned old = xb_add(&bar[XB_XSUB(b.x)], 1u);
        const unsigned gen = old / nloc;
        if (old + 1u == (gen + 1u) * nloc) {
            __builtin_amdgcn_fence(__ATOMIC_RELEASE, "agent");
            asm volatile("s_waitcnt vmcnt(0)" ::: "memory");
            const unsigned og = xb_add(&bar[XB_TOP], 1u);
            const unsigned tg = og / nx;
            if (og + 1u == (tg + 1u) * nx) xb_add(&bar[XB_TOPGEN], 1u);
            else XB_SPIN(xb_ld(&bar[XB_TOPGEN]) == tg, bar);
            __builtin_amdgcn_fence(__ATOMIC_ACQUIRE, "agent");
            xb_add(&bar[XB_XGEN(b.x)], 1u);
            asm volatile("s_waitcnt vmcnt(0)" ::: "memory");
        } else {
            XB_SPIN(xb_ld(&bar[XB_XGEN(b.x)]) == gen, bar);
            __builtin_amdgcn_fence(__ATOMIC_ACQUIRE, "agent");
            asm volatile("s_waitcnt vmcnt(0)" ::: "memory");
        }
    }
    __syncthreads();
}

struct Args { const float* in[14]; float* out; unsigned char* ws; int ph_lo, ph_hi; };
struct Frame {
    LAS unsigned char* lds;
    int tid, lane, wave, vcu, G;
    unsigned char* ws;
};

__device__ __forceinline__ void transpose_item(const float* W, int K, int N, bf16* WT, LAS float* scr, int item, int lane, const float* gain) {
    const int nblk = (N + 31) / 32, kb = item / nblk, nb = item % nblk, k0 = 64 * kb, n0 = 32 * nb;
    const int nn = n0 + (lane & 31);
#pragma unroll 8
    for (int i = 0; i < 32; ++i) { const int kk = 2 * i + (lane >> 5); const float v = W[(size_t)(k0 + kk) * N + (nn < N ? nn : N - 1)] * (gain ? gain[k0 + kk] : 1.f); scr[kk * 33 + (lane & 31)] = (nn < N) ? v : 0.f; }
    LDS_WAIT(); asm volatile("" ::: "memory");
    const int c = lane & 7;
#pragma unroll
    for (int j = 0; j < 4; ++j) { const int n = (lane >> 3) + 8 * j; const LAS float* s = scr + (8 * c) * 33 + n;
        u32x4 o; o.x = cvt_pk_bf16(s[0 * 33], s[1 * 33]); o.y = cvt_pk_bf16(s[2 * 33], s[3 * 33]); o.z = cvt_pk_bf16(s[4 * 33], s[5 * 33]); o.w = cvt_pk_bf16(s[6 * 33], s[7 * 33]);
        *(u32x4*)(WT + (size_t)(n0 + n) * K + k0 + 8 * c) = o; }
    LDS_WAIT(); asm volatile("" ::: "memory");
}
__device__ __forceinline__ void convert_weight(Frame& F, const float* W, int K, int N, bf16* WT, const float* gain = nullptr) {
    LAS float* scr = (LAS float*)(F.lds + F.wave * 16384);
    const int gw = F.vcu * NWAVES + F.wave, NGW = F.G * NWAVES;
    const int nitems = (K / 64) * ((N + 31) / 32);
    for (int it = gw; it < nitems; it += NGW) transpose_item(W, K, N, WT, scr, it, F.lane, gain);
}
__device__ __forceinline__ void rms_row_to_bf16(const float* xrow, const float* g, bf16* orow, int lane) {
    const f32x4* xr = (const f32x4*)xrow + lane; const f32x4* gr = (const f32x4*)g + lane;
    f32x4 v[8]; float s = 0.f;
#pragma unroll
    for (int j = 0; j < 8; ++j) { v[j] = xr[64 * j]; s += (v[j].x * v[j].x + v[j].y * v[j].y) + (v[j].z * v[j].z + v[j].w * v[j].w); }
    const float rs = 1.0f / sqrtf(wave_sum(s) * (1.f / DM) + NORM_EPS);
    u32x2* o8 = (u32x2*)orow + lane;
#pragma unroll
    for (int j = 0; j < 8; ++j) { const f32x4 gg = gr[64 * j]; u32x2 w; w.x = cvt_pk_bf16(v[j].x * rs * gg.x, v[j].y * rs * gg.y); w.y = cvt_pk_bf16(v[j].z * rs * gg.z, v[j].w * rs * gg.w); o8[64 * j] = w; }
}
__device__ __forceinline__ void rms_rows(Frame& F, const float* X, const float* g, bf16* H) {
    const int gw = F.vcu * NWAVES + F.wave, NGW = F.G * NWAVES;
    for (int m = gw; m < T; m += NGW) rms_row_to_bf16(X + (size_t)m * DM, g, H + (size_t)m * DM, F.lane);
}
__device__ __forceinline__ void rms_rows_final(Frame& F, float* X, const float* g) {
    const int gw = F.vcu * NWAVES + F.wave, NGW = F.G * NWAVES;
    for (int m = gw; m < T; m += NGW) {
        f32x4* xr = (f32x4*)(X + (size_t)m * DM) + F.lane; const f32x4* gr = (const f32x4*)g + F.lane;
        f32x4 v[8]; float s = 0.f;
#pragma unroll
        for (int j = 0; j < 8; ++j) { v[j] = xr[64 * j]; s += (v[j].x * v[j].x + v[j].y * v[j].y) + (v[j].z * v[j].z + v[j].w * v[j].w); }
        const float rs = 1.0f / sqrtf(wave_sum(s) * (1.f / DM) + NORM_EPS);
#pragma unroll
        for (int j = 0; j < 8; ++j) { const f32x4 gg = gr[64 * j]; xr[64 * j] = v[j] * rs * gg; }
    }
}
__device__ __forceinline__ void rope_tables(Frame& F) {
    float* c128 = (float*)(F.ws + WS_COS128); float* s128 = (float*)(F.ws + WS_SIN128);
    float* c64 = (float*)(F.ws + WS_COS64); float* s64 = (float*)(F.ws + WS_SIN64);
    const int gt = F.vcu * 512 + F.tid, NT_ = F.G * 512;
    for (int e = gt; e < SEQ * 64 + SEQ * 32; e += NT_) {
        int pos, i, dim; float* cp; float* sp;
        if (e < SEQ * 64) { pos = e >> 6; i = e & 63; dim = 128; cp = c128 + e; sp = s128 + e; }
        else { const int e2 = e - SEQ * 64; pos = e2 >> 5; i = e2 & 31; dim = 64; cp = c64 + e2; sp = s64 + e2; }
        const float ex = (float)(2 * i) / (float)dim;
        const float inv = (float)exp(-(double)ex * 9.210340371976184);
        const float ang = (float)pos * inv;
        const double rev = (double)ang * 0.15915494309189535;
        const double fr = rev - rint(rev);
        const float a = (float)(fr * 6.283185307179586);
        *cp = __cosf(a); *sp = __sinf(a);
    }
}

namespace att {
constexpr int SHM_V = 64 * 128 * 2, SHM_K = 64 * 128 * 2, SHM_PE = 64 * 64 * 2;
constexpr int OFF_V = 0, OFF_K = 2 * SHM_V, OFF_PE = OFF_K + 2 * SHM_K, OFF_WS = OFF_PE + 2 * SHM_PE;
constexpr int OFF_TL = OFF_WS + 2048;
constexpr int OFF_KM = 90112;
constexpr int OFF_LB = OFF_TL + 1024;
enum { MODE_MLA = 0, MODE_DSA = 1, MODE_MOWN = 2, MODE_DIL = 3, MODE_MSEL = 4 };
constexpr float THR = 8.f;

#define KSWZ(row, colB) ((row) * 256 + ((colB) ^ (((row) & 7) << 4)))
#define SBAR() __builtin_amdgcn_sched_barrier(0)
__device__ __forceinline__ int v_st(int k, int c) { const int kk = (k & ~0xC) | ((k & 4) << 1) | ((k & 8) >> 1); return ((kk >> 3) * 4 + (c >> 5)) * 512 + ((kk & 7) * 32 + (c & 31)) * 2; }
__device__ __forceinline__ int v_rd_base(int lane) { return ((lane & 3) << 3) | (((lane >> 2) & 3) << 6) | (((lane >> 4) & 1) << 5) | (((lane >> 5) & 1) << 8); }
constexpr int v_rd_off(int d0, int ks, int half) { return d0 * 512 + ks * 4096 + half * 2048; }
__device__ __forceinline__ int crow(int r, int hi) { return (r & 3) + 8 * (r >> 2) + 4 * hi; }
__device__ __forceinline__ bf16x8 pack8(f32x4 a, f32x4 b) {
    u32x4 w = {cvt_pk_bf16(a[0], a[1]), cvt_pk_bf16(a[2], a[3]), cvt_pk_bf16(b[0], b[1]), cvt_pk_bf16(b[2], b[3])};
    return *reinterpret_cast<bf16x8*>(&w);
}
__device__ __forceinline__ void rope_pair(bf16x8& a, bf16x8& b, const float* cs, const float* sn, float scale = 1.0f) {
    const f32x4 c0 = *(const f32x4*)cs * scale, c1 = *(const f32x4*)(cs + 4) * scale, s0 = *(const f32x4*)sn * scale, s1 = *(const f32x4*)(sn + 4) * scale;
    f32x4 y1a, y1b, y2a, y2b;
#pragma unroll
    for (int j = 0; j < 4; ++j) {
        const float x1 = bf2f((unsigned short)a[j]), x2 = bf2f((unsigned short)b[j]);
        y1a[j] = x1 * c0[j] - x2 * s0[j]; y2a[j] = x1 * s0[j] + x2 * c0[j];
        const float z1 = bf2f((unsigned short)a[4 + j]), z2 = bf2f((unsigned short)b[4 + j]);
        y1b[j] = z1 * c1[j] - z2 * s1[j]; y2b[j] = z1 * s1[j] + z2 * c1[j];
    }
    a = pack8(y1a, y1b); b = pack8(y2a, y2b);
}
__device__ __forceinline__ void mask_tile(f32x16& p0, f32x16& p1, int dq, unsigned W) {
    const float NEG = -__builtin_inff();
#pragma unroll
    for (int r = 0; r < 16; ++r) {
        const int c = (r & 3) + 8 * (r >> 2);
        if ((unsigned)(dq - c) >= W) p0[r] = NEG;
        if ((unsigned)(dq - c - 32) >= W) p1[r] = NEG;
    }
}
__device__ __forceinline__ void mask_bits(f32x16& p0, f32x16& p1, unsigned w0s, unsigned w1s) {
    const float NEG = -__builtin_inff();
#pragma unroll
    for (int r = 0; r < 16; ++r) {
        const int c = (r & 3) + 8 * (r >> 2);
        if (!((w0s >> c) & 1u)) p0[r] = NEG;
        if (!((w1s >> c) & 1u)) p1[r] = NEG;
    }
}
template <int MODE>
__device__ __forceinline__ void partialSM(f32x16& p0, f32x16& p1, float& m_reg, float& mn, float& alpha) {
    constexpr float SCALE = (MODE == MODE_MLA) ? 0.07216878364870322f : 0.08838834764831845f;
    float pmax = p0[0];
#pragma unroll
    for (int r = 1; r < 16; ++r) pmax = fmaxf(pmax, p0[r]);
#pragma unroll
    for (int r = 0; r < 16; ++r) pmax = fmaxf(pmax, p1[r]);
    { auto rr = __builtin_amdgcn_permlane32_swap(__float_as_uint(pmax), __float_as_uint(pmax), false, false);
      pmax = fmaxf(__uint_as_float(rr[0]), __uint_as_float(rr[1])); }
    constexpr float C2 = 1.4426950408889634f * SCALE;
    if (__builtin_expect(__all((pmax - m_reg) * SCALE <= THR), 1)) { mn = m_reg; alpha = 1.f; }
    else { mn = fmaxf(m_reg, pmax); alpha = __builtin_amdgcn_exp2f((m_reg - mn) * C2); m_reg = mn; }
    const float mnL = -mn * C2;
#pragma unroll
    for (int r = 0; r < 16; ++r) p0[r] = fmaf(p0[r], C2, mnL);
#pragma unroll
    for (int r = 0; r < 16; ++r) p1[r] = fmaf(p1[r], C2, mnL);
#pragma unroll
    for (int r = 0; r < 16; ++r) p0[r] = __builtin_amdgcn_exp2f(p0[r]);
}
template <bool BITS>
__device__ __forceinline__ void finishSM(f32x16& p0, f32x16& p1, float alpha, float& l_reg, bf16x8& pa0, bf16x8& pa1, bf16x8& pa2, bf16x8& pa3, unsigned w0s, unsigned w1s) {
#pragma unroll
    for (int r = 0; r < 16; ++r) p1[r] = __builtin_amdgcn_exp2f(p1[r]);
    if constexpr (BITS) {
#pragma unroll
        for (int r = 0; r < 16; ++r) { const int c = (r & 3) + 8 * (r >> 2);
            p0[r] = __uint_as_float(__float_as_uint(p0[r]) & (unsigned)__builtin_amdgcn_sbfe((int)w0s, c, 1));
            p1[r] = __uint_as_float(__float_as_uint(p1[r]) & (unsigned)__builtin_amdgcn_sbfe((int)w1s, c, 1)); } }
    float ps = 0;
#pragma unroll
    for (int r = 0; r < 16; ++r) ps += p0[r];
#pragma unroll
    for (int r = 0; r < 16; ++r) ps += p1[r];
    { auto rr = __builtin_amdgcn_permlane32_swap(__float_as_uint(ps), __float_as_uint(ps), false, false);
      ps = __uint_as_float(rr[0]) + __uint_as_float(rr[1]); }
    l_reg = l_reg * alpha + ps;
#define PK4(P, B_, OUT) do { unsigned a0 = cvt_pk_bf16(P[B_+0], P[B_+1]), a1 = cvt_pk_bf16(P[B_+2], P[B_+3]);                          \
        unsigned b0 = cvt_pk_bf16(P[B_+4], P[B_+5]), b1 = cvt_pk_bf16(P[B_+6], P[B_+7]);                                             \
        auto r0 = __builtin_amdgcn_permlane32_swap(a0, b0, false, false); auto r1 = __builtin_amdgcn_permlane32_swap(a1, b1, false, false); \
        u32x4 w = {r0[0], r1[0], r0[1], r1[1]}; OUT = *reinterpret_cast<bf16x8*>(&w); } while (0)
    PK4(p0, 0, pa0); PK4(p0, 8, pa1); PK4(p1, 0, pa2); PK4(p1, 8, pa3);
#undef PK4
}
template <int KB>
__device__ __forceinline__ void qkt(f32x16& p0, f32x16& p1, LAS const char* K_lds, int r32, int hi, const bf16x8* qr) {
    p0 = f32x16{}; p1 = f32x16{};
    LAS const char* kb[4];
#pragma unroll
    for (int dd = 0; dd < 4; ++dd) kb[dd] = K_lds + KB * SHM_K + KSWZ(r32, (dd * 16 + hi * 8) * 2);
#pragma unroll
    for (int d0 = 0; d0 < 8; ++d0) { LAS const char* a = kb[d0 & 3] + (d0 >> 2) * 128;
        bf16x8 b0 = *reinterpret_cast<LAS const bf16x8*>(a);
        bf16x8 b1 = *reinterpret_cast<LAS const bf16x8*>(a + 32 * 256);
        p0 = __builtin_amdgcn_mfma_f32_32x32x16_bf16(b0, qr[d0], p0, 0, 0, 0);
        p1 = __builtin_amdgcn_mfma_f32_32x32x16_bf16(b1, qr[d0], p1, 0, 0, 0); }
}
template <int KB>
__device__ __forceinline__ void qkt_pe(f32x16& p0, f32x16& p1, LAS const char* PE_lds, int r32, int hi, const bf16x8* qr  ) {
#pragma unroll
    for (int dd = 0; dd < 4; ++dd) { LAS const char* a = PE_lds + KB * SHM_PE + r32 * 128 + ((dd * 32 + hi * 16) ^ ((r32 & 7) << 4));
        bf16x8 b0 = *reinterpret_cast<LAS const bf16x8*>(a);
        bf16x8 b1 = *reinterpret_cast<LAS const bf16x8*>(a + 32 * 128);
        p0 = __builtin_amdgcn_mfma_f32_32x32x16_bf16(b0, qr[dd], p0, 0, 0, 0);
        p1 = __builtin_amdgcn_mfma_f32_32x32x16_bf16(b1, qr[dd], p1, 0, 0, 0); }
}
template <int VB>
__device__ __forceinline__ void pv_tile(f32x16* o, int vb0, bf16x8 pa0, bf16x8 pa1, bf16x8 pa2, bf16x8 pa3) {
#define TRRD(dst, off) asm volatile("ds_read_b64_tr_b16 %0, %1 offset:%2" : "=&v"(dst) : "v"(vb0), "i"(off) : "memory")
#define PV_D0(d0) do { s16x4 l0, l1, l2, l3, h0, h1, h2, h3; constexpr int b_ = VB * SHM_V + v_rd_off(d0, 0, 0); \
        TRRD(l0, b_); TRRD(h0, b_ + 2048); TRRD(l1, b_ + 4096); TRRD(h1, b_ + 6144); TRRD(l2, b_ + 8192); TRRD(h2, b_ + 10240); TRRD(l3, b_ + 12288); TRRD(h3, b_ + 14336); \
        asm volatile("s_waitcnt lgkmcnt(0)" ::: "memory"); SBAR(); \
        o[d0] = __builtin_amdgcn_mfma_f32_32x32x16_bf16(pa0, (bf16x8){l0[0], l0[1], l0[2], l0[3], h0[0], h0[1], h0[2], h0[3]}, o[d0], 0, 0, 0);   \
        o[d0] = __builtin_amdgcn_mfma_f32_32x32x16_bf16(pa1, (bf16x8){l1[0], l1[1], l1[2], l1[3], h1[0], h1[1], h1[2], h1[3]}, o[d0], 0, 0, 0);   \
        o[d0] = __builtin_amdgcn_mfma_f32_32x32x16_bf16(pa2, (bf16x8){l2[0], l2[1], l2[2], l2[3], h2[0], h2[1], h2[2], h2[3]}, o[d0], 0, 0, 0);   \
        o[d0] = __builtin_amdgcn_mfma_f32_32x32x16_bf16(pa3, (bf16x8){l3[0], l3[1], l3[2], l3[3], h3[0], h3[1], h3[2], h3[3]}, o[d0], 0, 0, 0); } while (0)
    PV_D0(0); PV_D0(1); PV_D0(2); PV_D0(3);
#undef PV_D0
#undef TRRD
}

struct UnitArgs {
    const bf16* Q; size_t qpitch;
    const bf16* K; size_t kpitch;
    const bf16* PE; size_t pepitch;
    const bf16* V; size_t vpitch;
    bf16* O; size_t opitch;
    float* LSE; int lse_stride;
    const float* cosT; const float* sinT;
    int pos0, posstride;
    int P0;
    const unsigned* BM;
    const float* KMP;
    int own;
    unsigned* SEL; int* CNT;
    size_t oslot, lslot;
};

template <int MODE>
__device__ __forceinline__ void attn_unit(LAS char* lds, const UnitArgs& U) {
    constexpr bool MLA = MODE == MODE_MLA, DSA = MODE == MODE_DSA, MOWN = MODE == MODE_MOWN, MSEL = MODE == MODE_MSEL, DIL = MODE == MODE_DIL;
    constexpr int NQF = MLA ? 12 : 8;
    constexpr float SCALE = MLA ? 0.07216878364870322f : 0.08838834764831845f;
    constexpr float C2 = 1.4426950408889634f * SCALE;
    const int tid = threadIdx.x, wid = __builtin_amdgcn_readfirstlane(tid >> 6), lane = tid & 63, r32 = lane & 31, hi = lane >> 5;
    LAS char* V_lds = lds + OFF_V; LAS char* K_lds = lds + OFF_K; LAS char* PE_lds = lds + OFF_PE;
    LAS float* wsf = (LAS float*)(lds + OFF_WS) + wid * 64; LAS float* li_l = wsf; LAS float* al_l = wsf + 32;
    LAS unsigned* rinfo = (LAS unsigned*)(lds + OFF_TL);
    const int qlo = U.P0 + wid * 32;
    int qrow = qlo + r32; bool rvalid = true;
    if constexpr (MSEL) { const unsigned inf_ = rinfo[wid * 32 + r32]; rvalid = inf_ != 0xFFFFFFFFu; qrow = rvalid ? (int)(inf_ & 0xFFFFu) : 0; }
    const int qm = qrow - 4 * hi;
    bf16x8 qr[NQF];
    { const bf16* qp = U.Q + (size_t)qrow * U.qpitch + hi * 8;
#pragma unroll
      for (int d0 = 0; d0 < NQF; ++d0) qr[d0] = *(const bf16x8*)(qp + d0 * 16);
      const int pos = U.pos0 + U.posstride * qrow;
      if constexpr (MLA) {
#pragma unroll
          for (int dd = 0; dd < 2; ++dd) rope_pair(qr[8 + dd], qr[10 + dd], U.cosT + (size_t)pos * 32 + dd * 16 + hi * 8, U.sinT + (size_t)pos * 32 + dd * 16 + hi * 8);
      } else {
#pragma unroll
          for (int dd = 0; dd < 4; ++dd) rope_pair(qr[dd], qr[4 + dd], U.cosT + (size_t)pos * 64 + dd * 16 + hi * 8, U.sinT + (size_t)pos * 64 + dd * 16 + hi * 8);
      } }
    int NT = 4, kb_first = 0;
    if constexpr (MLA || DSA) { NT = (U.P0 + 255) / 64 + 1; }
    if constexpr (DIL) { const int lowk = U.P0 - 128; const int j_lo = lowk > 0 ? lowk / 64 : 0; kb_first = j_lo * 64; NT = (U.P0 + 255) / 64 + 1 - j_lo; }
    if constexpr (MOWN || MSEL) { kb_first = U.own * 256; NT = 4; }
    if constexpr (MOWN) {
        const int own = U.own;
        LAS char* KM = lds + OFF_KM;
        { const int jb = tid >> 4, d8 = (tid & 15) * 8; const float* kp = U.KMP + (size_t)jb * 512 + d8;
          f32x4 a0 = (f32x4){0.f, 0.f, 0.f, 0.f}, a1 = a0;
#pragma unroll
          for (int pq = 0; pq < 4; ++pq) { a0 += *(const f32x4*)(kp + pq * 128); a1 += *(const f32x4*)(kp + pq * 128 + 4); }
          *(LAS bf16x8*)(KM + jb * 256 + d8 * 2) = pack8(a0 * (1.f / 256.f), a1 * (1.f / 256.f)); }
        __syncthreads();
        f32x16 g = f32x16{};
#pragma unroll
        for (int d0 = 0; d0 < 8; ++d0) { const bf16x8 a = *(const LAS bf16x8*)(KM + r32 * 256 + (d0 * 16 + hi * 8) * 2);
            g = __builtin_amdgcn_mfma_f32_32x32x16_bf16(a, qr[d0], g, 0, 0, 0); }
        const float NEG = -__builtin_inff();
#pragma unroll
        for (int r = 0; r < 16; ++r) if (crow(r, hi) >= own) g[r] = NEG;
        unsigned selbits = 0;
#pragma unroll
        for (int round = 0; round < 3; ++round) {
            float bv = NEG; int bi = 64;
#pragma unroll
            for (int r = 0; r < 16; ++r) { const int j = crow(r, hi); if (g[r] > bv) { bv = g[r]; bi = j; } }
            const float ov = __shfl_xor(bv, 32); const int oi = __shfl_xor(bi, 32);
            const bool take_other = (ov > bv) || (ov == bv && oi < bi);
            const float wv = take_other ? ov : bv; const int wi = take_other ? oi : bi;
            if (wv > NEG) { selbits |= 1u << wi;
#pragma unroll
                for (int r = 0; r < 16; ++r) if (crow(r, hi) == wi) g[r] = NEG; }
        }
        const int nsel = __builtin_popcount(selbits);
        if (hi == 0) { U.SEL[qrow] = selbits;
#pragma unroll
            for (int s_ = 0; s_ < 3; ++s_) if (s_ >= nsel) U.LSE[(size_t)s_ * U.lslot + (size_t)qrow * U.lse_stride] = NEG; }
        LAS int* cw = (LAS int*)(lds + OFF_TL);
#pragma unroll 4
        for (int j = 0; j < 32; ++j) { const int c_ = __builtin_popcountll(__ballot(hi == 0 && ((selbits >> j) & 1u))); if (lane == 0) cw[wid * 32 + j] = c_; }
        __syncthreads();
        if (tid < 32) { int s_ = 0;
#pragma unroll
            for (int w_ = 0; w_ < 8; ++w_) s_ += cw[w_ * 32 + tid];
            U.CNT[tid] = s_; }
        __syncthreads();
    }
    float m_reg = -1e30f, l_reg = 0.f; f32x16 o[4] = {};
    unsigned koff, voff, peoff = 0u;
    { const int row = 4 * wid + (lane >> 4), colB = ((lane & 15) * 16) ^ ((row & 7) << 4); koff = (unsigned)((row * U.kpitch) * 2 + colB); }
    { const int kk = (wid >> 1) * 8 + ((lane & 31) >> 2), k = (kk & ~0xC) | ((kk & 4) << 1) | ((kk & 8) >> 1), c = (2 * (wid & 1) + (lane >> 5)) * 32 + (lane & 3) * 8;
      voff = (unsigned)((k * U.vpitch + c) * 2); }
    if constexpr (MLA) { const int row = 8 * wid + (lane >> 3), colB = ((lane & 7) * 16) ^ ((row & 7) << 4); peoff = (unsigned)((row * U.pepitch) * 2 + colB); }
    const unsigned bmoff = (unsigned)qrow * 1024u;
    const int vb0 = (int)(unsigned)(uintptr_t)V_lds + v_rd_base(lane);
    u32x2 mw_n = (u32x2){0u, 0u}, mw_c = (u32x2){0u, 0u};
#define KBASE(t) (kb_first + (t) * 64)
#define SLOAD(kb_, bf) do { const char* kt_ = (const char*)U.K + (size_t)(kb_) * U.kpitch * 2; const char* vt_ = (const char*)U.V + (size_t)(kb_) * U.vpitch * 2; \
        __builtin_amdgcn_global_load_lds((const unsigned*)(kt_ + koff), (LAS unsigned*)(K_lds + (bf) * SHM_K + wid * 1024), 16, 0, 0); \
        __builtin_amdgcn_global_load_lds((const unsigned*)(kt_ + (size_t)64 * U.kpitch + koff), (LAS unsigned*)(K_lds + (bf) * SHM_K + 8192 + wid * 1024), 16, 0, 0); \
        __builtin_amdgcn_global_load_lds((const unsigned*)(vt_ + voff), (LAS unsigned*)(V_lds + (bf) * SHM_V + wid * 1024), 16, 0, 0); \
        __builtin_amdgcn_global_load_lds((const unsigned*)(vt_ + (size_t)64 * U.vpitch + voff), (LAS unsigned*)(V_lds + (bf) * SHM_V + 8192 + wid * 1024), 16, 0, 0); \
        if constexpr (MLA) __builtin_amdgcn_global_load_lds((const unsigned*)((const char*)U.PE + (size_t)(kb_) * U.pepitch * 2 + peoff), (LAS unsigned*)(PE_lds + (bf) * SHM_PE + wid * 1024), 16, 0, 0); \
        if constexpr (DSA) mw_n = *(const u32x2*)((const char*)U.BM + (size_t)((kb_) >> 5) * 4 + bmoff); } while (0)
#define RESC(a) do { if (__any((a) < 1.f)) { if (hi == 0) al_l[r32] = (a); asm volatile("s_waitcnt lgkmcnt(0)" ::: "memory"); \
        _Pragma("unroll") for (int d_ = 0; d_ < 4; ++d_) _Pragma("unroll") for (int r = 0; r < 16; ++r) o[d_][r] *= al_l[crow(r, hi)]; } } while (0)
    const bool wact = MSEL ? (bool)__any(rvalid) : true;
#define STEP(t_, B_, NB_) do { const int kb_ = KBASE(t_); const bool more_ = (t_) + 1 < NT; \
        if (more_) { const int kbn_ = KBASE((t_) + 1); SLOAD(kbn_, NB_); } \
        bool act_ = wact; \
        if constexpr (MLA || DSA || MOWN) act_ = kb_ <= qlo + 31; \
        if constexpr (DIL) act_ = (kb_ <= qlo + 31) && (kb_ + 63 >= qlo - 128); \
        if (act_) { f32x16 p0, p1; qkt<B_>(p0, p1, K_lds, r32, hi, qr); \
            if constexpr (MLA) qkt_pe<B_>(p0, p1, PE_lds, r32, hi, qr + 8); \
            if constexpr (MLA || DSA || MOWN) { if (kb_ + 63 > qlo) mask_tile(p0, p1, qm - kb_, 0x7fffffffu); } \
            if constexpr (DIL) { if (kb_ + 63 > qlo || kb_ <= qlo + 31 - 129) mask_tile(p0, p1, qm - kb_, 129u); } \
            float mn_, al_; partialSM<MODE>(p0, p1, m_reg, mn_, al_); RESC(al_); \
            bf16x8 pa0, pa1, pa2, pa3; finishSM<DSA>(p0, p1, al_, l_reg, pa0, pa1, pa2, pa3, mw_c.x >> (4 * hi), mw_c.y >> (4 * hi)); SBAR(); \
            pv_tile<B_>(o, vb0, pa0, pa1, pa2, pa3); } \
        VM_WAIT(); mw_c = mw_n; \
        __syncthreads(); } while (0)
    { const int kb0 = KBASE(0); SLOAD(kb0, 0); VM_WAIT(); mw_c = mw_n; }
    __syncthreads();
    for (int t = 0; t < NT; t += 2) {
        STEP(t, 0, 1);
        if (t + 1 < NT) STEP(t + 1, 1, 0);
    }
    if (hi == 0) li_l[r32] = l_reg;
    asm volatile("s_waitcnt lgkmcnt(0)" ::: "memory");
    float rli[16];
#pragma unroll
    for (int r = 0; r < 16; ++r) rli[r] = __builtin_amdgcn_rcpf(li_l[crow(r, hi)]);
    if constexpr (MSEL) {
        if (wact) {
#pragma unroll
            for (int r = 0; r < 16; ++r) { const unsigned inf_ = rinfo[wid * 32 + crow(r, hi)];
                if (inf_ != 0xFFFFFFFFu) { bf16* rb = U.O + (size_t)(inf_ >> 16) * U.oslot + (size_t)(inf_ & 0xFFFFu) * U.opitch;
#pragma unroll
                    for (int d0 = 0; d0 < 4; ++d0) { const float v = o[d0][r] * rli[r];
                        const float vn = __shfl_xor(v, 1);
                        if ((r32 & 1) == 0) *(unsigned*)(rb + d0 * 32 + r32) = cvt_pk_bf16(v, vn); } } }
            if (hi == 0 && rvalid) { const unsigned inf_ = rinfo[wid * 32 + r32];
                U.LSE[(size_t)(inf_ >> 16) * U.lslot + (size_t)(inf_ & 0xFFFFu) * U.lse_stride] = m_reg * C2 + __builtin_amdgcn_logf(l_reg); }
        }
    } else {
      { const unsigned lane_off = (unsigned)((4 * hi * U.opitch + r32) * 2);
        const char* obase = (const char*)(U.O + (size_t)qlo * U.opitch);
#pragma unroll
        for (int r = 0; r < 16; ++r) { const char* rb = obase + (size_t)((r & 3) + 8 * (r >> 2)) * U.opitch * 2;
#pragma unroll
          for (int d0 = 0; d0 < 4; ++d0) { const float v = o[d0][r] * rli[r];
              const float vn = __shfl_xor(v, 1);
              if ((r32 & 1) == 0) *(unsigned*)(rb + d0 * 64 + lane_off) = cvt_pk_bf16(v, vn); } } }
      if constexpr (DIL) { if (hi == 0) U.LSE[(size_t)qrow * U.lse_stride] = m_reg * C2 + __builtin_amdgcn_logf(l_reg); }
      if constexpr (MOWN) { if (hi == 0) U.LSE[(size_t)3 * U.lslot + (size_t)qrow * U.lse_stride] = m_reg * C2 + __builtin_amdgcn_logf(l_reg); }
    }
    __syncthreads();
#undef KBASE
#undef SLOAD
#undef RESC
#undef STEP
}
}

__device__ __forceinline__ void rope_row_heads128(bf16* kbase, const float* cs, const float* sn, int lane) {
    const int h = lane >> 3, i0 = (lane & 7) * 8;
    bf16* p = kbase + h * 128 + i0;
    bf16x8 a = *(const bf16x8*)p, b = *(const bf16x8*)(p + 64);
    att::rope_pair(a, b, cs + i0, sn + i0);
    *(bf16x8*)p = a; *(bf16x8*)(p + 64) = b;
}
__device__ __forceinline__ void post_even(Frame& F, const float* g_q, const float* g_kv) {
    bf16* PROJ = (bf16*)(F.ws + WS_PROJ);
    const float* c128 = (const float*)(F.ws + WS_COS128); const float* s128 = (const float*)(F.ws + WS_SIN128);
    const float* c64 = (const float*)(F.ws + WS_COS64); const float* s64 = (const float*)(F.ws + WS_SIN64);
    const int gw = F.vcu * NWAVES + F.wave, NGW = F.G * NWAVES, lane = F.lane;
    for (int m = gw; m < T; m += NGW) {
        bf16* row = PROJ + (size_t)m * EVEN_INP; const int pos = m & (SEQ - 1);
        {
            bf16x8 v = *(const bf16x8*)(row + EC_CQ + lane * 8); float f[8], s = 0.f;
#pragma unroll
            for (int j = 0; j < 8; ++j) { f[j] = bf2f((unsigned short)v[j]); s += f[j] * f[j]; }
            const float rs = 1.0f / sqrtf(wave_sum(s) * (1.f / 512.f) + NORM_EPS);
            const f32x4 g0 = *(const f32x4*)(g_q + lane * 8), g1 = *(const f32x4*)(g_q + lane * 8 + 4);
            f32x4 o0 = {f[0] * rs * g0[0], f[1] * rs * g0[1], f[2] * rs * g0[2], f[3] * rs * g0[3]}, o1 = {f[4] * rs * g1[0], f[5] * rs * g1[1], f[6] * rs * g1[2], f[7] * rs * g1[3]};
            *(bf16x8*)(row + EC_CQ + lane * 8) = att::pack8(o0, o1); }
        {
            const u32x2 v = *(const u32x2*)(row + EC_CKV + lane * 4);
            const float f0 = bf2f((unsigned short)(v.x & 0xffff)), f1 = bf2f((unsigned short)(v.x >> 16)), f2 = bf2f((unsigned short)(v.y & 0xffff)), f3 = bf2f((unsigned short)(v.y >> 16));
            const float rs = 1.0f / sqrtf(wave_sum(f0 * f0 + f1 * f1 + f2 * f2 + f3 * f3) * (1.f / 256.f) + NORM_EPS);
            const f32x4 g0 = *(const f32x4*)(g_kv + lane * 4);
            u32x2 w; w.x = cvt_pk_bf16(f0 * rs * g0[0], f1 * rs * g0[1]); w.y = cvt_pk_bf16(f2 * rs * g0[2], f3 * rs * g0[3]);
            *(u32x2*)(row + EC_CKV + lane * 4) = w; }
        {
            const int i = lane & 31; bf16* p = row + ((lane < 32) ? EC_KPE : EC_KI) + i;
            const float x1 = bf2f(p[0]), x2 = bf2f(p[32]); const float c = c64[pos * 32 + i], s = s64[pos * 32 + i];
            const unsigned y = cvt_pk_bf16(x1 * c - x2 * s, x1 * s + x2 * c);
            p[0] = (bf16)(y & 0xffff); p[32] = (bf16)(y >> 16); }
        rope_row_heads128(row + EC_K, c128 + (size_t)pos * 64, s128 + (size_t)pos * 64, lane);
    }
}
__device__ __forceinline__ void post_odd(Frame& F) {
    bf16* PROJ = (bf16*)(F.ws + WS_PROJ2);
    const float* c128 = (const float*)(F.ws + WS_COS128); const float* s128 = (const float*)(F.ws + WS_SIN128);
    float* KMP = (float*)(F.ws + WS_KM);
    LAS float* red = (LAS float*)F.lds;
    const int lane = F.lane, h = lane >> 3, i0 = (lane & 7) * 8;
    for (int u = F.vcu; u < T / 64; u += F.G) {
        float sa[8], sb[8];
#pragma unroll
        for (int j = 0; j < 8; ++j) { sa[j] = 0.f; sb[j] = 0.f; }
        for (int rr = 0; rr < 8; ++rr) {
            const int m = u * 64 + F.wave * 8 + rr; const int pos = m & (SEQ - 1);
            bf16* row = PROJ + (size_t)m * ODD_IN;
            const float* cs = c128 + (size_t)pos * 64; const float* sn = s128 + (size_t)pos * 64;
            { bf16* p = row + OC_KC + h * 128 + i0; bf16x8 a = *(const bf16x8*)p, b = *(const bf16x8*)(p + 64);
              const f32x4 c0 = *(const f32x4*)(cs + i0), c1 = *(const f32x4*)(cs + i0 + 4), s0 = *(const f32x4*)(sn + i0), s1 = *(const f32x4*)(sn + i0 + 4);
              f32x4 y1a, y1b, y2a, y2b;
#pragma unroll
              for (int j = 0; j < 4; ++j) { const float x1 = bf2f((unsigned short)a[j]), x2 = bf2f((unsigned short)b[j]); y1a[j] = x1 * c0[j] - x2 * s0[j]; y2a[j] = x1 * s0[j] + x2 * c0[j];
                  const float z1 = bf2f((unsigned short)a[4 + j]), z2 = bf2f((unsigned short)b[4 + j]); y1b[j] = z1 * c1[j] - z2 * s1[j]; y2b[j] = z1 * s1[j] + z2 * c1[j];
                  sa[j] += y1a[j]; sa[4 + j] += y1b[j]; sb[j] += y2a[j]; sb[4 + j] += y2b[j]; }
              *(bf16x8*)p = att::pack8(y1a, y1b); *(bf16x8*)(p + 64) = att::pack8(y2a, y2b); }
            rope_row_heads128(row + OC_KD, cs, sn, lane);
        }
#pragma unroll
        for (int j = 0; j < 8; ++j) { red[F.wave * 1024 + h * 128 + i0 + j] = sa[j]; red[F.wave * 1024 + h * 128 + 64 + i0 + j] = sb[j]; }
        __syncthreads();
        { const int b = u / 128, jq = u % 128, jb = jq >> 2, q4 = jq & 3;
#pragma unroll
          for (int cc = 0; cc < 2; ++cc) { const int col = F.tid + cc * 512; float s = 0.f;
#pragma unroll
              for (int w = 0; w < 8; ++w) s += red[w * 1024 + col];
              const int hh = col >> 7, d = col & 127;
              KMP[((((size_t)b * 8 + hh) * 32 + jb) * 4 + q4) * 128 + d] = s; } }
        __syncthreads();
    }
}

#ifndef REPMASK
#define REPMASK 0ull
#endif
#define IDX_REP_A ((((REPMASK) >> 24) & 1ull) ? 2 : 1)
#define IDX_REP_B ((((REPMASK) >> 25) & 1ull) ? 2 : 1)
__device__ __forceinline__ void indexer_unit(Frame& F, int b, int i) {
    const bf16* PR = (const bf16*)(F.ws + WS_PROJ) + (size_t)b * SEQ * EVEN_INP;
    const float* c64 = (const float*)(F.ws + WS_COS64); const float* s64 = (const float*)(F.ws + WS_SIN64);
    float* SCw = (float*)(F.ws + WS_SC + (size_t)blockIdx.x * MiB);
    unsigned* BMb = (unsigned*)(F.ws + WS_BM) + (size_t)b * SEQ * 256;
    LAS unsigned char* lds = F.lds;
    const int tid = F.tid, wid = F.wave, lane = F.lane, r32 = lane & 31, hi = lane >> 5;
    const int t0 = 32 * i;
    LAS float* sgl = (LAS float*)(lds + 139264);
    {
        const int row = tid & 31, h = tid >> 5; const int pos = t0 + row;
        const float wv = bf2f(PR[(size_t)pos * EVEN_INP + EC_WI + h]) * 0.03125f;
        sgl[h * 32 + row] = wv < 0.f ? -1.f : 1.f;
        const bf16* qp = PR + (size_t)pos * EVEN_INP + EC_QI + h * 64;
        bf16x8 f[8];
#pragma unroll
        for (int p = 0; p < 8; ++p) f[p] = *(const bf16x8*)(qp + p * 8);
#pragma unroll
        for (int p = 0; p < 4; ++p) att::rope_pair(f[p], f[p + 4], c64 + (size_t)pos * 32 + p * 8, s64 + (size_t)pos * 32 + p * 8, fabsf(wv));
#pragma unroll
        for (int p = 0; p < 8; ++p) *(LAS bf16x8*)(lds + ((((h * 4 + (p >> 1)) * 2 + (p & 1)) * 32 + row) * 16)) = f[p];
    }
    __syncthreads();
    {
        const int row = tid & 31, dg = tid >> 5, ks = dg >> 2, hi2 = (dg >> 1) & 1, e0 = (dg & 1) * 4;
        float acc4[4] = {0.f, 0.f, 0.f, 0.f};
#pragma unroll
        for (int h = 0; h < 16; ++h) { const u32x2 v = *(const LAS u32x2*)(lds + ((((h * 4 + ks) * 2 + hi2) * 32 + row) * 16) + e0 * 2); const float sg = sgl[h * 32 + row];
            acc4[0] += sg * bf2f((unsigned short)(v.x & 0xffff)); acc4[1] += sg * bf2f((unsigned short)(v.x >> 16));
            acc4[2] += sg * bf2f((unsigned short)(v.y & 0xffff)); acc4[3] += sg * bf2f((unsigned short)(v.y >> 16)); }
        u32x2 o2; o2.x = cvt_pk_bf16(acc4[0], acc4[1]); o2.y = cvt_pk_bf16(acc4[2], acc4[3]);
        *(LAS u32x2*)(lds + ((((16 * 4 + ks) * 2 + hi2) * 32 + row) * 16) + e0 * 2) = o2;
    }
    __syncthreads();
    const int nkeys = 32 * (i + 1), nsteps = (nkeys + 63) / 64;
    LAS float* tls = (LAS float*)(lds + 69632 + wid * 8704);
    for (int rep_ = 0; rep_ < IDX_REP_A; ++rep_)
    for (int g = wid; g < nsteps; g += 8) {
        const int k0 = 64 * g;
        bf16x8 ka[4], kb[4];
        { const bf16* kp = PR + (size_t)(k0 + r32) * EVEN_INP + EC_KI + hi * 8;
#pragma unroll
          for (int ks = 0; ks < 4; ++ks) { ka[ks] = *(const bf16x8*)(kp + ks * 16); kb[ks] = *(const bf16x8*)(kp + (size_t)32 * EVEN_INP + ks * 16); } }
        f32x16 s0 = f32x16{}, s1 = f32x16{};
        LAS const unsigned char* qb_ = lds + (hi * 32 + r32) * 16;
#define IDX_MMA(A0, A1, H) do { A0 = f32x16{}; A1 = f32x16{}; _Pragma("unroll") for (int ks = 0; ks < 4; ++ks) { const bf16x8 q = *(const LAS bf16x8*)(qb_ + (H) * 4096 + ks * 1024); \
            A0 = __builtin_amdgcn_mfma_f32_32x32x16_bf16(ka[ks], q, A0, 0, 0, 0); A1 = __builtin_amdgcn_mfma_f32_32x32x16_bf16(kb[ks], q, A1, 0, 0, 0); } } while (0)
#define IDX_ACC(A0, A1, W) do { _Pragma("unroll") for (int r = 0; r < 16; ++r) { s0[r] = fmaf(W, __builtin_fabsf(A0[r]), s0[r]); s1[r] = fmaf(W, __builtin_fabsf(A1[r]), s1[r]); } } while (0)
        f32x16 a0, a1, b0, b1;
        IDX_MMA(a0, a1, 0);
#pragma unroll 1
        for (int h = 0; h < 16; h += 2) {
            const float w0 = sgl[h * 32 + r32], w1 = sgl[(h + 1) * 32 + r32];
            IDX_MMA(b0, b1, h + 1);
            __builtin_amdgcn_sched_barrier(0);
            IDX_ACC(a0, a1, w0);
            __builtin_amdgcn_sched_barrier(0);
            IDX_MMA(a0, a1, h + 2);
            __builtin_amdgcn_sched_barrier(0);
            IDX_ACC(b0, b1, w1);
            __builtin_amdgcn_sched_barrier(0);
        }
#pragma unroll
        for (int r = 0; r < 16; ++r) { s0[r] = 0.5f * (s0[r] + a0[r]); s1[r] = 0.5f * (s1[r] + a1[r]); }
#undef IDX_MMA
#undef IDX_ACC
#pragma unroll
        for (int q4 = 0; q4 < 4; ++q4) {
            *(LAS f32x4*)(tls + r32 * 68 + 8 * q4 + 4 * hi) = (f32x4){s0[4 * q4], s0[4 * q4 + 1], s0[4 * q4 + 2], s0[4 * q4 + 3]};
            *(LAS f32x4*)(tls + r32 * 68 + 32 + 8 * q4 + 4 * hi) = (f32x4){s1[4 * q4], s1[4 * q4 + 1], s1[4 * q4 + 2], s1[4 * q4 + 3]}; }
        LDS_WAIT(); asm volatile("" ::: "memory");
#pragma unroll
        for (int ps = 0; ps < 8; ++ps) { const int row = ps * 4 + (lane >> 4), c4 = (lane & 15) * 4;
            const f32x4 v = *(const LAS f32x4*)(tls + row * 68 + c4);
            u32x4 uu;
#pragma unroll
            for (int e = 0; e < 4; ++e) { const unsigned x = __float_as_uint(v[e]); const unsigned y = (x & 0x80000000u) ? ~x : (x | 0x80000000u);
                uu[e] = (k0 + c4 + e <= t0 + row) ? y : 0u; }
            *(u32x4*)(SCw + (size_t)row * 8192 + k0 + c4) = uu; }
        LDS_WAIT(); asm volatile("" ::: "memory");
    }
    {
        const int kz0 = 64 * nsteps, kz1 = (kz0 + 1023) & ~1023, n4 = (kz1 - kz0) >> 2;
        for (int idx = tid; idx < 32 * n4; idx += 512) { const int row = idx / n4, c = idx - row * n4;
            *(u32x4*)(SCw + (size_t)row * 8192 + kz0 + 4 * c) = (u32x4){0u, 0u, 0u, 0u}; } }
    VM_WAIT();
    __syncthreads();
    __builtin_amdgcn_fence(__ATOMIC_ACQUIRE, "agent");
    VM_WAIT();
    for (int k_ = 0; k_ < 4 * IDX_REP_B; ++k_) { const int k = k_ & 3;
        const int rho = wid * 4 + k, t = t0 + rho, nvalid = t + 1, nch = (nvalid + 63) >> 6;
        const float* srow = SCw + (size_t)rho * 8192 + lane;
        unsigned u[128];
#pragma unroll
        for (int g8 = 0; g8 < 8; ++g8) {
            if (g8 * 16 < nch) {
                const float* sg0 = srow + g8 * 1024; asm volatile("" : "+v"(sg0));
                const GAS unsigned* sg = (const GAS unsigned*)sg0;
#pragma unroll
                for (int jj = 0; jj < 16; ++jj) u[g8 * 16 + jj] = sg[64 * jj];
            } else {
#pragma unroll
                for (int jj = 0; jj < 16; ++jj) u[g8 * 16 + jj] = 0u;
            }
        }
        unsigned tau = 1u;
#define SEL_COUNT(cand_, cnt_) do { cnt_ = 0; _Pragma("unroll") for (int g8 = 0; g8 < 8; ++g8) if (g8 * 16 < nch) { \
            _Pragma("unroll") for (int jj = 0; jj < 16; ++jj) { cnt_ += __builtin_popcountll(__ballot(u[g8 * 16 + jj] >= (cand_))); if ((jj & 7) == 7) asm volatile("" : "+s"(cnt_)); } } } while (0)
        if (nvalid > 256) {
            unsigned P = 0u; int c1 = 0;
            for (int bit = 31; bit >= 16; --bit) { const unsigned cand = P | (1u << bit); int cnt; SEL_COUNT(cand, cnt); if (cnt >= 256) P = cand; else c1 = cnt; }
            constexpr int LCAP = 1024;
            LAS unsigned* lst = (LAS unsigned*)(lds + wid * (LCAP * 4));
            int c2 = 0;
#pragma unroll
            for (int g8 = 0; g8 < 8; ++g8) if (g8 * 16 < nch) {
#pragma unroll
                for (int jj = 0; jj < 16; ++jj) { const unsigned x = u[g8 * 16 + jj] ^ P; const bool fl = x < 65536u; const unsigned long long bal = __ballot(fl);
                    if (bal != 0ull) { const int pos = c2 + (int)__builtin_amdgcn_mbcnt_hi((unsigned)(bal >> 32), __builtin_amdgcn_mbcnt_lo((unsigned)bal, 0u));
                        if (fl && pos < LCAP) lst[pos] = x;
                        c2 += __builtin_popcountll(bal); } } }
            const int need = 256 - c1;
            if (c2 <= LCAP) {
                asm volatile("s_waitcnt lgkmcnt(0)" ::: "memory");
                unsigned L = 0u;
                for (int bit = 15; bit >= 0; --bit) { const unsigned cand = L | (1u << bit); int cnt = 0;
                    for (int i0 = 0; i0 < c2; i0 += 64) { const int i = i0 + lane; cnt += __builtin_popcountll(__ballot(i < c2 && lst[i < c2 ? i : 0] >= cand)); }
                    if (cnt >= need) L = cand; }
                tau = P | L;
            } else {
                tau = P;
                for (int bit = 15; bit >= 0; --bit) { const unsigned cand = tau | (1u << bit); int cnt; SEL_COUNT(cand, cnt); if (cnt >= 256) tau = cand; }
            }
        }
#undef SEL_COUNT
        unsigned* brow = BMb + (size_t)t * 256;
#pragma unroll
        for (int half = 0; half < 2; ++half) { unsigned lo = 0u, hw = 0u;
#pragma unroll
            for (int jj = 0; jj < 64; ++jj) { const unsigned long long bm = __ballot(u[half * 64 + jj] >= tau);
                const unsigned bl_ = (unsigned)bm, bh_ = (unsigned)(bm >> 32);
                asm volatile("s_nop 1\n\tv_writelane_b32 %0, %2, %4\n\tv_writelane_b32 %1, %3, %4" : "+v"(lo), "+v"(hw) : "s"(bl_), "s"(bh_), "n"(jj)); }
            *(u32x2*)(brow + (half * 64 + lane) * 2) = (u32x2){lo, hw}; }
    }
    __syncthreads();
}
__device__ __forceinline__ void dil_combine(Frame& F, bf16* O) {
    const bf16* OG = (const bf16*)(F.ws + WS_OG); const float* LSE = (const float*)(F.ws + WS_LSE);
    const int gw = F.vcu * NWAVES + F.wave, NGW = F.G * NWAVES, lane = F.lane, h = lane >> 3;
    for (int m = gw; m < T; m += NGW) {
        float l[3], w[3];
#pragma unroll
        for (int g = 0; g < 3; ++g) l[g] = LSE[((size_t)g * T + m) * 8 + h];
        const float mx = fmaxf(l[0], fmaxf(l[1], l[2]));
        float ssum = 0.f;
#pragma unroll
        for (int g = 0; g < 3; ++g) { w[g] = __builtin_amdgcn_exp2f(l[g] - mx); ssum += w[g]; }
        const float inv = 1.f / ssum;
        float acc[16];
        bf16* op = O + (size_t)m * DM + 1024 + lane * 16;
#pragma unroll
        for (int g = 0; g < 3; ++g) { const bf16* p = g == 0 ? op : OG + ((size_t)(g - 1) * T + m) * 1024 + lane * 16;
            const bf16x8 a = *(const bf16x8*)p, b = *(const bf16x8*)(p + 8); const float wg = w[g] * inv;
#pragma unroll
            for (int j = 0; j < 8; ++j) { const float xa = wg * bf2f((unsigned short)a[j]), xb = wg * bf2f((unsigned short)b[j]);
                acc[j] = g == 0 ? xa : acc[j] + xa; acc[8 + j] = g == 0 ? xb : acc[8 + j] + xb; } }
        *(bf16x8*)op = att::pack8((f32x4){acc[0], acc[1], acc[2], acc[3]}, (f32x4){acc[4], acc[5], acc[6], acc[7]});
        *(bf16x8*)(op + 8) = att::pack8((f32x4){acc[8], acc[9], acc[10], acc[11]}, (f32x4){acc[12], acc[13], acc[14], acc[15]});
    }
}
__device__ __forceinline__ int moba_chunk_table(Frame& F, const int* CNT, LAS int* ctab) {
    LAS int* wt = ctab + 512;
    int v = 0;
    if (F.tid < 496) { const int bh = F.tid / 31, j = F.tid - bh * 31; int n = 0;
        for (int qb = j + 1; qb < 32; ++qb) n += CNT[(bh * 32 + qb) * 32 + j];
        v = (n + 255) >> 8; }
    int incl = v;
#pragma unroll
    for (int o_ = 1; o_ < 64; o_ <<= 1) { const int x_ = __shfl_up(incl, o_); if (F.lane >= o_) incl += x_; }
    if (F.lane == 63) wt[F.wave] = incl;
    __syncthreads();
    int off = 0;
    for (int w_ = 0; w_ < F.wave; ++w_) off += wt[w_];
    ctab[F.tid] = off + incl - v;
    if (F.tid == 511) ctab[512 + 16] = off + incl;
    __syncthreads();
    return ctab[512 + 16];
}
__device__ __forceinline__ void moba_build_list(Frame& F, const unsigned* SEL, const int* CNT, int bh, int j, int c, LAS unsigned* rinfo, LAS int* wc) {
    const int tid = F.tid, lane = F.lane, wid = F.wave;
    if (tid < 256) rinfo[tid] = 0xFFFFFFFFu;
    __syncthreads();
    const int lo = 256 * c, hi_ = lo + 256;
    const int qbl = lane & 31;
    int cq = (qbl > j) ? CNT[(bh * 32 + qbl) * 32 + j] : 0;
    int incl = cq;
#pragma unroll
    for (int o_ = 1; o_ < 32; o_ <<= 1) { const int v_ = __shfl_up(incl, o_, 32); if (qbl >= o_) incl += v_; }
    const int start = incl - cq;
    const bool ov = cq > 0 && start < hi_ && start + cq > lo;
    unsigned ovm = (unsigned)__ballot(ov && lane < 32);
    for (int k = 0; ovm != 0u; ++k) {
        const int qb = __builtin_ctz(ovm); ovm &= ovm - 1u;
        if ((k & 7) != wid) continue;
        const int base = __shfl(start, qb);
        const u32x4 w4 = *(const u32x4*)(SEL + (size_t)bh * SEQ + qb * 256 + lane * 4);
        int f[4]; int n = 0;
#pragma unroll
        for (int e = 0; e < 4; ++e) { f[e] = (w4[e] >> j) & 1u; n += f[e]; }
        int inc2 = n;
#pragma unroll
        for (int o_ = 1; o_ < 64; o_ <<= 1) { const int v_ = __shfl_up(inc2, o_); if (lane >= o_) inc2 += v_; }
        int pos = base + inc2 - n;
#pragma unroll
        for (int e = 0; e < 4; ++e) { if (f[e]) { if (pos >= lo && pos < hi_) rinfo[pos - lo] = (unsigned)(qb * 256 + lane * 4 + e) | ((unsigned)__builtin_popcount(w4[e] & ((1u << j) - 1u)) << 16); ++pos; } }
    }
    __syncthreads();
}
__device__ __forceinline__ void moba_combine(Frame& F, bf16* O, const bf16* PO, const float* LSEP) {
    const int gw = F.vcu * NWAVES + F.wave, NGW = F.G * NWAVES, lane = F.lane, h = lane >> 3;
    for (int m = gw; m < T; m += NGW) {
        float l[4], w[4];
#pragma unroll
        for (int s_ = 0; s_ < 4; ++s_) l[s_] = LSEP[((size_t)s_ * T + m) * 8 + h];
        const float mx = fmaxf(fmaxf(l[0], l[1]), fmaxf(l[2], l[3]));
        float ssum = 0.f;
#pragma unroll
        for (int s_ = 0; s_ < 4; ++s_) { w[s_] = __builtin_amdgcn_exp2f(l[s_] - mx); ssum += w[s_]; }
        const float inv = 1.f / ssum;
        float acc[16];
        bf16* op = O + (size_t)m * DM + lane * 16;
        { const bf16x8 a = *(const bf16x8*)op, b = *(const bf16x8*)(op + 8); const float wg = w[3] * inv;
#pragma unroll
          for (int j = 0; j < 8; ++j) { acc[j] = wg * bf2f((unsigned short)a[j]); acc[8 + j] = wg * bf2f((unsigned short)b[j]); } }
#pragma unroll
        for (int s_ = 0; s_ < 3; ++s_) { if (w[s_] > 0.f) { const bf16* p = PO + ((size_t)s_ * T + m) * 1024 + lane * 16;
            const bf16x8 a = *(const bf16x8*)p, b = *(const bf16x8*)(p + 8); const float wg = w[s_] * inv;
#pragma unroll
            for (int j = 0; j < 8; ++j) { acc[j] += wg * bf2f((unsigned short)a[j]); acc[8 + j] += wg * bf2f((unsigned short)b[j]); } } }
        *(bf16x8*)op = att::pack8((f32x4){acc[0], acc[1], acc[2], acc[3]}, (f32x4){acc[4], acc[5], acc[6], acc[7]});
        *(bf16x8*)(op + 8) = att::pack8((f32x4){acc[8], acc[9], acc[10], acc[11]}, (f32x4){acc[12], acc[13], acc[14], acc[15]});
    }
}
__global__ void __launch_bounds__(NWAVES * 64, 2) fwd_kernel(Args args) {
    extern __shared__ __attribute__((aligned(16))) unsigned char lds_raw[];
    Frame F;
    F.lds = (LAS unsigned char*)lds_raw;
    F.tid = threadIdx.x; F.lane = F.tid & 63; F.wave = __builtin_amdgcn_readfirstlane(F.tid >> 6);
    F.G = gridDim.x; { const int bx = blockIdx.x; F.vcu = (F.G % 8 == 0) ? (bx % 8) * (F.G / 8) + bx / 8 : bx; }
    F.ws = args.ws;
    volatile LAS unsigned* MISC = (volatile LAS unsigned*)(F.lds + MISC_OFF);
    for (int u = F.tid; u < (LDS_BYTES - MISC_OFF) / 4; u += NWAVES * 64) ((LAS unsigned*)(F.lds + MISC_OFF))[u] = 0u;
    __syncthreads();
    unsigned* ctl = (unsigned*)(F.ws + WS_CTL);
    XcdBarrier bar = xcd_barrier_post(ctl + CW_BAR, MISC + 8);
    const int lo = args.ph_lo, hi = args.ph_hi;
#ifndef REPMASK
#define REPMASK 0ull
#endif
#define REP(k) ((((REPMASK) >> (k)) & 1ull) ? 2 : 1)
#ifndef ONLY_MODE
#define ONLY_MODE (-1)
#endif
#ifndef PHMASK
#define PHMASK 0xFFFFFFFFull
#endif
#define IN(k) ((((PHMASK) >> (k)) & 1ull) && lo <= (k) && (k) < hi)
#define GRID_BAR() xcd_barrier(bar)

    const float* x = args.in[0]; const float* ln_mix = args.in[1]; const float* ln_mlp = args.in[2]; const float* ln_final = args.in[3];
    const float* e_w_in = args.in[4]; const float* e_g_q = args.in[5]; const float* e_g_kv = args.in[6];
    const float* e_w_uq = args.in[7]; const float* e_w_ukv = args.in[8]; const float* e_w_out = args.in[9];
    const float* o_w_in = args.in[10]; const float* o_w_out = args.in[11]; const float* mlp_w1 = args.in[12]; const float* mlp_w2 = args.in[13];
    float* X = args.out;
    bf16* PROJ = (bf16*)(F.ws + WS_PROJ); bf16* PROJ2 = (bf16*)(F.ws + WS_PROJ2);
    const float* c128 = (const float*)(F.ws + WS_COS128); const float* s128 = (const float*)(F.ws + WS_SIN128);
    const float* c64 = (const float*)(F.ws + WS_COS64); const float* s64 = (const float*)(F.ws + WS_SIN64);

    if (IN(0)) {
        convert_weight(F, e_w_in, DM, EVEN_IN, (bf16*)(F.ws + WS_WIN_E));
        convert_weight(F, e_w_uq, 512, 1536, (bf16*)(F.ws + WS_WUQ));
        convert_weight(F, e_w_ukv, 256, 2048, (bf16*)(F.ws + WS_WUKV));
        convert_weight(F, e_w_out, DM, DM, (bf16*)(F.ws + WS_WOUT_E));
        convert_weight(F, o_w_in, DM, ODD_IN, (bf16*)(F.ws + WS_WIN_O), ln_mix + DM);
        convert_weight(F, o_w_out, DM, DM, (bf16*)(F.ws + WS_WOUT_O));
        { u32x4* z = (u32x4*)((bf16*)(F.ws + WS_WIN_E) + (size_t)5024 * DM); const int n16 = 96 * DM * 2 / 16;
            for (int i = F.vcu * 512 + F.tid; i < n16; i += F.G * 512) z[i] = (u32x4){0u, 0u, 0u, 0u}; }
        rope_tables(F);
        rms_rows(F, x, ln_mix, (bf16*)(F.ws + WS_H0));
        GRID_BAR();
    }
    if (IN(1)) {
        pg8::Gemm g{(const bf16*)(F.ws + WS_H0), (const bf16*)(F.ws + WS_WIN_E), T, EVEN_INP, DM, DM, DM};
        pg8::StaticOrder S; S.init(T, EVEN_INP, F.G, (int)blockIdx.x);
        pg8::EpiBf16<0> E{PROJ, EVEN_INP, nullptr};
        for (int rep = 0; rep < REP(1); ++rep) pg8::gemm_phase(F.lds, g, S, E);
        GRID_BAR();
    }
    if (IN(2)) { post_even(F, e_g_q, e_g_kv); GRID_BAR(); }
    if (IN(3)) {
        for (int rep = 0; rep < REP(3); ++rep)
        for (int it = blockIdx.x; it < 256; it += F.G) { const int b = it >> 7, p = it & 127;
            indexer_unit(F, b, 255 - p); indexer_unit(F, b, p); }
        GRID_BAR();
    }
    if (IN(4)) {
        { pg8::Gemm g{PROJ + EC_CQ, (const bf16*)(F.ws + WS_WUQ), T, 1536, 512, EVEN_INP, 512};
          pg8::StaticOrder S; S.init(T, 1536, F.G, (int)blockIdx.x);
          pg8::EpiBf16<0> E{(bf16*)(F.ws + WS_Q), 1536, nullptr};
          pg8::gemm_phase(F.lds, g, S, E); }
        { pg8::Gemm g{PROJ + EC_CKV, (const bf16*)(F.ws + WS_WUKV), T, 2048, 256, EVEN_INP, 256};
          pg8::StaticOrder S; S.init(T, 2048, F.G, (int)blockIdx.x);
          pg8::EpiBf16<0> E{(bf16*)(F.ws + WS_KV), 2048, nullptr};
          pg8::gemm_phase(F.lds, g, S, E); }
        GRID_BAR();
    }
    if (IN(5)) {
        bf16* O = (bf16*)(F.ws + WS_H0);
        for (int it = blockIdx.x; it < 256; it += F.G) { const int bh = it >> 4, pi = it & 15, b = bh >> 3, h = bh & 7;
            const size_t r0 = (size_t)b * SEQ;
            for (int pass = 0; pass < 2 * REP(20); ++pass) { const int qb = (pass & 1) ? pi : 31 - pi;
                att::UnitArgs U{};
                U.Q = (const bf16*)(F.ws + WS_Q) + r0 * 1536 + h * 192; U.qpitch = 1536;
                U.K = (const bf16*)(F.ws + WS_KV) + r0 * 2048 + h * 256; U.kpitch = 2048;
                U.V = U.K + 128; U.vpitch = 2048;
                U.PE = PROJ + r0 * EVEN_INP + EC_KPE; U.pepitch = EVEN_INP;
                U.O = O + r0 * DM + h * 128; U.opitch = DM;
                U.cosT = c64; U.sinT = s64; U.pos0 = 0; U.posstride = 1; U.P0 = qb * 256;
                if (ONLY_MODE < 0 || ONLY_MODE == 0) att::attn_unit<att::MODE_MLA>((LAS char*)F.lds, U); }
            for (int pass = 0; pass < 2 * REP(21); ++pass) { const int qb = (pass & 1) ? pi : 31 - pi;
                att::UnitArgs U{};
                U.Q = PROJ + r0 * EVEN_INP + EC_Q + h * 128; U.qpitch = EVEN_INP;
                U.K = PROJ + r0 * EVEN_INP + EC_K + h * 128; U.kpitch = EVEN_INP;
                U.V = PROJ + r0 * EVEN_INP + EC_V + h * 128; U.vpitch = EVEN_INP;
                U.O = O + r0 * DM + 1024 + h * 128; U.opitch = DM;
                U.cosT = c128; U.sinT = s128; U.pos0 = 0; U.posstride = 1; U.P0 = qb * 256;
                U.BM = (const unsigned*)(F.ws + WS_BM) + r0 * 256;
                if (ONLY_MODE < 0 || ONLY_MODE == 1) att::attn_unit<att::MODE_DSA>((LAS char*)F.lds, U); }
        }
        GRID_BAR();
    }
    if (IN(6)) {
        pg8::Gemm g{(const bf16*)(F.ws + WS_H0), (const bf16*)(F.ws + WS_WOUT_E), T, DM, DM, DM, DM};
        pg8::StaticOrder S; S.init(T, DM, F.G, (int)blockIdx.x);
        pg8::EpiResF32X<true> E{x, X, (bf16*)(F.ws + WS_XB), (float*)(F.ws + WS_SSQ), DM};
        for (int rep = 0; rep < REP(6); ++rep) pg8::gemm_phase(F.lds, g, S, E);
        GRID_BAR();
    }
#define MLP_PHASES(LAYER) do { \
        if (IN(8)) { for (int rep = 0; rep < REP(8); ++rep) { \
            convert_weight(F, mlp_w1 + (size_t)LAYER * DM * DFF, DM, DFF, (bf16*)(F.ws + WS_W1B), ln_mlp + LAYER * DM); \
            convert_weight(F, mlp_w2 + (size_t)LAYER * DM * DFF, DFF, DM, (bf16*)(F.ws + WS_W2B)); } \
            GRID_BAR(); \
        } \
        if (IN(9)) { \
            pg8::Gemm g{(const bf16*)(F.ws + WS_XB), (const bf16*)(F.ws + WS_W1B), T, DFF, DM, DM, DM}; \
            pg8::StaticOrder S; S.init(T, DFF, F.G, (int)blockIdx.x); \
            pg8::EpiBf16<1, true> E{(bf16*)(F.ws + WS_HID), DFF, (const float*)(F.ws + WS_SSQ)}; \
            for (int rep = 0; rep < REP(9); ++rep) pg8::gemm_phase(F.lds, g, S, E); \
            GRID_BAR(); \
        } \
        if (IN(10)) { \
            pg8::Gemm g{(const bf16*)(F.ws + WS_HID), (const bf16*)(F.ws + WS_W2B), T, DM, DFF, DFF, DFF}; \
            pg8::StaticOrder S; S.init(T, DM, F.G, (int)blockIdx.x); \
            pg8::EpiResF32X<true> E{X, X, (bf16*)(F.ws + WS_XB), (float*)(F.ws + WS_SSQ), DM}; \
            pg8::gemm_phase(F.lds, g, S, E); \
            GRID_BAR(); \
        } \
    } while (0)
    MLP_PHASES(0);
            if (IN(12)) {
                pg8::Gemm g{(const bf16*)(F.ws + WS_XB), (const bf16*)(F.ws + WS_WIN_O), T, ODD_IN, DM, DM, DM};
                pg8::StaticOrder S; S.init(T, ODD_IN, F.G, (int)blockIdx.x);
                pg8::EpiBf16<0, true> E{PROJ2, ODD_IN, (const float*)(F.ws + WS_SSQ)};
                pg8::gemm_phase(F.lds, g, S, E);
                GRID_BAR();
            }
            if (IN(13)) { post_odd(F); GRID_BAR(); }
            if (IN(14)) {
                bf16* O = (bf16*)(F.ws + WS_H1);
                for (int it = blockIdx.x; it < 256; it += F.G) { const int bh = it >> 4, pi = it & 15, b = bh >> 3, h = bh & 7;
                    const size_t r0 = (size_t)b * SEQ;
                    for (int pass = 0; pass < 2 * REP(22); ++pass) { const int qb = (pass & 1) ? pi : 31 - pi;
                        att::UnitArgs U{};
                        U.Q = PROJ2 + r0 * ODD_IN + OC_QC + h * 128; U.qpitch = ODD_IN;
                        U.K = PROJ2 + r0 * ODD_IN + OC_KC + h * 128; U.kpitch = ODD_IN;
                        U.V = PROJ2 + r0 * ODD_IN + OC_VC + h * 128; U.vpitch = ODD_IN;
                        U.O = O + r0 * DM + h * 128; U.opitch = DM;
                        U.cosT = c128; U.sinT = s128; U.pos0 = 0; U.posstride = 1; U.P0 = qb * 256; U.own = qb;
                        U.KMP = (const float*)(F.ws + WS_KM) + (size_t)bh * 32 * 512;
                        U.LSE = (float*)(F.ws + WS_MLSE) + r0 * 8 + h; U.lse_stride = 8; U.lslot = (size_t)T * 8;
                        U.SEL = (unsigned*)(F.ws + WS_SEL) + (size_t)bh * SEQ; U.CNT = (int*)(F.ws + WS_CNT) + (bh * 32 + qb) * 32;
                        if (ONLY_MODE < 0 || ONLY_MODE == 2) att::attn_unit<att::MODE_MOWN>((LAS char*)F.lds, U); }
                    for (int k6 = 0; k6 < 6 * REP(23); ++k6) { const int k = k6 % 6; const int w = k * 16 + pi, gi = w >> 5, u = w & 31;
                        const int d = gi == 0 ? 1 : (gi == 1 ? 4 : 16);
                        const int r = gi == 0 ? 0 : (gi == 1 ? (u >> 3) : (u >> 1)), qb = gi == 0 ? u : (gi == 1 ? (u & 7) : (u & 1));
                        att::UnitArgs U{};
                        const bf16* base = PROJ2 + (r0 + r) * ODD_IN + h * 128;
                        U.Q = base + OC_QD; U.K = base + OC_KD; U.V = base + OC_VD; U.qpitch = U.kpitch = U.vpitch = (size_t)d * ODD_IN;
                        if (gi == 0) { U.O = O + r0 * DM + 1024 + h * 128; U.opitch = DM; }
                        else { U.O = (bf16*)(F.ws + WS_OG) + ((size_t)(gi - 1) * T + r0 + r) * 1024 + h * 128; U.opitch = (size_t)d * 1024; }
                        U.LSE = (float*)(F.ws + WS_LSE) + ((size_t)gi * T + r0 + r) * 8 + h; U.lse_stride = d * 8;
                        U.cosT = c128; U.sinT = s128; U.pos0 = r; U.posstride = d; U.P0 = qb * 256;
                        if (ONLY_MODE < 0 || ONLY_MODE == 3) att::attn_unit<att::MODE_DIL>((LAS char*)F.lds, U); }
                }
                GRID_BAR();
            }
            if (IN(17)) {
                const unsigned* SEL = (const unsigned*)(F.ws + WS_SEL); const int* CNT = (const int*)(F.ws + WS_CNT);
                LAS int* ctab = (LAS int*)(F.lds + 98304);
                LAS unsigned* rinfo = (LAS unsigned*)(F.lds + att::OFF_TL); LAS int* wc = (LAS int*)(F.lds + att::OFF_LB);
                for (int rep = 0; rep < REP(17); ++rep) {
                const int total = moba_chunk_table(F, CNT, ctab);
                for (int id = blockIdx.x; id < total; id += F.G) {
                    int lo_ = 0, hi_ = 496;
                    while (hi_ - lo_ > 1) { const int mid = (lo_ + hi_) >> 1; if (ctab[mid] <= id) lo_ = mid; else hi_ = mid; }
                    const int li = lo_, c = id - ctab[li], bh = li / 31, j = li - bh * 31, b = bh >> 3, h = bh & 7;
                    moba_build_list(F, SEL, CNT, bh, j, c, rinfo, wc);
                    const size_t r0 = (size_t)b * SEQ;
                    att::UnitArgs U{};
                    U.Q = PROJ2 + r0 * ODD_IN + OC_QC + h * 128; U.qpitch = ODD_IN;
                    U.K = PROJ2 + r0 * ODD_IN + OC_KC + h * 128; U.kpitch = ODD_IN;
                    U.V = PROJ2 + r0 * ODD_IN + OC_VC + h * 128; U.vpitch = ODD_IN;
                    U.O = (bf16*)(F.ws + WS_MPO) + r0 * 1024 + h * 128; U.opitch = 1024; U.oslot = (size_t)T * 1024;
                    U.LSE = (float*)(F.ws + WS_MLSE) + r0 * 8 + h; U.lse_stride = 8; U.lslot = (size_t)T * 8;
                    U.cosT = c128; U.sinT = s128; U.pos0 = 0; U.posstride = 1; U.P0 = 0; U.own = j;
                    att::attn_unit<att::MODE_MSEL>((LAS char*)F.lds, U);
                } }
                GRID_BAR();
            }
            if (IN(15)) { dil_combine(F, (bf16*)(F.ws + WS_H1)); moba_combine(F, (bf16*)(F.ws + WS_H1), (const bf16*)(F.ws + WS_MPO), (const float*)(F.ws + WS_MLSE)); GRID_BAR(); }
            if (IN(16)) {
                pg8::Gemm g{(const bf16*)(F.ws + WS_H1), (const bf16*)(F.ws + WS_WOUT_O), T, DM, DM, DM, DM};
                pg8::StaticOrder S; S.init(T, DM, F.G, (int)blockIdx.x);
                pg8::EpiResF32X<true> E{X, X, (bf16*)(F.ws + WS_XB), (float*)(F.ws + WS_SSQ), DM};
                pg8::gemm_phase(F.lds, g, S, E);
                GRID_BAR();
            }
    MLP_PHASES(1);
#undef MLP_PHASES
    if (IN(19)) rms_rows_final(F, X, ln_final);
#undef IN
#undef GRID_BAR
}

extern "C" void kernel_launch(void* const* d_in, const int* in_sizes, int n_in, void* d_out, int out_size, void* d_ws, size_t ws_size, hipStream_t stream) {
    static int grid = 0;
    if (grid == 0) {
        if (n_in != 14 || out_size != T * DM || ws_size < WS_END) { fprintf(stderr, "kernel_launch: unexpected shapes (n_in %d out %d ws %zu)\n", n_in, out_size, ws_size); grid = -1; return; }
        int dev = 0, cus = 0, per_cu = 0;
        if (hipGetDevice(&dev) != hipSuccess || hipDeviceGetAttribute(&cus, hipDeviceAttributeMultiprocessorCount, dev) != hipSuccess) { grid = -1; return; }
        if (hipFuncSetAttribute((const void*)fwd_kernel, hipFuncAttributeMaxDynamicSharedMemorySize, LDS_BYTES) != hipSuccess) { fprintf(stderr, "kernel_launch: hipFuncSetAttribute failed\n"); grid = -1; return; }
        if (hipOccupancyMaxActiveBlocksPerMultiprocessor(&per_cu, (const void*)fwd_kernel, NWAVES * 64, LDS_BYTES) != hipSuccess || per_cu < 1)
            fprintf(stderr, "kernel_launch: occupancy query reports %d\n", per_cu);
        (void)hipGetLastError();
        grid = cus;
    }
    if (grid < 0) return;
    (void)hipMemsetAsync((char*)d_ws + WS_CTL, 0, CTL_ZERO_BYTES, stream);
    Args a{};
    for (int i = 0; i < 14; ++i) a.in[i] = (const float*)d_in[i];
    a.out = (float*)d_out; a.ws = (unsigned char*)d_ws; a.ph_lo = 0; a.ph_hi = 64;
    hipLaunchKernelGGL(fwd_kernel, dim3(grid), dim3(NWAVES * 64), LDS_BYTES, stream, a);
}
```

```cpp
#include <hip/hip_runtime.h>
#include <cstdio>
#include <cstdint>

#define GAS __attribute__((address_space(1)))
#define LAS __attribute__((address_space(3)))
typedef unsigned short bf16;
typedef short bf16x8 __attribute__((ext_vector_type(8)));
typedef short s16x4 __attribute__((ext_vector_type(4)));
typedef float f32x4 __attribute__((ext_vector_type(4)));
typedef float f32x2 __attribute__((ext_vector_type(2)));
typedef float f32x16 __attribute__((ext_vector_type(16)));
typedef unsigned u32x4 __attribute__((ext_vector_type(4)));
typedef unsigned u32x2 __attribute__((ext_vector_type(2)));

constexpr int DM = 2048, BATCH = 2, SEQ = 8192, T = BATCH * SEQ, DFF = 8192;
constexpr int EVEN_IN = 5008, EVEN_INP = 5120, ODD_IN = 6144;
constexpr float NORM_EPS = 1e-6f;
constexpr int EC_CQ = 0, EC_CKV = 512, EC_KPE = 768, EC_Q = 832, EC_K = 1856, EC_V = 2880, EC_QI = 3904, EC_KI = 4928, EC_WI = 4992;
constexpr int OC_QC = 0, OC_KC = 1024, OC_VC = 2048, OC_QD = 3072, OC_KD = 4096, OC_VD = 5120;

constexpr size_t MiB = 1u << 20;
constexpr size_t WS_CTL = 0, CTL_ZERO_BYTES = 32768;
constexpr size_t WS_COS128 = 1 * MiB, WS_SIN128 = 3 * MiB, WS_COS64 = 5 * MiB, WS_SIN64 = 6 * MiB;
constexpr size_t WS_KM = 7 * MiB;
constexpr size_t WS_WOUT_O = 8 * MiB, WS_WIN_E = 16 * MiB, WS_WUQ = 36 * MiB, WS_WUKV = 38 * MiB, WS_WOUT_E = 39 * MiB, WS_WIN_O = 47 * MiB;
constexpr size_t WS_BM = 71 * MiB;
constexpr size_t WS_PROJ = 87 * MiB;
constexpr size_t WS_H0 = 247 * MiB;
constexpr size_t WS_SC = 247 * MiB;
constexpr size_t WS_Q = 311 * MiB, WS_KV = 359 * MiB;
constexpr size_t WS_H2 = 87 * MiB, WS_HID = 151 * MiB, WS_W1B = 407 * MiB, WS_W2B = 439 * MiB;
constexpr size_t WS_XB = 87 * MiB;
constexpr size_t WS_PROJ2 = 151 * MiB;
constexpr size_t WS_H1 = 343 * MiB;
constexpr size_t WS_SSQ = 509 * MiB;
constexpr size_t WS_OG = 16 * MiB;
constexpr size_t WS_MPO = 407 * MiB;
constexpr size_t WS_LSE = 503 * MiB;
constexpr size_t WS_MLSE = 505 * MiB;
constexpr size_t WS_SEL = 507 * MiB;
constexpr size_t WS_CNT = 508 * MiB;
constexpr size_t WS_END = 512 * MiB;
constexpr int CW_TMO = 0, CW_BAR = 4096;

constexpr int RING_BYTES = 131072;
constexpr int MISC_OFF = 147200;
constexpr int LDS_BYTES = 147456;
constexpr int NWAVES = 8;

__device__ __forceinline__ unsigned cvt_pk_bf16(float lo, float hi) { unsigned r; asm volatile("v_cvt_pk_bf16_f32 %0, %1, %2" : "=v"(r) : "v"(lo), "v"(hi)); return r; }
__device__ __forceinline__ float bf2f(unsigned short b) { return __builtin_bit_cast(float, ((unsigned)b) << 16); }
__device__ __forceinline__ float wave_sum(float v) {
#pragma unroll
    for (int o = 1; o < 64; o <<= 1) v += __shfl_xor(v, o);
    return v;
}
#define LDS_WAIT() asm volatile("s_waitcnt lgkmcnt(0)" ::: "memory")
#define VM_WAIT() asm volatile("s_waitcnt vmcnt(0)" ::: "memory")

namespace pg8 {
constexpr int BM = 256, BK = 64, HALF = 128, HTB = HALF * BK * 2, STAGE_BYTES = 8 * HTB, NXCD = 8, WGM = 4;
__host__ __device__ __forceinline__ int lds_byte(int r, int c) { const int st = (r >> 4) * 2 + (c >> 5), rr = r & 15, cc = c & 31, ob = rr * 64 + cc * 2; return st * 1024 + (ob ^ (((ob >> 9) & 1) << 5)); }
__host__ __device__ __forceinline__ void stage_rc(int b, int& R, int& C) { const int st = b / 1024, sb = b % 1024, swz = sb ^ (((sb >> 9) & 1) << 5); R = (st >> 1) * 16 + swz / 64; C = (st & 1) * 32 + (swz % 64) / 2; }
__host__ __device__ __forceinline__ int perm32(int rho) { const int n = rho >> 4, i = rho & 15; return 8 * (i >> 2) + 4 * n + (i & 3); }

struct Unit { int pm, pn; };
struct Gemm { const bf16* A; const bf16* Bt; int M, N, K, lda, ldb; };

struct StaticOrder {
    int nM, nN, nwg, G, c, kvbal;
    __host__ __device__ __forceinline__ void init(int M, int N, int G_, int c_) { nM = M / BM; nN = N / BM; nwg = nM * nN; G = G_; c = c_; kvbal = 0; }
    __host__ __device__ __forceinline__ bool next(int i, Unit& u) const {
        long L = (long)i * G + c;
        if (kvbal) {
            if (c < 128) L = i == 0 ? c : nwg; else L = i < 3 ? 128 + 3 * (c - 128) + i : nwg; }
        if (L >= nwg) return false;
        int wgid = (int)L; { const int q = nwg / NXCD, r = nwg % NXCD, xcd = wgid % NXCD, off = wgid / NXCD; wgid = (xcd < r ? xcd * (q + 1) : r * (q + 1) + (xcd - r) * q) + off; }
        const int nig = WGM * nN, gid = wgid / nig, fm = gid * WGM, gsz = (nM - fm) < WGM ? (nM - fm) : WGM;
        u.pm = fm + ((wgid % nig) % gsz); u.pn = (wgid % nig) / gsz; return true;
    }
};

template <int ACT  , bool SCALED = false> struct EpiBf16 {
    static constexpr bool PERM = true;
    static constexpr bool HAS_PRE = SCALED;
    bf16* O; int ldc; const float* ssq;
    __device__ __forceinline__ void pre_issue(const Unit& u, int wr, int wc, int fr, int fq, f32x4 (&raw)[2][2]) const {
        const int row0 = u.pm * BM + wr * 64 + fr + wc * 16;
#pragma unroll
        for (int ai = 0; ai < 2; ++ai) { const float* sp = ssq + (size_t)(row0 + ai * HALF) * 32 + fq * 8; raw[ai][0] = *(const f32x4*)sp; raw[ai][1] = *(const f32x4*)(sp + 4); }
    }
    __device__ __forceinline__ void pre_finish(const f32x4 (&raw)[2][2], float (&rs)[2]) const {
#pragma unroll
        for (int ai = 0; ai < 2; ++ai) { const f32x4 a = raw[ai][0], b = raw[ai][1];
            float s = ((a[0] + a[1]) + (a[2] + a[3])) + ((b[0] + b[1]) + (b[2] + b[3]));
            s += __shfl_xor(s, 16); s += __shfl_xor(s, 32);
            rs[ai] = __builtin_amdgcn_rsqf(s * (1.f / DM) + NORM_EPS); }
    }
    __device__ __forceinline__ void half(const f32x4 (&acc)[2][2][4][2], const Unit& u, int ai, int wr, int wc, int fr, int fq, const float (&rs)[4]) const {
        const int row0 = u.pm * BM + wr * 64 + fr; const int col0 = u.pn * BM + wc * 32 + 8 * fq;
#pragma unroll
        for (int m = 0; m < 4; ++m) { bf16* rowp = O + (size_t)(row0 + ai * HALF + m * 16) * ldc + col0;
#pragma unroll
            for (int bj = 0; bj < 2; ++bj) { f32x4 v0 = acc[ai][bj][m][0], v1 = acc[ai][bj][m][1];
                if constexpr (SCALED) { v0 = v0 * rs[m]; v1 = v1 * rs[m]; }
                if (ACT == 1) {
#pragma unroll
                    for (int j = 0; j < 4; ++j) { const float a = fmaxf(v0[j], 0.f), b = fmaxf(v1[j], 0.f); v0[j] = a * a; v1[j] = b * b; } }
                u32x4 w; w.x = cvt_pk_bf16(v0[0], v0[1]); w.y = cvt_pk_bf16(v0[2], v0[3]); w.z = cvt_pk_bf16(v1[0], v1[1]); w.w = cvt_pk_bf16(v1[2], v1[3]);
                *(u32x4*)(rowp + bj * HALF) = w; } }
    }
};
struct EpiRopeOdd {
    static constexpr bool PERM = true;
    static constexpr bool HAS_PRE = false;
    bf16* O; int ldc; const float* cosT; const float* sinT; float* KMP; const float* ssq;
    __device__ __forceinline__ void operator()(const f32x4 (&acc)[2][2][4][2], const Unit& u, int wr, int wc, int fr, int fq) const {
        const int row0 = u.pm * BM + wr * 64 + fr; const int col0 = u.pn * BM + wc * 32 + 8 * fq;
        const bool roped = (u.pn < 8) || (u.pn >= 12 && u.pn < 20);
        const bool ksum = (u.pn >= 4 && u.pn < 8);
        float colsum[2][2][8];
#pragma unroll
        for (int ai = 0; ai < 2; ++ai)
#pragma unroll
            for (int bj = 0; bj < 2; ++bj)
#pragma unroll
                for (int e = 0; e < 8; ++e) colsum[ai][bj][e] = 0.f;
        struct Ld { f32x4 a, b, cs[2], sn[2]; };
        Ld L[2];
#define ERO_ISSUE(g_, D_) do { const int row_ = row0 + ((g_) >> 2) * HALF + ((g_) & 3) * 16; const float* sp_ = ssq + (size_t)row_ * 32 + fq * 8; D_.a = *(const f32x4*)sp_; D_.b = *(const f32x4*)(sp_ + 4); \
            if (roped) { const int pos_ = row_ & (SEQ - 1); _Pragma("unroll") for (int bj_ = 0; bj_ < 2; ++bj_) { const int i0_ = ((col0 + bj_ * HALF) & 127) >> 1; \
                D_.cs[bj_] = *(const f32x4*)(cosT + (size_t)pos_ * 64 + i0_); D_.sn[bj_] = *(const f32x4*)(sinT + (size_t)pos_ * 64 + i0_); } } } while (0)
        ERO_ISSUE(0, L[0]);
#pragma unroll
        for (int g8 = 0; g8 < 8; ++g8) { const int ai = g8 >> 2, m = g8 & 3; const int row = row0 + ai * HALF + m * 16; bf16* rowp = O + (size_t)row * ldc + col0;
                if (g8 + 1 < 8) ERO_ISSUE(g8 + 1, L[(g8 + 1) & 1]);
                asm volatile("" ::: "memory");
                const Ld& D = L[g8 & 1];
                float rs;
                { const f32x4 a = D.a, b = D.b;
                  float s = ((a[0] + a[1]) + (a[2] + a[3])) + ((b[0] + b[1]) + (b[2] + b[3])); s += __shfl_xor(s, 16); s += __shfl_xor(s, 32);
                  rs = __builtin_amdgcn_rsqf(s * (1.f / DM) + NORM_EPS); }
#pragma unroll
                for (int bj = 0; bj < 2; ++bj) { f32x4 v0 = acc[ai][bj][m][0] * rs, v1 = acc[ai][bj][m][1] * rs;
                    if (roped) { const f32x4 c = D.cs[bj], s = D.sn[bj];
                        const f32x4 r0 = {v0[0] * c[0] - v0[1] * s[0], v0[0] * s[0] + v0[1] * c[0], v0[2] * c[1] - v0[3] * s[1], v0[2] * s[1] + v0[3] * c[1]};
                        const f32x4 r1 = {v1[0] * c[2] - v1[1] * s[2], v1[0] * s[2] + v1[1] * c[2], v1[2] * c[3] - v1[3] * s[3], v1[2] * s[3] + v1[3] * c[3]};
                        v0 = r0; v1 = r1; }
                    if (ksum) {
#pragma unroll
                        for (int e = 0; e < 4; ++e) { colsum[ai][bj][e] += v0[e]; colsum[ai][bj][4 + e] += v1[e]; } }
                    u32x4 w; w.x = cvt_pk_bf16(v0[0], v0[1]); w.y = cvt_pk_bf16(v0[2], v0[3]); w.z = cvt_pk_bf16(v1[0], v1[1]); w.w = cvt_pk_bf16(v1[2], v1[3]);
                    *(u32x4*)(rowp + bj * HALF) = w; } }
#undef ERO_ISSUE
        if (ksum) {
            const int b = u.pm >> 5, jb = u.pm & 31;
#pragma unroll
            for (int ai = 0; ai < 2; ++ai)
#pragma unroll
                for (int bj = 0; bj < 2; ++bj) {
#pragma unroll
                    for (int e = 0; e < 8; ++e) { float s = colsum[ai][bj][e]; s += __shfl_xor(s, 1); s += __shfl_xor(s, 2); s += __shfl_xor(s, 4); s += __shfl_xor(s, 8); colsum[ai][bj][e] = s; }
                    if (fr == 0) { const int col = col0 + bj * HALF - 1024, hh = col >> 7, d = col & 127;
                        float* kp = KMP + ((((size_t)b * 8 + hh) * 32 + jb) * 4 + (ai * 2 + wr)) * 128 + d;
                        *(f32x4*)kp = (f32x4){colsum[ai][bj][0], colsum[ai][bj][1], colsum[ai][bj][2], colsum[ai][bj][3]};
                        *(f32x4*)(kp + 4) = (f32x4){colsum[ai][bj][4], colsum[ai][bj][5], colsum[ai][bj][6], colsum[ai][bj][7]}; } }
        }
    }
};
struct EpiRopeEven {
    static constexpr bool PERM = true;
    static constexpr bool HAS_PRE = false;
    bf16* O; int ldc; const float* c128; const float* s128; const float* c64; const float* s64; float* ssq;
    __device__ __forceinline__ void operator()(const f32x4 (&acc)[2][2][4][2], const Unit& u, int wr, int wc, int fr, int fq) const {
        const int row0 = u.pm * BM + wr * 64 + fr; const int col0 = u.pn * BM + wc * 32 + 8 * fq;
        int cls[2], i0[2];
#pragma unroll
        for (int bj = 0; bj < 2; ++bj) { const int colw = u.pn * BM + bj * HALF + wc * 32, col = col0 + bj * HALF;
            cls[bj] = (colw >= 832 && colw < 2880) ? 1 : (((colw >= 768 && colw < 832) || (colw >= 3904 && colw < 4992)) ? 2 : 0);
            i0[bj] = cls[bj] == 1 ? (((col - 832) & 127) >> 1) : ((col & 63) >> 1); }
        const bool dossq = u.pn < 3;
        struct Ld { f32x4 c[2], s[2]; };
        Ld L[2];
#define ERE_ISSUE(g_, D_) do { const int pos_ = (row0 + ((g_) >> 2) * HALF + ((g_) & 3) * 16) & (SEQ - 1); _Pragma("unroll") for (int bj_ = 0; bj_ < 2; ++bj_) { \
            if (cls[bj_] == 1) { D_.c[bj_] = *(const f32x4*)(c128 + (size_t)pos_ * 64 + i0[bj_]); D_.s[bj_] = *(const f32x4*)(s128 + (size_t)pos_ * 64 + i0[bj_]); } \
            else if (cls[bj_] == 2) { D_.c[bj_] = *(const f32x4*)(c64 + (size_t)pos_ * 32 + i0[bj_]); D_.s[bj_] = *(const f32x4*)(s64 + (size_t)pos_ * 32 + i0[bj_]); } } } while (0)
        ERE_ISSUE(0, L[0]);
#pragma unroll
        for (int g8 = 0; g8 < 8; ++g8) { const int ai = g8 >> 2, m = g8 & 3; const int row = row0 + ai * HALF + m * 16; bf16* rowp = O + (size_t)row * ldc + col0;
                if (g8 + 1 < 8) ERE_ISSUE(g8 + 1, L[(g8 + 1) & 1]);
                asm volatile("" ::: "memory");
                const Ld& D = L[g8 & 1];
                float ss = 0.f;
#pragma unroll
                for (int bj = 0; bj < 2; ++bj) { f32x4 v0 = acc[ai][bj][m][0], v1 = acc[ai][bj][m][1];
                    if (cls[bj] != 0) { const f32x4 c = D.c[bj], s = D.s[bj];
                        const f32x4 r0 = {v0[0] * c[0] - v0[1] * s[0], v0[0] * s[0] + v0[1] * c[0], v0[2] * c[1] - v0[3] * s[1], v0[2] * s[1] + v0[3] * c[1]};
                        const f32x4 r1 = {v1[0] * c[2] - v1[1] * s[2], v1[0] * s[2] + v1[1] * c[2], v1[2] * c[3] - v1[3] * s[3], v1[2] * s[3] + v1[3] * c[3]};
                        v0 = r0; v1 = r1; }
                    if (dossq) ss += ((v0[0] * v0[0] + v0[1] * v0[1]) + (v0[2] * v0[2] + v0[3] * v0[3])) + ((v1[0] * v1[0] + v1[1] * v1[1]) + (v1[2] * v1[2] + v1[3] * v1[3]));
                    u32x4 w; w.x = cvt_pk_bf16(v0[0], v0[1]); w.y = cvt_pk_bf16(v0[2], v0[3]); w.z = cvt_pk_bf16(v1[0], v1[1]); w.w = cvt_pk_bf16(v1[2], v1[3]);
                    *(u32x4*)(rowp + bj * HALF) = w; }
                if (dossq) { ss += __shfl_xor(ss, 16); ss += __shfl_xor(ss, 32); if (fq == 0) ssq[(size_t)row * 16 + u.pn * 4 + wc] = ss; } }
#undef ERE_ISSUE
    }
};
template <int P0, int NP, int NCOL, bool ROPEQ> struct EpiUp {
    static constexpr bool PERM = true;
    static constexpr bool HAS_PRE = false;
    bf16* O; int ldc; const float* ssq; const float* c64; const float* s64;
    __device__ __forceinline__ void operator()(const f32x4 (&acc)[2][2][4][2], const Unit& u, int wr, int wc, int fr, int fq) const {
        const int row0 = u.pm * BM + wr * 64 + fr; const int col0 = u.pn * BM + wc * 32 + 8 * fq;
        bool rp[2]; int i0[2];
#pragma unroll
        for (int bj = 0; bj < 2; ++bj) { const int colw = u.pn * BM + bj * HALF + wc * 32, col = col0 + bj * HALF; const int o = colw % 192;
            rp[bj] = ROPEQ && o >= 128; i0[bj] = ((col % 192) - 128) >> 1; }
        struct Ld { f32x4 p[NP / 4], c[2], sn[2]; };
        Ld L[2];
#define EUP_ISSUE(g_, D_) do { const int row_ = row0 + ((g_) >> 2) * HALF + ((g_) & 3) * 16; const int pos_ = row_ & (SEQ - 1); \
            _Pragma("unroll") for (int q4_ = 0; q4_ < NP / 4; ++q4_) D_.p[q4_] = *(const f32x4*)(ssq + (size_t)row_ * 16 + P0 + 4 * q4_); \
            _Pragma("unroll") for (int bj_ = 0; bj_ < 2; ++bj_) if (rp[bj_]) { D_.c[bj_] = *(const f32x4*)(c64 + (size_t)pos_ * 32 + i0[bj_]); D_.sn[bj_] = *(const f32x4*)(s64 + (size_t)pos_ * 32 + i0[bj_]); } } while (0)
        EUP_ISSUE(0, L[0]);
#pragma unroll
        for (int g8 = 0; g8 < 8; ++g8) { const int ai = g8 >> 2, m = g8 & 3; const int row = row0 + ai * HALF + m * 16; bf16* rowp = O + (size_t)row * ldc + col0;
                if (g8 + 1 < 8) EUP_ISSUE(g8 + 1, L[(g8 + 1) & 1]);
                asm volatile("" ::: "memory");
                const Ld& D = L[g8 & 1];
                float s = 0.f;
#pragma unroll
                for (int q4 = 0; q4 < NP / 4; ++q4) { const f32x4 a = D.p[q4]; s += (a[0] + a[1]) + (a[2] + a[3]); }
                const float rs = __builtin_amdgcn_rsqf(s * (1.f / NCOL) + NORM_EPS);
#pragma unroll
                for (int bj = 0; bj < 2; ++bj) { f32x4 v0 = acc[ai][bj][m][0] * rs, v1 = acc[ai][bj][m][1] * rs;
                    if (rp[bj]) { const f32x4 c = D.c[bj], sn = D.sn[bj];
                        const f32x4 r0 = {v0[0] * c[0] - v0[1] * sn[0], v0[0] * sn[0] + v0[1] * c[0], v0[2] * c[1] - v0[3] * sn[1], v0[2] * sn[1] + v0[3] * c[1]};
                        const f32x4 r1 = {v1[0] * c[2] - v1[1] * sn[2], v1[0] * sn[2] + v1[1] * c[2], v1[2] * c[3] - v1[3] * sn[3], v1[2] * sn[3] + v1[3] * c[3]};
                        v0 = r0; v1 = r1; }
                    u32x4 w; w.x = cvt_pk_bf16(v0[0], v0[1]); w.y = cvt_pk_bf16(v0[2], v0[3]); w.z = cvt_pk_bf16(v1[0], v1[1]); w.w = cvt_pk_bf16(v1[2], v1[3]);
                    *(u32x4*)(rowp + bj * HALF) = w; } }
#undef EUP_ISSUE
    }
};
struct EpiResF32 {
    static constexpr bool PERM = false;
    static constexpr bool HAS_PRE = false;
    const float* base; float* out; int ldc;
    __device__ __forceinline__ void operator()(const f32x4 (&acc)[2][2][4][2], const Unit& u, int wr, int wc, int fr, int fq) const {
        const int row0 = u.pm * BM + wr * 64 + fr, col0 = u.pn * BM + wc * 32 + 4 * fq;
#pragma unroll
        for (int ai = 0; ai < 2; ++ai)
#pragma unroll
            for (int m = 0; m < 4; ++m) { const size_t off = (size_t)(row0 + ai * HALF + m * 16) * ldc + col0;
                f32x4 bs[2][2];
#pragma unroll
                for (int bj = 0; bj < 2; ++bj)
#pragma unroll
                    for (int n = 0; n < 2; ++n) bs[bj][n] = *(const f32x4*)(base + off + bj * HALF + n * 16);
#pragma unroll
                for (int bj = 0; bj < 2; ++bj)
#pragma unroll
                    for (int n = 0; n < 2; ++n) *(f32x4*)(out + off + bj * HALF + n * 16) = acc[ai][bj][m][n] + bs[bj][n];
                asm volatile("" ::: "memory"); }
    }
};

template <bool XB> struct EpiResF32X {
    static constexpr bool PERM = true;
    static constexpr bool HAS_PRE = false;
    const float* base; float* out; bf16* xb; float* ssq; int ldc;
    __device__ __forceinline__ void operator()(const f32x4 (&acc)[2][2][4][2], const Unit& u, int wr, int wc, int fr, int fq) const {
        const int row0 = u.pm * BM + wr * 64 + fr, col0 = u.pn * BM + wc * 32 + 8 * fq;
        f32x4 vn[2][2];
#define ERX_LOAD(g_) do { const size_t off_ = (size_t)(row0 + ((g_) >> 2) * HALF + ((g_) & 3) * 16) * ldc + col0; \
            _Pragma("unroll") for (int bj = 0; bj < 2; ++bj) _Pragma("unroll") for (int n = 0; n < 2; ++n) vn[bj][n] = *(const f32x4*)(base + off_ + bj * HALF + n * 4); } while (0)
        ERX_LOAD(0);
#pragma unroll
        for (int g = 0; g < 8; ++g) { const int ai = g >> 2, m = g & 3; const int row = row0 + ai * HALF + m * 16; const size_t off = (size_t)row * ldc + col0;
            f32x4 v[2][2];
#pragma unroll
            for (int bj = 0; bj < 2; ++bj)
#pragma unroll
                for (int n = 0; n < 2; ++n) v[bj][n] = vn[bj][n];
            if (g < 7) ERX_LOAD(g + 1);
            asm volatile("" ::: "memory");
            float ss = 0.f;
#pragma unroll
            for (int bj = 0; bj < 2; ++bj) { const f32x4 o0 = acc[ai][bj][m][0] + v[bj][0], o1 = acc[ai][bj][m][1] + v[bj][1];
                *(f32x4*)(out + off + bj * HALF) = o0; *(f32x4*)(out + off + bj * HALF + 4) = o1;
                if constexpr (XB) { u32x4 w; w.x = cvt_pk_bf16(o0[0], o0[1]); w.y = cvt_pk_bf16(o0[2], o0[3]); w.z = cvt_pk_bf16(o1[0], o1[1]); w.w = cvt_pk_bf16(o1[2], o1[3]);
                    *(u32x4*)(xb + off + bj * HALF) = w;
                    ss += ((o0[0] * o0[0] + o0[1] * o0[1]) + (o0[2] * o0[2] + o0[3] * o0[3])) + ((o1[0] * o1[0] + o1[1] * o1[1]) + (o1[2] * o1[2] + o1[3] * o1[3])); } }
            if constexpr (XB) { ss += __shfl_xor(ss, 16); ss += __shfl_xor(ss, 32);
                if (fq == 0) ssq[(size_t)row * 32 + u.pn * 4 + wc] = ss; }
        }
#undef ERX_LOAD
    }
};

template <bool BASE_F32> struct EpiResBf16 {
    static constexpr bool PERM = true;
    static constexpr bool HAS_PRE = false;
    const void* base; bf16* xb; float* ssq; int ldc;
    __device__ __forceinline__ void operator()(const f32x4 (&acc)[2][2][4][2], const Unit& u, int wr, int wc, int fr, int fq) const {
        const int row0 = u.pm * BM + wr * 64 + fr, col0 = u.pn * BM + wc * 32 + 8 * fq;
        f32x4 vn[2][2];
#define ERB_LOAD(g_) do { const size_t off_ = (size_t)(row0 + ((g_) >> 2) * HALF + ((g_) & 3) * 16) * ldc + col0; \
            _Pragma("unroll") for (int bj = 0; bj < 2; ++bj) { \
                if constexpr (BASE_F32) { vn[bj][0] = *(const f32x4*)((const float*)base + off_ + bj * HALF); vn[bj][1] = *(const f32x4*)((const float*)base + off_ + bj * HALF + 4); } \
                else { const u32x4 w_ = *(const u32x4*)((const bf16*)base + off_ + bj * HALF); \
                    vn[bj][0] = (f32x4){__uint_as_float(w_.x << 16), __uint_as_float(w_.x & 0xffff0000u), __uint_as_float(w_.y << 16), __uint_as_float(w_.y & 0xffff0000u)}; \
                    vn[bj][1] = (f32x4){__uint_as_float(w_.z << 16), __uint_as_float(w_.z & 0xffff0000u), __uint_as_float(w_.w << 16), __uint_as_float(w_.w & 0xffff0000u)}; } } } while (0)
        ERB_LOAD(0);
#pragma unroll
        for (int g = 0; g < 8; ++g) { const int ai = g >> 2, m = g & 3; const int row = row0 + ai * HALF + m * 16; const size_t off = (size_t)row * ldc + col0;
            f32x4 v[2][2];
#pragma unroll
            for (int bj = 0; bj < 2; ++bj)
#pragma unroll
                for (int n = 0; n < 2; ++n) v[bj][n] = vn[bj][n];
            if (g < 7) ERB_LOAD(g + 1);
            asm volatile("" ::: "memory");
            float ss = 0.f;
#pragma unroll
            for (int bj = 0; bj < 2; ++bj) { const f32x4 o0 = acc[ai][bj][m][0] + v[bj][0], o1 = acc[ai][bj][m][1] + v[bj][1];
                u32x4 w; w.x = cvt_pk_bf16(o0[0], o0[1]); w.y = cvt_pk_bf16(o0[2], o0[3]); w.z = cvt_pk_bf16(o1[0], o1[1]); w.w = cvt_pk_bf16(o1[2], o1[3]);
                *(u32x4*)(xb + off + bj * HALF) = w;
                ss += ((o0[0] * o0[0] + o0[1] * o0[1]) + (o0[2] * o0[2] + o0[3] * o0[3])) + ((o1[0] * o1[0] + o1[1] * o1[1]) + (o1[2] * o1[2] + o1[3] * o1[3])); }
            ss += __shfl_xor(ss, 16); ss += __shfl_xor(ss, 32);
            if (fq == 0) ssq[(size_t)row * 32 + u.pn * 4 + wc] = ss;
        }
#undef ERB_LOAD
    }
};

template <class Epi>
__device__ __forceinline__ void gemm_phase(LAS unsigned char* lds, const Gemm g, const StaticOrder& S, const Epi& E) {
    const int tid = threadIdx.x, wid = __builtin_amdgcn_readfirstlane(tid >> 6), lane = tid & 63, wr = wid >> 2, wc = wid & 3, fr = lane & 15, fq = lane >> 4;
    const int K = g.K, nt = K / BK;
    unsigned voffA[2], voffB[2];
#pragma unroll
    for (int i = 0; i < 2; ++i) { int R, C; stage_rc(tid * 16 + i * 8192, R, C); const int Rb = Epi::PERM ? ((R & ~31) + perm32(R & 31)) : R;
        voffA[i] = (unsigned)(R * g.lda + C) * 2u; voffB[i] = (unsigned)(Rb * g.ldb + C) * 2u; }
    const size_t kstep = (size_t)(BK * 2);
    const size_t hA = (size_t)HALF * g.lda * 2, hB = (size_t)HALF * g.ldb * 2;
    const size_t tA = 2 * hA, tB = 2 * hB;
    const unsigned ldsw = (unsigned)wid * 1024u;
    const int aoff = lds_byte(wr * 64 + fr, fq * 8), boff = lds_byte(wc * 32 + fr, fq * 8);
#define PG8_SA(b, h) (((b) * 2 + (h)) * HTB)
#define PG8_SB(b, h) ((4 + (b) * 2 + (h)) * HTB)
#define PG8_STAGE(bufoff, gbase, voff) do { _Pragma("unroll") for (int _i = 0; _i < 2; ++_i) \
        __builtin_amdgcn_global_load_lds((const unsigned*)((const char*)(gbase) + (voff)[_i]), (LAS unsigned*)(lds + (bufoff) + ldsw + _i * 8192), 16, 0, 0); } while (0)
#define PG8_LDA(dst, b, h) do { _Pragma("unroll") for (int m = 0; m < 4; ++m) _Pragma("unroll") for (int k = 0; k < 2; ++k) dst[m][k] = *(const LAS bf16x8*)(lds + PG8_SA(b, h) + aoff + m * 2048 + k * 1024); } while (0)
#define PG8_LDB(dst, b, h) do { _Pragma("unroll") for (int n = 0; n < 2; ++n) _Pragma("unroll") for (int k = 0; k < 2; ++k) dst[n][k] = *(const LAS bf16x8*)(lds + PG8_SB(b, h) + boff + n * 2048 + k * 1024); } while (0)
#define PG8_MMA(ai, bj, At, Bt) do { __builtin_amdgcn_s_setprio(1); _Pragma("unroll") for (int m = 0; m < 4; ++m) _Pragma("unroll") for (int n = 0; n < 2; ++n) _Pragma("unroll") for (int k = 0; k < 2; ++k) \
        acc[ai][bj][m][n] = __builtin_amdgcn_mfma_f32_16x16x32_bf16(Bt[n][k], At[m][k], acc[ai][bj][m][n], 0, 0, 0); __builtin_amdgcn_s_setprio(0); } while (0)
#define PG8_WAIT_V(n) asm volatile("s_waitcnt vmcnt(" #n ")" ::: "memory")
#define PG8_WAIT_L(n) asm volatile("s_waitcnt lgkmcnt(" #n ")" ::: "memory")
#define PG8_BAR __builtin_amdgcn_s_barrier()
#define PG8_SCHED __builtin_amdgcn_sched_barrier(0)
    Unit cur, nxt; int ui = 0;
    if (!S.next(0, cur)) return;
    f32x4 acc[2][2][4][2];
#pragma unroll
    for (int a = 0; a < 2; ++a)
#pragma unroll
        for (int b = 0; b < 2; ++b)
#pragma unroll
            for (int m = 0; m < 4; ++m)
#pragma unroll
                for (int n = 0; n < 2; ++n) acc[a][b][m][n] = (f32x4){0.f, 0.f, 0.f, 0.f};
    bf16x8 At[4][2], B0[2][2], B1[2][2];
    LAS float* rsl = (LAS float*)(lds + 131072) + wr * 128 + fr;
#define PG8_RS_PUT(buf_, rs_) do { if (fq == 0) { rsl[(buf_) * 256 + wc * 16] = rs_[0]; rsl[(buf_) * 256 + 64 + wc * 16] = rs_[1]; } } while (0)
#define PG8_RS_GET(buf_, ai_, rs_) do { _Pragma("unroll") for (int m_ = 0; m_ < 4; ++m_) rs_[m_] = rsl[(buf_) * 256 + (ai_) * 64 + m_ * 16]; } while (0)
    if constexpr (Epi::HAS_PRE) { f32x4 raw0[2][2]; float r0[2]; E.pre_issue(cur, wr, wc, fr, fq, raw0); E.pre_finish(raw0, r0); PG8_RS_PUT(0, r0); }
    const char* cA = (const char*)g.A + (size_t)cur.pm * tA; const char* cB = (const char*)g.Bt + (size_t)cur.pn * tB;
    PG8_STAGE(PG8_SB(0, 0), cB, voffB); PG8_STAGE(PG8_SB(0, 1), cB + hB, voffB); PG8_STAGE(PG8_SA(0, 0), cA, voffA); PG8_STAGE(PG8_SA(0, 1), cA + hA, voffA);
    if (wr == 1) PG8_BAR;
    PG8_WAIT_V(2); PG8_BAR;
    PG8_STAGE(PG8_SB(1, 0), cB + kstep, voffB); PG8_STAGE(PG8_SA(1, 0), cA + kstep, voffA); PG8_STAGE(PG8_SB(1, 1), cB + hB + kstep, voffB);
    PG8_WAIT_V(6); PG8_BAR;
    for (;;) {
        const bool has_next = S.next(ui + 1, nxt);
        const char* nA = has_next ? (const char*)g.A + (size_t)nxt.pm * tA : cA; const char* nB = has_next ? (const char*)g.Bt + (size_t)nxt.pn * tB : cB;
        for (int t = 0; t < nt; t += 2) {
            const bool last = (t == nt - 2);
            const char* a1 = cA + (size_t)(t + 1) * kstep;
            const char* a2 = last ? nA : cA + (size_t)(t + 2) * kstep; const char* b2 = last ? nB : cB + (size_t)(t + 2) * kstep;
            const char* a3 = a2 + kstep; const char* b3 = b2 + kstep;
            PG8_LDB(B0, 0, 0); PG8_LDB(B1, 0, 1); PG8_SCHED; PG8_LDA(At, 0, 0); PG8_STAGE(PG8_SA(1, 1), a1 + hA, voffA);
            PG8_WAIT_V(8); PG8_WAIT_L(0); PG8_BAR; PG8_MMA(0, 0, At, B0); PG8_MMA(0, 1, At, B1); PG8_BAR; PG8_SCHED;
            PG8_LDA(At, 0, 1); PG8_STAGE(PG8_SB(0, 0), b2, voffB); PG8_STAGE(PG8_SB(0, 1), b2 + hB, voffB); PG8_STAGE(PG8_SA(0, 0), a2, voffA);
            PG8_WAIT_V(8); PG8_WAIT_L(0); PG8_BAR; PG8_MMA(1, 0, At, B0); PG8_MMA(1, 1, At, B1); PG8_BAR; PG8_SCHED;
            PG8_LDB(B0, 1, 0); PG8_LDB(B1, 1, 1); PG8_SCHED; PG8_LDA(At, 1, 0); PG8_STAGE(PG8_SA(0, 1), a2 + hA, voffA);
            PG8_WAIT_V(8); PG8_WAIT_L(0); PG8_BAR; PG8_MMA(0, 0, At, B0); PG8_MMA(0, 1, At, B1); PG8_BAR; PG8_SCHED;
            PG8_LDA(At, 1, 1); PG8_STAGE(PG8_SB(1, 0), b3, voffB); PG8_STAGE(PG8_SB(1, 1), b3 + hB, voffB); PG8_STAGE(PG8_SA(1, 0), a3, voffA);
            PG8_WAIT_V(8); PG8_WAIT_L(0); PG8_BAR; PG8_MMA(1, 0, At, B0); PG8_MMA(1, 1, At, B1); PG8_BAR; PG8_SCHED;
        }
        if (wr == 0) PG8_BAR;
        if constexpr (Epi::HAS_PRE) { f32x4 raw[2][2]; float rc[4], rn[2]; const int buf = ui & 1;
            if (has_next) E.pre_issue(nxt, wr, wc, fr, fq, raw);
            PG8_RS_GET(buf, 0, rc); PG8_SCHED; E.half(acc, cur, 0, wr, wc, fr, fq, rc); PG8_SCHED;
            PG8_RS_GET(buf, 1, rc); PG8_SCHED; E.half(acc, cur, 1, wr, wc, fr, fq, rc); PG8_SCHED;
            if (has_next) { E.pre_finish(raw, rn); PG8_RS_PUT(buf ^ 1, rn); } }
        else E(acc, cur, wr, wc, fr, fq);
        if (!has_next) break;
#pragma unroll
        for (int a = 0; a < 2; ++a)
#pragma unroll
            for (int b = 0; b < 2; ++b)
#pragma unroll
                for (int m = 0; m < 4; ++m)
#pragma unroll
                    for (int n = 0; n < 2; ++n) acc[a][b][m][n] = (f32x4){0.f, 0.f, 0.f, 0.f};
        cur = nxt; cA = nA; cB = nB; ++ui;
        if (wr == 1) PG8_BAR;
    }
    PG8_WAIT_V(0);
    PG8_BAR;
#undef PG8_SA
#undef PG8_SB
#undef PG8_STAGE
#undef PG8_LDA
#undef PG8_LDB
#undef PG8_MMA
#undef PG8_WAIT_V
#undef PG8_WAIT_L
#undef PG8_BAR
#undef PG8_SCHED
#undef PG8_RS_PUT
#undef PG8_RS_GET
}
}

#define XB_TMO      128
#define XB_XCNT(j)  (256  + 64 * (j))
#define XB_XSUB(j)  (1280 + 64 * (j))
#define XB_XGEN(j)  (2304 + 64 * (j))
#define XB_TOP      3328
#define XB_TOPGEN   3392
#define XCD_BAR_WORDS 3456
#define XB_SPIN_CAP (1u << 18)

__device__ __forceinline__ unsigned xb_ld(unsigned* p)              { return __hip_atomic_load(p, __ATOMIC_RELAXED, __HIP_MEMORY_SCOPE_AGENT); }
__device__ __forceinline__ unsigned xb_add(unsigned* p, unsigned v) { return __hip_atomic_fetch_add(p, v, __ATOMIC_RELAXED, __HIP_MEMORY_SCOPE_AGENT); }
__device__ __forceinline__ unsigned xb_xcc_id() { return (unsigned)__builtin_amdgcn_s_getreg((3 << 11) | 20) & 0xFu; }
#define XB_SPIN(cond, bar) do { unsigned _sp = 0; while (cond) { __builtin_amdgcn_s_sleep(1); \
    if ((++_sp & 255u) == 0u) { if (xb_ld(&(bar)[XB_TMO])) break; if (_sp > XB_SPIN_CAP) { atomicAdd(&(bar)[XB_TMO], 1u); break; } } } } while (0)

struct XcdBarrier { unsigned* bar; unsigned x; volatile LAS unsigned* st; };

__device__ __forceinline__ XcdBarrier xcd_barrier_post(unsigned* bar, volatile LAS unsigned* st) {
    XcdBarrier b; b.bar = bar; b.x = xb_xcc_id(); b.st = st;
    if (threadIdx.x == 0) (void)xb_add(&bar[XB_XCNT(b.x)], 1u);
    return b;
}
__device__ __forceinline__ void xcd_barrier_complete(unsigned* bar, unsigned x, unsigned& nloc, unsigned& nx) {
    const unsigned G = gridDim.x * gridDim.y * gridDim.z;
    unsigned sum, cnt, mine, sp = 0u;
    for (;;) {
        sum = 0u; cnt = 0u; mine = 0u;
#pragma unroll
        for (unsigned j = 0; j < 16; ++j) { const unsigned c = xb_ld(&bar[XB_XCNT(j)]); sum += c; cnt += (c > 0u) ? 1u : 0u; mine = (j == x) ? c : mine; }
        if (sum == G) break;
        __builtin_amdgcn_s_sleep(1);
        if ((++sp & 255u) == 0u) { if (xb_ld(&bar[XB_TMO])) break; if (sp > XB_SPIN_CAP) { atomicAdd(&bar[XB_TMO], 1u); break; } }
    }
    nloc = mine > 0u ? mine : 1u; nx = cnt > 0u ? cnt : 1u;
}
__device__ __forceinline__ void xcd_barrier(const XcdBarrier& b) {
    asm volatile("s_waitcnt vmcnt(0)" ::: "memory");
    __syncthreads();
    if (threadIdx.x == 0) {
        unsigned* bar = b.bar;
        __builtin_amdgcn_s_waitcnt(0);
        unsigned nloc = b.st[0], nx = b.st[1];
        if (nloc == 0u) { xcd_barrier_complete(bar, b.x, nloc, nx); b.st[0] = nloc; b.st[1] = nx; }
        const unsigned old = xb_add(&bar[XB_XSUB(b.x)], 1u);
        const unsigned gen = old / nloc;
        if (old + 1u == (gen + 1u) * nloc) {
            __builtin_amdgcn_fence(__ATOMIC_RELEASE, "agent");
            asm volatile("s_waitcnt vmcnt(0)" ::: "memory");
            const unsigned og = xb_add(&bar[XB_TOP], 1u);
            const unsigned tg = og / nx;
            if (og + 1u == (tg + 1u) * nx) xb_add(&bar[XB_TOPGEN], 1u);
            else XB_SPIN(xb_ld(&bar[XB_TOPGEN]) == tg, bar);
            __builtin_amdgcn_fence(__ATOMIC_ACQUIRE, "agent");
            xb_add(&bar[XB_XGEN(b.x)], 1u);
            asm volatile("s_waitcnt vmcnt(0)" ::: "memory");
        } else {
            XB_SPIN(xb_ld(&bar[XB_XGEN(b.x)]) == gen, bar);
            __builtin_amdgcn_fence(__ATOMIC_ACQUIRE, "agent");
            asm volatile("s_waitcnt vmcnt(0)" ::: "memory");
        }
    }
    __syncthreads();
}

struct Args { const float* in[14]; float* out; unsigned char* ws; int ph_lo, ph_hi; };
struct Frame {
    LAS unsigned char* lds;
    int tid, lane, wave, vcu, G;
    unsigned char* ws;
};

__device__ __forceinline__ int rope_colmap(int kind, int n) {
    if (kind == 1) { if (n < 2048 || (n >= 3072 && n < 5120)) { const int o = n & 127; return n - o + 2 * (o & 63) + (o >> 6); } return n; }
    if (kind == 2) {
        if (n >= 832 && n < 2880) { const int o = (n - 832) & 127; return n - o + 2 * (o & 63) + (o >> 6); }
        if ((n >= 768 && n < 832) || (n >= 3904 && n < 4992)) { const int o = n & 63; return n - o + 2 * (o & 31) + (o >> 5); }
        return n; }
    if (kind == 3) { const int o = n % 192; if (o >= 128) { const int p = o - 128; return n - p + 2 * (p & 31) + (p >> 5); } return n; }
    return n;
}
__device__ __forceinline__ void tr_load(const float* W, int K, int N, int item, int lane, const float* gain, float (&v)[32], f32x4& g0, f32x4& g1) {
    const int nblk = (N + 31) / 32, kb = item / nblk, nb = item % nblk, k0 = 64 * kb, n0 = 32 * nb;
    const int nn = n0 + (lane & 31);
    const float* wp = W + (size_t)(k0 + (lane >> 5)) * N + (nn < N ? nn : N - 1);
#pragma unroll
    for (int i = 0; i < 32; ++i) v[i] = wp[(size_t)(2 * i) * N];
    if (gain) { const f32x4* gp = (const f32x4*)(gain + k0 + 8 * (lane & 7)); g0 = gp[0]; g1 = gp[1]; }
    else { g0 = (f32x4){1.f, 1.f, 1.f, 1.f}; g1 = g0; }
}
__device__ __forceinline__ void tr_store(int K, int N, bf16* WT, LAS float* scr, int item, int lane, const float (&v)[32], const f32x4 g0, const f32x4 g1, int permkind) {
    const int nblk = (N + 31) / 32, kb = item / nblk, nb = item % nblk, k0 = 64 * kb, n0 = 32 * nb;
    const int nn = n0 + (lane & 31);
#pragma unroll
    for (int i = 0; i < 32; ++i) { const int kk = 2 * i + (lane >> 5); scr[kk * 33 + (lane & 31)] = (nn < N) ? v[i] : 0.f; }
    LDS_WAIT(); asm volatile("" ::: "memory");
    const int c = lane & 7;
#pragma unroll
    for (int j = 0; j < 4; ++j) { const int n = (lane >> 3) + 8 * j; const LAS float* s = scr + (8 * c) * 33 + n;
        u32x4 o; o.x = cvt_pk_bf16(s[0 * 33] * g0.x, s[1 * 33] * g0.y); o.y = cvt_pk_bf16(s[2 * 33] * g0.z, s[3 * 33] * g0.w);
        o.z = cvt_pk_bf16(s[4 * 33] * g1.x, s[5 * 33] * g1.y); o.w = cvt_pk_bf16(s[6 * 33] * g1.z, s[7 * 33] * g1.w);
        *(u32x4*)(WT + (size_t)rope_colmap(permkind, n0 + n) * K + k0 + 8 * c) = o; }
    LDS_WAIT(); asm volatile("" ::: "memory");
}
__device__ __forceinline__ void convert_weight(Frame& F, const float* W, int K, int N, bf16* WT, const float* gain = nullptr, int permkind = 0, int* rot = nullptr) {
    LAS float* scr = (LAS float*)(F.lds + F.wave * 16384);
    const int NGW = F.G * NWAVES; int gw = F.vcu * NWAVES + F.wave;
    const int nitems = (K / 64) * ((N + 31) / 32);
    if (rot) { gw -= *rot; if (gw < 0) gw += NGW; *rot = (*rot + nitems) % NGW; }
    float v[32]; f32x4 g0, g1;
    int it = gw;
    if (it < nitems) tr_load(W, K, N, it, F.lane, gain, v, g0, g1);
    for (; it < nitems; it += NGW) {
        float vn[32]; f32x4 gn0 = g0, gn1 = g1; const int itn = it + NGW;
        if (itn < nitems) tr_load(W, K, N, itn, F.lane, gain, vn, gn0, gn1);
        else {
#pragma unroll
            for (int i = 0; i < 32; ++i) vn[i] = 0.f; }
        tr_store(K, N, WT, scr, it, F.lane, v, g0, g1, permkind);
#pragma unroll
        for (int i = 0; i < 32; ++i) v[i] = vn[i];
        g0 = gn0; g1 = gn1;
    }
}
__device__ __forceinline__ void rms_row_to_bf16(const float* xrow, const float* g, bf16* orow, int lane) {
    const f32x4* xr = (const f32x4*)xrow + lane; const f32x4* gr = (const f32x4*)g + lane;
    f32x4 v[8]; float s = 0.f;
#pragma unroll
    for (int j = 0; j < 8; ++j) { v[j] = xr[64 * j]; s += (v[j].x * v[j].x + v[j].y * v[j].y) + (v[j].z * v[j].z + v[j].w * v[j].w); }
    const float rs = 1.0f / sqrtf(wave_sum(s) * (1.f / DM) + NORM_EPS);
    u32x2* o8 = (u32x2*)orow + lane;
#pragma unroll
    for (int j = 0; j < 8; ++j) { const f32x4 gg = gr[64 * j]; u32x2 w; w.x = cvt_pk_bf16(v[j].x * rs * gg.x, v[j].y * rs * gg.y); w.y = cvt_pk_bf16(v[j].z * rs * gg.z, v[j].w * rs * gg.w); o8[64 * j] = w; }
}
__device__ __forceinline__ void rms_rows(Frame& F, const float* X, const float* g, bf16* H) {
    const int gw = F.vcu * NWAVES + F.wave, NGW = F.G * NWAVES;
    for (int m = gw; m < T; m += NGW) rms_row_to_bf16(X + (size_t)m * DM, g, H + (size_t)m * DM, F.lane);
}
__device__ __forceinline__ void rms_rows_final(Frame& F, const bf16* XB, const float* ssq, float* out, const float* g, float oscale = 1.f) {
    const int gw = F.vcu * NWAVES + F.wave, NGW = F.G * NWAVES;
    const f32x4* gr = (const f32x4*)g;
    for (int m = gw; m < T; m += 2 * NGW) {
        const int m1 = m + NGW; const bool two = m1 < T; const int mb = two ? m1 : m;
        const float sva = (F.lane < 32) ? ssq[(size_t)m * 32 + F.lane] : 0.f;
        const float svb = (F.lane < 32) ? ssq[(size_t)mb * 32 + F.lane] : 0.f;
        const u32x4* xa = (const u32x4*)(XB + (size_t)m * DM) + F.lane; const u32x4* xb = (const u32x4*)(XB + (size_t)mb * DM) + F.lane;
        u32x4 wa[4], wb[4];
#pragma unroll
        for (int j = 0; j < 4; ++j) { wa[j] = xa[64 * j]; wb[j] = xb[64 * j]; }
        const float rsa = (1.0f / sqrtf(wave_sum(sva) * (1.f / DM) + NORM_EPS)) * oscale;
        const float rsb = (1.0f / sqrtf(wave_sum(svb) * (1.f / DM) + NORM_EPS)) * oscale;
        f32x4* oa = (f32x4*)(out + (size_t)m * DM); f32x4* ob = (f32x4*)(out + (size_t)mb * DM);
#pragma unroll
        for (int j = 0; j < 4; ++j) { const int c4 = (F.lane + 64 * j) * 2;
            const f32x4 g0 = gr[c4], g1 = gr[c4 + 1];
            { const u32x4 w = wa[j];
              const f32x4 a = {__uint_as_float(w.x << 16), __uint_as_float(w.x & 0xffff0000u), __uint_as_float(w.y << 16), __uint_as_float(w.y & 0xffff0000u)};
              const f32x4 b = {__uint_as_float(w.z << 16), __uint_as_float(w.z & 0xffff0000u), __uint_as_float(w.w << 16), __uint_as_float(w.w & 0xffff0000u)};
              oa[c4] = a * rsa * g0; oa[c4 + 1] = b * rsa * g1; }
            if (two) { const u32x4 w = wb[j];
              const f32x4 a = {__uint_as_float(w.x << 16), __uint_as_float(w.x & 0xffff0000u), __uint_as_float(w.y << 16), __uint_as_float(w.y & 0xffff0000u)};
              const f32x4 b = {__uint_as_float(w.z << 16), __uint_as_float(w.z & 0xffff0000u), __uint_as_float(w.w << 16), __uint_as_float(w.w & 0xffff0000u)};
              ob[c4] = a * rsb * g0; ob[c4 + 1] = b * rsb * g1; } }
    }
}
__device__ __forceinline__ void rope_tables(Frame& F) {
    float* c128 = (float*)(F.ws + WS_COS128); float* s128 = (float*)(F.ws + WS_SIN128);
    float* c64 = (float*)(F.ws + WS_COS64); float* s64 = (float*)(F.ws + WS_SIN64);
    const int gt = F.vcu * 512 + F.tid, NT_ = F.G * 512;
    for (int e = gt; e < SEQ * 64 + SEQ * 32; e += NT_) {
        int pos, i, dim; float* cp; float* sp;
        if (e < SEQ * 64) { pos = e >> 6; i = e & 63; dim = 128; cp = c128 + e; sp = s128 + e; }
        else { const int e2 = e - SEQ * 64; pos = e2 >> 5; i = e2 & 31; dim = 64; cp = c64 + e2; sp = s64 + e2; }
        const float ex = (float)(2 * i) / (float)dim;
        const float inv = (float)exp(-(double)ex * 9.210340371976184);
        const float ang = (float)pos * inv;
        const double rev = (double)ang * 0.15915494309189535;
        const double fr = rev - rint(rev);
        const float a = (float)(fr * 6.283185307179586);
        *cp = __cosf(a); *sp = __sinf(a);
    }
}

namespace att {
constexpr int SHM_V = 64 * 128 * 2, SHM_K = 64 * 128 * 2, SHM_PE = 64 * 64 * 2;
constexpr int OFF_V = 0, OFF_K = 2 * SHM_V, OFF_PE = OFF_K + 2 * SHM_K, OFF_WS = OFF_PE + 2 * SHM_PE;
constexpr int OFF_TL = OFF_WS + 2048;
constexpr int OFF_KM = 90112;
constexpr int OFF_LB = OFF_TL + 1024;
constexpr int OFF_QPE = 98304;
enum { MODE_MLA = 0, MODE_DSA = 1, MODE_MOWN = 2, MODE_DIL = 3, MODE_MSEL = 4 };
constexpr float THR = 8.f;

#define KSWZ(row, colB) ((row) * 256 + ((colB) ^ (((row) & 7) << 4)))
#define SBAR() __builtin_amdgcn_sched_barrier(0)
__device__ __forceinline__ int v_st(int k, int c) { const int kk = (k & ~0xC) | ((k & 4) << 1) | ((k & 8) >> 1); return ((kk >> 3) * 4 + (c >> 5)) * 512 + ((kk & 7) * 32 + (c & 31)) * 2; }
__device__ __forceinline__ int v_rd_base(int lane) { return ((lane & 3) << 3) | (((lane >> 2) & 3) << 6) | (((lane >> 4) & 1) << 5) | (((lane >> 5) & 1) << 8); }
constexpr int v_rd_off(int d0, int ks, int half) { return d0 * 512 + ks * 4096 + half * 2048; }
__device__ __forceinline__ int crow(int r, int hi) { return (r & 3) + 8 * (r >> 2) + 4 * hi; }
__device__ __forceinline__ bf16x8 pack8(f32x4 a, f32x4 b) {
    u32x4 w = {cvt_pk_bf16(a[0], a[1]), cvt_pk_bf16(a[2], a[3]), cvt_pk_bf16(b[0], b[1]), cvt_pk_bf16(b[2], b[3])};
    return *reinterpret_cast<bf16x8*>(&w);
}
__device__ __forceinline__ void rope_pair(bf16x8& a, bf16x8& b, const float* cs, const float* sn, float scale = 1.0f) {
    const f32x4 c0 = *(const f32x4*)cs * scale, c1 = *(const f32x4*)(cs + 4) * scale, s0 = *(const f32x4*)sn * scale, s1 = *(const f32x4*)(sn + 4) * scale;
    f32x4 y1a, y1b, y2a, y2b;
#pragma unroll
    for (int j = 0; j < 4; ++j) {
        const float x1 = bf2f((unsigned short)a[j]), x2 = bf2f((unsigned short)b[j]);
        y1a[j] = x1 * c0[j] - x2 * s0[j]; y2a[j] = x1 * s0[j] + x2 * c0[j];
        const float z1 = bf2f((unsigned short)a[4 + j]), z2 = bf2f((unsigned short)b[4 + j]);
        y1b[j] = z1 * c1[j] - z2 * s1[j]; y2b[j] = z1 * s1[j] + z2 * c1[j];
    }
    a = pack8(y1a, y1b); b = pack8(y2a, y2b);
}
__device__ __forceinline__ void mask_tile(f32x16& p0, f32x16& p1, int dq, unsigned W) {
    const float NEG = -__builtin_inff();
#pragma unroll
    for (int r = 0; r < 16; ++r) {
        const int c = (r & 3) + 8 * (r >> 2);
        if ((unsigned)(dq - c) >= W) p0[r] = NEG;
        if ((unsigned)(dq - c - 32) >= W) p1[r] = NEG;
    }
}
__device__ __forceinline__ void mask_bits(f32x16& p0, f32x16& p1, unsigned w0s, unsigned w1s) {
    const float NEG = -__builtin_inff();
#pragma unroll
    for (int r = 0; r < 16; ++r) {
        const int c = (r & 3) + 8 * (r >> 2);
        if (!((w0s >> c) & 1u)) p0[r] = NEG;
        if (!((w1s >> c) & 1u)) p1[r] = NEG;
    }
}
template <int MODE>
__device__ __forceinline__ void partialSM(f32x16& p0, f32x16& p1, float& m_reg, float& mn, float& alpha) {
    constexpr float SCALE = (MODE == MODE_MLA) ? 0.07216878364870322f : 0.08838834764831845f;
    float pmax = p0[0];
#pragma unroll
    for (int r = 1; r < 16; ++r) pmax = fmaxf(pmax, p0[r]);
#pragma unroll
    for (int r = 0; r < 16; ++r) pmax = fmaxf(pmax, p1[r]);
    { auto rr = __builtin_amdgcn_permlane32_swap(__float_as_uint(pmax), __float_as_uint(pmax), false, false);
      pmax = fmaxf(__uint_as_float(rr[0]), __uint_as_float(rr[1])); }
    constexpr float C2 = 1.4426950408889634f * SCALE;
    if (__builtin_expect(__all((pmax - m_reg) * SCALE <= THR), 1)) { mn = m_reg; alpha = 1.f; }
    else { mn = fmaxf(m_reg, pmax); alpha = __builtin_amdgcn_exp2f((m_reg - mn) * C2); m_reg = mn; }
    const float mnL = -mn * C2;
#pragma unroll
    for (int r = 0; r < 16; ++r) p0[r] = fmaf(p0[r], C2, mnL);
#pragma unroll
    for (int r = 0; r < 16; ++r) p1[r] = fmaf(p1[r], C2, mnL);
#pragma unroll
    for (int r = 0; r < 16; ++r) p0[r] = __builtin_amdgcn_exp2f(p0[r]);
}
template <bool BITS>
__device__ __forceinline__ void finishSM(f32x16& p0, f32x16& p1, float alpha, float& l_reg, bf16x8& pa0, bf16x8& pa1, bf16x8& pa2, bf16x8& pa3, unsigned w0s, unsigned w1s) {
#pragma unroll
    for (int r = 0; r < 16; ++r) p1[r] = __builtin_amdgcn_exp2f(p1[r]);
    if constexpr (BITS) {
#pragma unroll
        for (int r = 0; r < 16; ++r) { const int c = (r & 3) + 8 * (r >> 2);
            p0[r] = __uint_as_float(__float_as_uint(p0[r]) & (unsigned)__builtin_amdgcn_sbfe((int)w0s, c, 1));
            p1[r] = __uint_as_float(__float_as_uint(p1[r]) & (unsigned)__builtin_amdgcn_sbfe((int)w1s, c, 1)); } }
    float ps = 0;
#pragma unroll
    for (int r = 0; r < 16; ++r) ps += p0[r];
#pragma unroll
    for (int r = 0; r < 16; ++r) ps += p1[r];
    { auto rr = __builtin_amdgcn_permlane32_swap(__float_as_uint(ps), __float_as_uint(ps), false, false);
      ps = __uint_as_float(rr[0]) + __uint_as_float(rr[1]); }
    l_reg = l_reg * alpha + ps;
#define PK4(P, B_, OUT) do { unsigned a0 = cvt_pk_bf16(P[B_+0], P[B_+1]), a1 = cvt_pk_bf16(P[B_+2], P[B_+3]);                          \
        unsigned b0 = cvt_pk_bf16(P[B_+4], P[B_+5]), b1 = cvt_pk_bf16(P[B_+6], P[B_+7]);                                             \
        auto r0 = __builtin_amdgcn_permlane32_swap(a0, b0, false, false); auto r1 = __builtin_amdgcn_permlane32_swap(a1, b1, false, false); \
        u32x4 w = {r0[0], r1[0], r0[1], r1[1]}; OUT = *reinterpret_cast<bf16x8*>(&w); } while (0)
    PK4(p0, 0, pa0); PK4(p0, 8, pa1); PK4(p1, 0, pa2); PK4(p1, 8, pa3);
#undef PK4
}
template <int KB>
__device__ __forceinline__ void qkt(f32x16& p0, f32x16& p1, LAS const char* K_lds, int r32, int hi, const bf16x8* qr) {
    p0 = f32x16{}; p1 = f32x16{};
    int kb[4];
#pragma unroll
    for (int dd = 0; dd < 4; ++dd) kb[dd] = (int)(unsigned)(uintptr_t)K_lds + KSWZ(r32, (dd * 16 + hi * 8) * 2);
#define KRD(dst, av, off) asm volatile("ds_read_b128 %0, %1 offset:%2" : "=&v"(dst) : "v"(av), "n"(off) : "memory")
#define QKT_LD(X0, X1, d0_) do { KRD(X0, kb[(d0_) & 3], KB * SHM_K + ((d0_) >> 2) * 128); KRD(X1, kb[(d0_) & 3], KB * SHM_K + ((d0_) >> 2) * 128 + 32 * 256); } while (0)
#define QKT_W(n_) do { asm volatile("s_waitcnt lgkmcnt(" #n_ ")" ::: "memory"); SBAR(); } while (0)
#define QKT_MM(X0, X1, d0_) do { p0 = __builtin_amdgcn_mfma_f32_32x32x16_bf16(X0, qr[d0_], p0, 0, 0, 0); p1 = __builtin_amdgcn_mfma_f32_32x32x16_bf16(X1, qr[d0_], p1, 0, 0, 0); SBAR(); } while (0)
    bf16x8 a0, a1, b0, b1, c0, c1;
    QKT_LD(a0, a1, 0); QKT_LD(b0, b1, 1);
    QKT_LD(c0, c1, 2); QKT_W(4); QKT_MM(a0, a1, 0);
    QKT_LD(a0, a1, 3); QKT_W(4); QKT_MM(b0, b1, 1);
    QKT_LD(b0, b1, 4); QKT_W(4); QKT_MM(c0, c1, 2);
    QKT_LD(c0, c1, 5); QKT_W(4); QKT_MM(a0, a1, 3);
    QKT_LD(a0, a1, 6); QKT_W(4); QKT_MM(b0, b1, 4);
    QKT_LD(b0, b1, 7); QKT_W(4); QKT_MM(c0, c1, 5);
    QKT_W(2); QKT_MM(a0, a1, 6);
    QKT_W(0); QKT_MM(b0, b1, 7);
#undef QKT_LD
#undef QKT_MM
#undef QKT_W
#undef KRD
}
template <int KB>
__device__ __forceinline__ void qkt_pe(f32x16& p0, f32x16& p1, LAS const char* PE_lds, int r32, int hi, const bf16x8* qr  ) {
#pragma unroll
    for (int dd = 0; dd < 4; ++dd) { LAS const char* a = PE_lds + KB * SHM_PE + r32 * 128 + ((dd * 32 + hi * 16) ^ ((r32 & 7) << 4));
        bf16x8 b0 = *reinterpret_cast<LAS const bf16x8*>(a);
        bf16x8 b1 = *reinterpret_cast<LAS const bf16x8*>(a + 32 * 128);
        p0 = __builtin_amdgcn_mfma_f32_32x32x16_bf16(b0, qr[dd], p0, 0, 0, 0);
        p1 = __builtin_amdgcn_mfma_f32_32x32x16_bf16(b1, qr[dd], p1, 0, 0, 0); }
}
template <int KB>
__device__ __forceinline__ void qkt_pe_lq(f32x16& p0, f32x16& p1, LAS const char* PE_lds, int r32, int hi, LAS const char* qpe  ) {
#pragma unroll
    for (int dd = 0; dd < 4; ++dd) { LAS const char* a = PE_lds + KB * SHM_PE + r32 * 128 + ((dd * 32 + hi * 16) ^ ((r32 & 7) << 4));
        const bf16x8 q = *reinterpret_cast<LAS const bf16x8*>(qpe + dd * 1024);
        bf16x8 b0 = *reinterpret_cast<LAS const bf16x8*>(a);
        bf16x8 b1 = *reinterpret_cast<LAS const bf16x8*>(a + 32 * 128);
        p0 = __builtin_amdgcn_mfma_f32_32x32x16_bf16(b0, q, p0, 0, 0, 0);
        p1 = __builtin_amdgcn_mfma_f32_32x32x16_bf16(b1, q, p1, 0, 0, 0); }
}
template <int VB>
__device__ __forceinline__ void pv_tile(f32x16* o, int vb0, bf16x8 pa0, bf16x8 pa1, bf16x8 pa2, bf16x8 pa3) {
#define TRRD(dst, off) asm volatile("ds_read_b64_tr_b16 %0, %1 offset:%2" : "=&v"(dst) : "v"(vb0), "i"(off) : "memory")
#define PV_RD(S, d0) do { constexpr int b_ = VB * SHM_V + v_rd_off(d0, 0, 0); \
        TRRD(S[0], b_); TRRD(S[1], b_ + 2048); TRRD(S[2], b_ + 4096); TRRD(S[3], b_ + 6144); TRRD(S[4], b_ + 8192); TRRD(S[5], b_ + 10240); TRRD(S[6], b_ + 12288); TRRD(S[7], b_ + 14336); } while (0)
#define PV_MM(S, d0) do { \
        o[d0] = __builtin_amdgcn_mfma_f32_32x32x16_bf16(pa0, (bf16x8){S[0][0], S[0][1], S[0][2], S[0][3], S[1][0], S[1][1], S[1][2], S[1][3]}, o[d0], 0, 0, 0);   \
        o[d0] = __builtin_amdgcn_mfma_f32_32x32x16_bf16(pa1, (bf16x8){S[2][0], S[2][1], S[2][2], S[2][3], S[3][0], S[3][1], S[3][2], S[3][3]}, o[d0], 0, 0, 0);   \
        o[d0] = __builtin_amdgcn_mfma_f32_32x32x16_bf16(pa2, (bf16x8){S[4][0], S[4][1], S[4][2], S[4][3], S[5][0], S[5][1], S[5][2], S[5][3]}, o[d0], 0, 0, 0);   \
        o[d0] = __builtin_amdgcn_mfma_f32_32x32x16_bf16(pa3, (bf16x8){S[6][0], S[6][1], S[6][2], S[6][3], S[7][0], S[7][1], S[7][2], S[7][3]}, o[d0], 0, 0, 0); } while (0)
    s16x4 sa[8], sb[8];
    PV_RD(sa, 0);
    PV_RD(sb, 1); asm volatile("s_waitcnt lgkmcnt(8)" ::: "memory"); SBAR(); PV_MM(sa, 0); SBAR();
    PV_RD(sa, 2); asm volatile("s_waitcnt lgkmcnt(8)" ::: "memory"); SBAR(); PV_MM(sb, 1); SBAR();
    PV_RD(sb, 3); asm volatile("s_waitcnt lgkmcnt(8)" ::: "memory"); SBAR(); PV_MM(sa, 2); SBAR();
    asm volatile("s_waitcnt lgkmcnt(0)" ::: "memory"); SBAR(); PV_MM(sb, 3);
#undef PV_RD
#undef PV_MM
#undef TRRD
}

struct UnitArgs {
    const bf16* Q; size_t qpitch;
    const bf16* K; size_t kpitch;
    const bf16* PE; size_t pepitch;
    const bf16* V; size_t vpitch;
    bf16* O; size_t opitch;
    float* LSE; int lse_stride;
    const float* cosT; const float* sinT;
    int pos0, posstride;
    int P0;
    const unsigned* BM;
    const float* KMP;
    int own;
    unsigned* SEL; int* CNT;
    size_t oslot, lslot;
};

__device__ __forceinline__ void attn_preload_msel(LAS char* lds, const UnitArgs& U) {
    int tid_ = threadIdx.x; asm volatile("" : "+v"(tid_));
    const int tid = tid_, wid = __builtin_amdgcn_readfirstlane(tid >> 6), lane = tid & 63;
    LAS char* V_lds = lds + OFF_V; LAS char* K_lds = lds + OFF_K;
    unsigned koff, voff;
    { const int row = 4 * wid + (lane >> 4), colB = ((lane & 15) * 16) ^ ((row & 7) << 4); koff = (unsigned)((row * U.kpitch) * 2 + colB); }
    { const int kk = (wid >> 1) * 8 + ((lane & 31) >> 2), k = (kk & ~0xC) | ((kk & 4) << 1) | ((kk & 8) >> 1), c = (2 * (wid & 1) + (lane >> 5)) * 32 + (lane & 3) * 8;
      voff = (unsigned)((k * U.vpitch + c) * 2); }
    const int kb = U.own * 256;
    const char* kt_ = (const char*)U.K + (size_t)kb * U.kpitch * 2; const char* vt_ = (const char*)U.V + (size_t)kb * U.vpitch * 2;
    __builtin_amdgcn_global_load_lds((const unsigned*)(kt_ + koff), (LAS unsigned*)(K_lds + wid * 1024), 16, 0, 0);
    __builtin_amdgcn_global_load_lds((const unsigned*)(kt_ + (size_t)64 * U.kpitch + koff), (LAS unsigned*)(K_lds + 8192 + wid * 1024), 16, 0, 0);
    __builtin_amdgcn_global_load_lds((const unsigned*)(vt_ + voff), (LAS unsigned*)(V_lds + wid * 1024), 16, 0, 0);
    __builtin_amdgcn_global_load_lds((const unsigned*)(vt_ + (size_t)64 * U.vpitch + voff), (LAS unsigned*)(V_lds + 8192 + wid * 1024), 16, 0, 0);
}
template <int MODE>
__device__ __forceinline__ void attn_unit(LAS char* lds, const UnitArgs& U) {
    constexpr bool MLA = MODE == MODE_MLA, DSA = MODE == MODE_DSA, MOWN = MODE == MODE_MOWN, MSEL = MODE == MODE_MSEL, DIL = MODE == MODE_DIL;
    constexpr float SCALE = MLA ? 0.07216878364870322f : 0.08838834764831845f;
    constexpr float C2 = 1.4426950408889634f * SCALE;
    int tid_ = threadIdx.x; asm volatile("" : "+v"(tid_));
    const int tid = tid_, wid = __builtin_amdgcn_readfirstlane(tid >> 6), lane = tid & 63, r32 = lane & 31, hi = lane >> 5;
    LAS char* V_lds = lds + OFF_V; LAS char* K_lds = lds + OFF_K; LAS char* PE_lds = lds + OFF_PE;
    LAS float* wsf = (LAS float*)(lds + OFF_WS) + wid * 64; LAS float* li_l = wsf; LAS float* al_l = wsf + 32;
    LAS unsigned* rinfo = (LAS unsigned*)(lds + OFF_TL);
    const int qlo = U.P0 + wid * 32;
    int qrow = qlo + r32; bool rvalid = true;
    if constexpr (MSEL) { const unsigned inf_ = rinfo[wid * 32 + r32]; rvalid = inf_ != 0xFFFFFFFFu; qrow = rvalid ? (int)(inf_ & 0xFFFFu) : 0; }
    const int qm = qrow - 4 * hi;
    constexpr bool PIPE = false;
    int NT = 4, kb_first = 0;
    if constexpr (MLA || DSA) { NT = (U.P0 + 255) / 64 + 1; }
    if constexpr (DIL) { const int lowk = U.P0 - 128; const int j_lo = lowk > 0 ? lowk / 64 : 0; kb_first = j_lo * 64; NT = (U.P0 + 255) / 64 + 1 - j_lo; }
    if constexpr (MOWN || MSEL) { kb_first = U.own * 256; NT = 4; }
    unsigned koff, voff, peoff = 0u;
    { const int row = 4 * wid + (lane >> 4), colB = ((lane & 15) * 16) ^ ((row & 7) << 4); koff = (unsigned)((row * U.kpitch) * 2 + colB); }
    { const int kk = (wid >> 1) * 8 + ((lane & 31) >> 2), k = (kk & ~0xC) | ((kk & 4) << 1) | ((kk & 8) >> 1), c = (2 * (wid & 1) + (lane >> 5)) * 32 + (lane & 3) * 8;
      voff = (unsigned)((k * U.vpitch + c) * 2); }
    if constexpr (MLA) { const int row = 8 * wid + (lane >> 3), colB = ((lane & 7) * 16) ^ ((row & 7) << 4); peoff = (unsigned)((row * U.pepitch) * 2 + colB); }
    const unsigned bmoff = (unsigned)qrow * 1024u;
    const int vb0 = (int)(unsigned)(uintptr_t)V_lds + v_rd_base(lane);
    u32x2 mw_n = (u32x2){0u, 0u}, mw_c = (u32x2){0u, 0u};
#define KBASE(t) (kb_first + (t) * 64)
#define SLOAD(kb_, bf) do { const char* kt_ = (const char*)U.K + (size_t)(kb_) * U.kpitch * 2; const char* vt_ = (const char*)U.V + (size_t)(kb_) * U.vpitch * 2; \
        __builtin_amdgcn_global_load_lds((const unsigned*)(kt_ + koff), (LAS unsigned*)(K_lds + (bf) * SHM_K + wid * 1024), 16, 0, 0); \
        __builtin_amdgcn_global_load_lds((const unsigned*)(kt_ + (size_t)64 * U.kpitch + koff), (LAS unsigned*)(K_lds + (bf) * SHM_K + 8192 + wid * 1024), 16, 0, 0); \
        __builtin_amdgcn_global_load_lds((const unsigned*)(vt_ + voff), (LAS unsigned*)(V_lds + (bf) * SHM_V + wid * 1024), 16, 0, 0); \
        __builtin_amdgcn_global_load_lds((const unsigned*)(vt_ + (size_t)64 * U.vpitch + voff), (LAS unsigned*)(V_lds + (bf) * SHM_V + 8192 + wid * 1024), 16, 0, 0); \
        if constexpr (MLA) __builtin_amdgcn_global_load_lds((const unsigned*)((const char*)U.PE + (size_t)(kb_) * U.pepitch * 2 + peoff), (LAS unsigned*)(PE_lds + (bf) * SHM_PE + wid * 1024), 16, 0, 0); \
        if constexpr (DSA) mw_n = *(const u32x2*)((const char*)U.BM + (size_t)((kb_) >> 5) * 4 + bmoff); } while (0)
    if constexpr (!PIPE && !MSEL) { const int kb0 = KBASE(0); SLOAD(kb0, 0); }
    bf16x8 qr[8];
    LAS const char* qpe = lds + OFF_QPE + wid * 4096 + lane * 16;
    { const bf16* qp = U.Q + (size_t)qrow * U.qpitch + hi * 8;
#pragma unroll
      for (int d0 = 0; d0 < 8; ++d0) qr[d0] = *(const bf16x8*)(qp + d0 * 16);
      if constexpr (MLA) {
#pragma unroll
          for (int dd = 0; dd < 4; ++dd) *(LAS bf16x8*)(lds + OFF_QPE + wid * 4096 + lane * 16 + dd * 1024) = *(const bf16x8*)(qp + (8 + dd) * 16);
          asm volatile("s_waitcnt lgkmcnt(0)" ::: "memory"); }
    }
    if constexpr (MOWN) {
        const int own = U.own;
        LAS char* KM = lds + OFF_KM;
        { const int jb = tid >> 4, d8 = (tid & 15) * 8; const float* kp = U.KMP + (jb * 512 + d8);
          f32x4 a0 = (f32x4){0.f, 0.f, 0.f, 0.f}, a1 = a0;
#pragma unroll
          for (int pq = 0; pq < 4; ++pq) { a0 += *(const f32x4*)(kp + pq * 128); a1 += *(const f32x4*)(kp + pq * 128 + 4); }
          *(LAS bf16x8*)(KM + jb * 256 + d8 * 2) = pack8(a0 * (1.f / 256.f), a1 * (1.f / 256.f)); }
        __syncthreads();
        f32x16 g = f32x16{};
#pragma unroll
        for (int d0 = 0; d0 < 8; ++d0) { const bf16x8 a = *(const LAS bf16x8*)(KM + r32 * 256 + (d0 * 16 + hi * 8) * 2);
            g = __builtin_amdgcn_mfma_f32_32x32x16_bf16(a, qr[d0], g, 0, 0, 0); }
        const float NEG = -__builtin_inff();
#pragma unroll
        for (int r = 0; r < 16; ++r) if (crow(r, hi) >= own) g[r] = NEG;
        unsigned selbits = 0;
#pragma unroll
        for (int round = 0; round < 3; ++round) {
            float bv = NEG; int bi = 64;
#pragma unroll
            for (int r = 0; r < 16; ++r) { const int j = crow(r, hi); if (g[r] > bv) { bv = g[r]; bi = j; } }
            const float ov = __shfl_xor(bv, 32); const int oi = __shfl_xor(bi, 32);
            const bool take_other = (ov > bv) || (ov == bv && oi < bi);
            const float wv = take_other ? ov : bv; const int wi = take_other ? oi : bi;
            if (wv > NEG) { selbits |= 1u << wi;
#pragma unroll
                for (int r = 0; r < 16; ++r) if (crow(r, hi) == wi) g[r] = NEG; }
        }
        const int nsel = __builtin_popcount(selbits);
        if (hi == 0) { U.SEL[qrow] = selbits;
#pragma unroll
            for (int s_ = 0; s_ < 3; ++s_) if (s_ >= nsel) U.LSE[(size_t)s_ * U.lslot + (size_t)qrow * U.lse_stride] = NEG; }
        LAS int* cw = (LAS int*)(lds + OFF_TL);
#pragma unroll 4
        for (int j = 0; j < 32; ++j) { const int c_ = __builtin_popcountll(__ballot(hi == 0 && ((selbits >> j) & 1u))); if (lane == 0) cw[wid * 32 + j] = c_; }
        __syncthreads();
        if (tid < 32) { int s_ = 0;
#pragma unroll
            for (int w_ = 0; w_ < 8; ++w_) s_ += cw[w_ * 32 + tid];
            U.CNT[tid] = s_; }
        __syncthreads();
    }
    float m_reg = -1e30f, l_reg = 0.f; f32x16 o[4] = {};
#define RESC(a) do { if (__any((a) < 1.f)) { if (hi == 0) al_l[r32] = (a); asm volatile("s_waitcnt lgkmcnt(0)" ::: "memory"); \
        _Pragma("unroll") for (int d_ = 0; d_ < 4; ++d_) _Pragma("unroll") for (int r = 0; r < 16; ++r) o[d_][r] *= al_l[crow(r, hi)]; } } while (0)
    const bool wact = MSEL ? (bool)__any(rvalid) : true;
#define STEP(t_, B_, NB_) do { const int kb_ = KBASE(t_); const bool more_ = (t_) + 1 < NT; \
        bool act_ = wact; \
        if constexpr (MLA || DSA || MOWN) act_ = kb_ <= qlo + 31; \
        if constexpr (DIL) act_ = (kb_ <= qlo + 31) && (kb_ + 63 >= qlo - 128); \
        f32x16 p0, p1; float mn_, al_ = 1.f; \
        if (act_) { qkt<B_>(p0, p1, K_lds, r32, hi, qr); \
            if constexpr (MLA) qkt_pe_lq<B_>(p0, p1, PE_lds, r32, hi, qpe); \
            if constexpr (MLA || MOWN) { if (kb_ + 63 > qlo) mask_tile(p0, p1, qm - kb_, 0x7fffffffu); } \
            if constexpr (DIL) { if (kb_ + 63 > qlo || kb_ <= qlo + 31 - 129) mask_tile(p0, p1, qm - kb_, 129u); } \
            partialSM<MODE>(p0, p1, m_reg, mn_, al_); RESC(al_); } \
        SBAR(); \
          \
        if (more_) { const int kbn_ = KBASE((t_) + 1); SLOAD(kbn_, NB_); } \
        SBAR(); \
        if (act_) { bf16x8 pa0, pa1, pa2, pa3; finishSM<DSA>(p0, p1, al_, l_reg, pa0, pa1, pa2, pa3, mw_c.x >> (4 * hi), mw_c.y >> (4 * hi)); SBAR(); \
            pv_tile<B_>(o, vb0, pa0, pa1, pa2, pa3); } \
        VM_WAIT(); mw_c = mw_n; \
        __syncthreads(); } while (0)
    if (wid >= 4) __builtin_amdgcn_s_setprio(1);
    if constexpr (!PIPE) {
    { VM_WAIT(); mw_c = mw_n; }
    __syncthreads();
    for (int t = 0; t < NT; t += 2) {
        STEP(t, 0, 1);
        if (t + 1 < NT) STEP(t + 1, 1, 0);
    }
    } else {
#define SLOAD_K(kb_, bf) do { const char* kt_ = (const char*)U.K + (size_t)(kb_) * U.kpitch * 2; \
        __builtin_amdgcn_global_load_lds((const unsigned*)(kt_ + koff), (LAS unsigned*)(K_lds + (bf) * SHM_K + wid * 1024), 16, 0, 0); \
        __builtin_amdgcn_global_load_lds((const unsigned*)(kt_ + (size_t)64 * U.kpitch + koff), (LAS unsigned*)(K_lds + (bf) * SHM_K + 8192 + wid * 1024), 16, 0, 0); \
        if constexpr (MLA) __builtin_amdgcn_global_load_lds((const unsigned*)((const char*)U.PE + (size_t)(kb_) * U.pepitch * 2 + peoff), (LAS unsigned*)(PE_lds + (bf) * SHM_PE + wid * 1024), 16, 0, 0); } while (0)
#define SLOAD_V(kb_, bf) do { const char* vt_ = (const char*)U.V + (size_t)(kb_) * U.vpitch * 2; \
        __builtin_amdgcn_global_load_lds((const unsigned*)(vt_ + voff), (LAS unsigned*)(V_lds + (bf) * SHM_V + wid * 1024), 16, 0, 0); \
        __builtin_amdgcn_global_load_lds((const unsigned*)(vt_ + (size_t)64 * U.vpitch + voff), (LAS unsigned*)(V_lds + (bf) * SHM_V + 8192 + wid * 1024), 16, 0, 0); } while (0)
#define LOADMW(kb_) (*(const u32x2*)((const char*)U.BM + (size_t)((kb_) >> 5) * 4 + bmoff))
#define ACT_OF(kb_) ((MLA || DSA) ? ((kb_) <= qlo + 31) : (DIL ? (((kb_) <= qlo + 31) && ((kb_) + 63 >= qlo - 128)) : wact))
#define XPART1(PX0, PX1, KB_) do { qkt<KB_>(PX0, PX1, K_lds, r32, hi, qr); if constexpr (MLA) qkt_pe_lq<KB_>(PX0, PX1, PE_lds, r32, hi, qpe); } while (0)
#define XPART2(PX0, PX1, alX, kbx_) do { \
        if constexpr (MLA) { if ((kbx_) + 63 > qlo) mask_tile(PX0, PX1, qm - (kbx_), 0x7fffffffu); } \
        if constexpr (DIL) { if ((kbx_) + 63 > qlo || (kbx_) <= qlo + 31 - 129) mask_tile(PX0, PX1, qm - (kbx_), 129u); } \
        float mn_; partialSM<MODE>(PX0, PX1, m_reg, mn_, alX); } while (0)
#define HS(PX0, PX1, alX, actX, mwX, PY0, PY1, alY, actY, mwY, t_, KB_, VB_) do { const int kbx_ = KBASE(t_); \
        if ((t_) + 1 < NT) { const int kbn_ = KBASE((t_) + 1); SLOAD_K(kbn_, (KB_) ^ 1); } \
        SLOAD_V(kbx_, KB_); \
        actX = ACT_OF(kbx_); alX = 1.f; \
        bf16x8 pa0, pa1, pa2, pa3; \
        if (actX) XPART1(PX0, PX1, KB_); \
        if (actY) finishSM<DSA>(PY0, PY1, alY, l_reg, pa0, pa1, pa2, pa3, mwY.x >> (4 * hi), mwY.y >> (4 * hi)); \
        if constexpr (DSA) { if ((t_) + 1 < NT) mwY = LOADMW(KBASE((t_) + 1)); } \
        if (actY) { SBAR(); pv_tile<VB_>(o, vb0, pa0, pa1, pa2, pa3); } \
        if (actX) { XPART2(PX0, PX1, alX, kbx_); RESC(alX); } \
        VM_WAIT(); __syncthreads(); } while (0)
    f32x16 pA0, pA1, pB0, pB1; float alA = 1.f, alB = 1.f; bool actA = false, actB = false; u32x2 mwA = (u32x2){0u, 0u}, mwB = mwA;
    { const int kb0 = KBASE(0); SLOAD_K(kb0, 0); if constexpr (DSA) mwA = LOADMW(kb0); VM_WAIT(); }
    __syncthreads();
    {
        const int kb0 = KBASE(0);
        if (NT > 1) { const int kb1 = KBASE(1); SLOAD_K(kb1, 1); if constexpr (DSA) mwB = LOADMW(kb1); }
        SLOAD_V(kb0, 0);
        actA = ACT_OF(kb0);
        if (actA) { XPART1(pA0, pA1, 0); XPART2(pA0, pA1, alA, kb0); }
        VM_WAIT(); __syncthreads();
    }
    for (int t = 1; t < NT; t += 2) {
        HS(pB0, pB1, alB, actB, mwB, pA0, pA1, alA, actA, mwA, t, 1, 0);
        if (t + 1 < NT) HS(pA0, pA1, alA, actA, mwA, pB0, pB1, alB, actB, mwB, t + 1, 0, 1);
    }
    {
        bf16x8 pa0, pa1, pa2, pa3;
        if (NT & 1) { if (actA) { finishSM<DSA>(pA0, pA1, alA, l_reg, pa0, pa1, pa2, pa3, mwA.x >> (4 * hi), mwA.y >> (4 * hi)); SBAR(); pv_tile<0>(o, vb0, pa0, pa1, pa2, pa3); } }
        else { if (actB) { finishSM<DSA>(pB0, pB1, alB, l_reg, pa0, pa1, pa2, pa3, mwB.x >> (4 * hi), mwB.y >> (4 * hi)); SBAR(); pv_tile<1>(o, vb0, pa0, pa1, pa2, pa3); } }
    }
    __syncthreads();
#undef SLOAD_K
#undef SLOAD_V
#undef LOADMW
#undef ACT_OF
#undef XPART1
#undef XPART2
#undef HS
    }
    __builtin_amdgcn_s_setprio(0);
    if (hi == 0) li_l[r32] = l_reg;
    asm volatile("s_waitcnt lgkmcnt(0)" ::: "memory");
    float rli[16];
#pragma unroll
    for (int r = 0; r < 16; ++r) rli[r] = __builtin_amdgcn_rcpf(li_l[crow(r, hi)]);
    if constexpr (MSEL) {
        if (wact) {
#pragma unroll
            for (int r = 0; r < 16; ++r) { const unsigned inf_ = rinfo[wid * 32 + crow(r, hi)];
                if (inf_ != 0xFFFFFFFFu) { bf16* rb = U.O + (size_t)(inf_ >> 16) * U.oslot + (size_t)(inf_ & 0xFFFFu) * U.opitch;
#pragma unroll
                    for (int d0 = 0; d0 < 4; ++d0) { const float v = o[d0][r] * rli[r];
                        const float vn = __shfl_xor(v, 1);
                        if ((r32 & 1) == 0) *(unsigned*)(rb + d0 * 32 + r32) = cvt_pk_bf16(v, vn); } } }
            if (hi == 0 && rvalid) { const unsigned inf_ = rinfo[wid * 32 + r32];
                U.LSE[(size_t)(inf_ >> 16) * U.lslot + (size_t)(inf_ & 0xFFFFu) * U.lse_stride] = m_reg * C2 + __builtin_amdgcn_logf(l_reg); }
        }
    } else {
      { const unsigned lane_off = (unsigned)((4 * hi * U.opitch + r32) * 2);
        const char* obase = (const char*)(U.O + (size_t)qlo * U.opitch);
#pragma unroll
        for (int r = 0; r < 16; ++r) { const char* rb = obase + (size_t)((r & 3) + 8 * (r >> 2)) * U.opitch * 2;
#pragma unroll
          for (int d0 = 0; d0 < 4; ++d0) { const float v = o[d0][r] * rli[r];
              const float vn = __shfl_xor(v, 1);
              if ((r32 & 1) == 0) *(unsigned*)(rb + d0 * 64 + lane_off) = cvt_pk_bf16(v, vn); } } }
      if constexpr (DIL) { if (hi == 0) U.LSE[(size_t)qrow * U.lse_stride] = m_reg * C2 + __builtin_amdgcn_logf(l_reg); }
      if constexpr (MOWN) { if (hi == 0) U.LSE[(size_t)3 * U.lslot + (size_t)qrow * U.lse_stride] = m_reg * C2 + __builtin_amdgcn_logf(l_reg); }
    }
    __syncthreads();
#undef KBASE
#undef SLOAD
#undef RESC
#undef STEP
}
}

__device__ __forceinline__ void rope_row_heads128(bf16* kbase, const float* cs, const float* sn, int lane) {
    const int h = lane >> 3, i0 = (lane & 7) * 8;
    bf16* p = kbase + h * 128 + i0;
    bf16x8 a = *(const bf16x8*)p, b = *(const bf16x8*)(p + 64);
    att::rope_pair(a, b, cs + i0, sn + i0);
    *(bf16x8*)p = a; *(bf16x8*)(p + 64) = b;
}
__device__ __forceinline__ void post_even(Frame& F, const float* g_q, const float* g_kv, size_t ws_off = WS_PROJ) {
    bf16* PROJ = (bf16*)(F.ws + ws_off);
    const float* c128 = (const float*)(F.ws + WS_COS128); const float* s128 = (const float*)(F.ws + WS_SIN128);
    const float* c64 = (const float*)(F.ws + WS_COS64); const float* s64 = (const float*)(F.ws + WS_SIN64);
    const int gw = F.vcu * NWAVES + F.wave, NGW = F.G * NWAVES, lane = F.lane;
    for (int m = gw; m < T; m += NGW) {
        bf16* row = PROJ + (size_t)m * EVEN_INP; const int pos = m & (SEQ - 1);
        {
            bf16x8 v = *(const bf16x8*)(row + EC_CQ + lane * 8); float f[8], s = 0.f;
#pragma unroll
            for (int j = 0; j < 8; ++j) { f[j] = bf2f((unsigned short)v[j]); s += f[j] * f[j]; }
            const float rs = 1.0f / sqrtf(wave_sum(s) * (1.f / 512.f) + NORM_EPS);
            const f32x4 g0 = *(const f32x4*)(g_q + lane * 8), g1 = *(const f32x4*)(g_q + lane * 8 + 4);
            f32x4 o0 = {f[0] * rs * g0[0], f[1] * rs * g0[1], f[2] * rs * g0[2], f[3] * rs * g0[3]}, o1 = {f[4] * rs * g1[0], f[5] * rs * g1[1], f[6] * rs * g1[2], f[7] * rs * g1[3]};
            *(bf16x8*)(row + EC_CQ + lane * 8) = att::pack8(o0, o1); }
        {
            const u32x2 v = *(const u32x2*)(row + EC_CKV + lane * 4);
            const float f0 = bf2f((unsigned short)(v.x & 0xffff)), f1 = bf2f((unsigned short)(v.x >> 16)), f2 = bf2f((unsigned short)(v.y & 0xffff)), f3 = bf2f((unsigned short)(v.y >> 16));
            const float rs = 1.0f / sqrtf(wave_sum(f0 * f0 + f1 * f1 + f2 * f2 + f3 * f3) * (1.f / 256.f) + NORM_EPS);
            const f32x4 g0 = *(const f32x4*)(g_kv + lane * 4);
            u32x2 w; w.x = cvt_pk_bf16(f0 * rs * g0[0], f1 * rs * g0[1]); w.y = cvt_pk_bf16(f2 * rs * g0[2], f3 * rs * g0[3]);
            *(u32x2*)(row + EC_CKV + lane * 4) = w; }
        {
            const int i = lane & 31; bf16* p = row + ((lane < 32) ? EC_KPE : EC_KI) + i;
            const float x1 = bf2f(p[0]), x2 = bf2f(p[32]); const float c = c64[pos * 32 + i], s = s64[pos * 32 + i];
            const unsigned y = cvt_pk_bf16(x1 * c - x2 * s, x1 * s + x2 * c);
            p[0] = (bf16)(y & 0xffff); p[32] = (bf16)(y >> 16); }
        rope_row_heads128(row + EC_K, c128 + (size_t)pos * 64, s128 + (size_t)pos * 64, lane);
    }
}
__device__ __forceinline__ void post_odd(Frame& F) {
    bf16* PROJ = (bf16*)(F.ws + WS_PROJ2);
    const float* c128 = (const float*)(F.ws + WS_COS128); const float* s128 = (const float*)(F.ws + WS_SIN128);
    float* KMP = (float*)(F.ws + WS_KM);
    LAS float* red = (LAS float*)F.lds;
    const int lane = F.lane, h = lane >> 3, i0 = (lane & 7) * 8;
    for (int u = F.vcu; u < T / 64; u += F.G) {
        float sa[8], sb[8];
#pragma unroll
        for (int j = 0; j < 8; ++j) { sa[j] = 0.f; sb[j] = 0.f; }
        for (int rr = 0; rr < 8; ++rr) {
            const int m = u * 64 + F.wave * 8 + rr; const int pos = m & (SEQ - 1);
            bf16* row = PROJ + (size_t)m * ODD_IN;
            const float* cs = c128 + (size_t)pos * 64; const float* sn = s128 + (size_t)pos * 64;
            { bf16* p = row + OC_KC + h * 128 + i0; bf16x8 a = *(const bf16x8*)p, b = *(const bf16x8*)(p + 64);
              const f32x4 c0 = *(const f32x4*)(cs + i0), c1 = *(const f32x4*)(cs + i0 + 4), s0 = *(const f32x4*)(sn + i0), s1 = *(const f32x4*)(sn + i0 + 4);
              f32x4 y1a, y1b, y2a, y2b;
#pragma unroll
              for (int j = 0; j < 4; ++j) { const float x1 = bf2f((unsigned short)a[j]), x2 = bf2f((unsigned short)b[j]); y1a[j] = x1 * c0[j] - x2 * s0[j]; y2a[j] = x1 * s0[j] + x2 * c0[j];
                  const float z1 = bf2f((unsigned short)a[4 + j]), z2 = bf2f((unsigned short)b[4 + j]); y1b[j] = z1 * c1[j] - z2 * s1[j]; y2b[j] = z1 * s1[j] + z2 * c1[j];
                  sa[j] += y1a[j]; sa[4 + j] += y1b[j]; sb[j] += y2a[j]; sb[4 + j] += y2b[j]; }
              *(bf16x8*)p = att::pack8(y1a, y1b); *(bf16x8*)(p + 64) = att::pack8(y2a, y2b); }
            rope_row_heads128(row + OC_KD, cs, sn, lane);
        }
#pragma unroll
        for (int j = 0; j < 8; ++j) { red[F.wave * 1024 + h * 128 + i0 + j] = sa[j]; red[F.wave * 1024 + h * 128 + 64 + i0 + j] = sb[j]; }
        __syncthreads();
        { const int b = u / 128, jq = u % 128, jb = jq >> 2, q4 = jq & 3;
#pragma unroll
          for (int cc = 0; cc < 2; ++cc) { const int col = F.tid + cc * 512; float s = 0.f;
#pragma unroll
              for (int w = 0; w < 8; ++w) s += red[w * 1024 + col];
              const int hh = col >> 7, d = col & 127;
              KMP[((((size_t)b * 8 + hh) * 32 + jb) * 4 + q4) * 128 + d] = s; } }
        __syncthreads();
    }
}

#ifndef REPMASK
#define REPMASK 0ull
#endif
#define IDX_REP_A ((((REPMASK) >> 24) & 1ull) ? 2 : 1)
#define IDX_REP_B ((((REPMASK) >> 25) & 1ull) ? 2 : 1)
__device__ __forceinline__ void indexer_unit(Frame& F, int b, int i) {
    const bf16* PR = (const bf16*)(F.ws + WS_PROJ) + (size_t)b * SEQ * EVEN_INP;
    const float* c64 = (const float*)(F.ws + WS_COS64); const float* s64 = (const float*)(F.ws + WS_SIN64);
    float* SCw = (float*)(F.ws + WS_SC + (size_t)blockIdx.x * MiB);
    unsigned* BMb = (unsigned*)(F.ws + WS_BM) + (size_t)b * SEQ * 256;
    LAS unsigned char* lds = F.lds;
    const int tid = F.tid, wid = F.wave, lane = F.lane, r32 = lane & 31, hi = lane >> 5;
    const int t0 = 32 * i;
    LAS float* sgl = (LAS float*)(lds + 139264);
    {
        const int row = tid & 31, h = tid >> 5; const int pos = t0 + row;
        const float wv = bf2f(PR[(size_t)pos * EVEN_INP + EC_WI + h]) * 0.03125f;
        sgl[h * 32 + row] = wv < 0.f ? -1.f : 1.f;
        const bf16* qp = PR + (size_t)pos * EVEN_INP + EC_QI + h * 64;
        bf16x8 f[8];
#pragma unroll
        for (int p = 0; p < 8; ++p) f[p] = *(const bf16x8*)(qp + p * 8);
        { const float aw = fabsf(wv);
#pragma unroll
          for (int p = 0; p < 8; ++p) { f32x4 lo, hi4;
#pragma unroll
              for (int e = 0; e < 4; ++e) { lo[e] = bf2f((unsigned short)f[p][e]) * aw; hi4[e] = bf2f((unsigned short)f[p][4 + e]) * aw; }
              f[p] = att::pack8(lo, hi4); } }
#pragma unroll
        for (int p = 0; p < 8; ++p) *(LAS bf16x8*)(lds + ((((h * 4 + (p >> 1)) * 2 + (p & 1)) * 32 + row) * 16)) = f[p];
    }
    __syncthreads();
    {
        const int row = tid & 31, dg = tid >> 5, ks = dg >> 2, hi2 = (dg >> 1) & 1, e0 = (dg & 1) * 4;
        float acc4[4] = {0.f, 0.f, 0.f, 0.f};
#pragma unroll
        for (int h = 0; h < 16; ++h) { const u32x2 v = *(const LAS u32x2*)(lds + ((((h * 4 + ks) * 2 + hi2) * 32 + row) * 16) + e0 * 2); const float sg = sgl[h * 32 + row];
            acc4[0] += sg * bf2f((unsigned short)(v.x & 0xffff)); acc4[1] += sg * bf2f((unsigned short)(v.x >> 16));
            acc4[2] += sg * bf2f((unsigned short)(v.y & 0xffff)); acc4[3] += sg * bf2f((unsigned short)(v.y >> 16)); }
        u32x2 o2; o2.x = cvt_pk_bf16(acc4[0], acc4[1]); o2.y = cvt_pk_bf16(acc4[2], acc4[3]);
        *(LAS u32x2*)(lds + ((((16 * 4 + ks) * 2 + hi2) * 32 + row) * 16) + e0 * 2) = o2;
    }
    __syncthreads();
    const int nkeys = 32 * (i + 1), nsteps = (nkeys + 63) / 64;
    LAS float* tls = (LAS float*)(lds + 69632 + wid * 8704);
    for (int rep_ = 0; rep_ < IDX_REP_A; ++rep_) {
    bf16x8 ka[4], kb[4];
#define IDX_LDK(G_) do { const bf16* kp = PR + (size_t)(64 * (G_) + r32) * EVEN_INP + EC_KI + hi * 8; \
        _Pragma("unroll") for (int ks = 0; ks < 4; ++ks) { ka[ks] = *(const bf16x8*)(kp + ks * 16); kb[ks] = *(const bf16x8*)(kp + (size_t)32 * EVEN_INP + ks * 16); } } while (0)
    if (wid < nsteps) IDX_LDK(wid);
    for (int g = wid; g < nsteps; g += 8) {
        const int k0 = 64 * g;
        f32x16 s0 = f32x16{}, s1 = f32x16{};
        LAS const unsigned char* qb_ = lds + (hi * 32 + r32) * 16;
#define IDX_LDQ(Q, H) do { _Pragma("unroll") for (int ks = 0; ks < 4; ++ks) Q[ks] = *(const LAS bf16x8*)(qb_ + (H) * 4096 + ks * 1024); } while (0)
#define IDX_MMA(A0, A1, Q) do { A0 = f32x16{}; A1 = f32x16{}; _Pragma("unroll") for (int ks = 0; ks < 4; ++ks) { \
            A0 = __builtin_amdgcn_mfma_f32_32x32x16_bf16(ka[ks], Q[ks], A0, 0, 0, 0); A1 = __builtin_amdgcn_mfma_f32_32x32x16_bf16(kb[ks], Q[ks], A1, 0, 0, 0); } } while (0)
#define IDX_ACC(A0, A1, W) do { _Pragma("unroll") for (int r = 0; r < 16; ++r) { s0[r] = fmaf(W, __builtin_fabsf(A0[r]), s0[r]); s1[r] = fmaf(W, __builtin_fabsf(A1[r]), s1[r]); } } while (0)
        f32x16 a0, a1, b0, b1; bf16x8 qx[4], qy[4];
        IDX_LDQ(qx, 0); IDX_LDQ(qy, 1);
        IDX_MMA(a0, a1, qx);
#pragma unroll 1
        for (int h = 0; h < 16; h += 2) {
            const float w0 = sgl[h * 32 + r32], w1 = sgl[(h + 1) * 32 + r32];
            IDX_LDQ(qx, h + 2);
            __builtin_amdgcn_sched_barrier(0);
            IDX_MMA(b0, b1, qy);
            __builtin_amdgcn_sched_barrier(0);
            IDX_ACC(a0, a1, w0);
            __builtin_amdgcn_sched_barrier(0);
            if (h + 3 < 17) IDX_LDQ(qy, h + 3);
            __builtin_amdgcn_sched_barrier(0);
            IDX_MMA(a0, a1, qx);
            __builtin_amdgcn_sched_barrier(0);
            IDX_ACC(b0, b1, w1);
            __builtin_amdgcn_sched_barrier(0);
        }
#undef IDX_LDQ
        __builtin_amdgcn_sched_barrier(0);
        if (g + 8 < nsteps) IDX_LDK(g + 8);
        __builtin_amdgcn_sched_barrier(0);
#undef IDX_LDK
#pragma unroll
        for (int r = 0; r < 16; ++r) { s0[r] = 0.5f * (s0[r] + a0[r]); s1[r] = 0.5f * (s1[r] + a1[r]); }
#undef IDX_MMA
#undef IDX_ACC
#pragma unroll
        for (int q4 = 0; q4 < 4; ++q4) {
            *(LAS f32x4*)(tls + r32 * 68 + 8 * q4 + 4 * hi) = (f32x4){s0[4 * q4], s0[4 * q4 + 1], s0[4 * q4 + 2], s0[4 * q4 + 3]};
            *(LAS f32x4*)(tls + r32 * 68 + 32 + 8 * q4 + 4 * hi) = (f32x4){s1[4 * q4], s1[4 * q4 + 1], s1[4 * q4 + 2], s1[4 * q4 + 3]}; }
        LDS_WAIT(); asm volatile("" ::: "memory");
#pragma unroll
        for (int ps = 0; ps < 8; ++ps) { const int row = ps * 4 + (lane >> 4), c4 = (lane & 15) * 4;
            const f32x4 v = *(const LAS f32x4*)(tls + row * 68 + c4);
            u32x4 uu;
#pragma unroll
            for (int e = 0; e < 4; ++e) { const unsigned x = __float_as_uint(v[e]); const unsigned y = (x & 0x80000000u) ? ~x : (x | 0x80000000u);
                uu[e] = (k0 + c4 + e <= t0 + row) ? y : 0u; }
            *(u32x4*)(SCw + (size_t)row * 8192 + k0 + c4) = uu; }
        LDS_WAIT(); asm volatile("" ::: "memory");
    } }
    {
        const int kz0 = 64 * nsteps, kz1 = (kz0 + 1023) & ~1023, n4 = (kz1 - kz0) >> 2;
        for (int idx = tid; idx < 32 * n4; idx += 512) { const int row = idx / n4, c = idx - row * n4;
            *(u32x4*)(SCw + (size_t)row * 8192 + kz0 + 4 * c) = (u32x4){0u, 0u, 0u, 0u}; } }
    VM_WAIT();
    __syncthreads();
    __builtin_amdgcn_fence(__ATOMIC_ACQUIRE, "agent");
    VM_WAIT();
    unsigned u[128];
#define SEL_LOADG(g8_, kk_) do { const int rho_ = wid * 4 + (kk_), nch_ = (t0 + rho_ + 1 + 63) >> 6; \
        if ((g8_) * 16 < nch_) { const float* sg0 = SCw + (size_t)rho_ * 8192 + lane + (g8_) * 1024; asm volatile("" : "+v"(sg0));     \
            const GAS unsigned* sg = (const GAS unsigned*)sg0; \
            _Pragma("unroll") for (int jj = 0; jj < 16; ++jj) u[(g8_) * 16 + jj] = sg[64 * jj]; } \
        else { _Pragma("unroll") for (int jj = 0; jj < 16; ++jj) u[(g8_) * 16 + jj] = 0u; } } while (0)
#pragma unroll
    for (int g8 = 0; g8 < 8; ++g8) SEL_LOADG(g8, 0);
    for (int k_ = 0; k_ < 4 * IDX_REP_B; ++k_) { const int k = k_ & 3;
        const int rho = wid * 4 + k, t = t0 + rho, nvalid = t + 1, nch = (nvalid + 63) >> 6;
        const bool more_rows = k_ + 1 < 4 * IDX_REP_B; const int kn = (k_ + 1) & 3;
        unsigned tau = 1u;
#define SEL_COUNT(cand_, cnt_) do { cnt_ = 0; _Pragma("unroll") for (int g8 = 0; g8 < 8; ++g8) if (g8 * 16 < nch) { \
            _Pragma("unroll") for (int jj = 0; jj < 16; ++jj) { cnt_ += __builtin_popcountll(__ballot(u[g8 * 16 + jj] >= (cand_))); if ((jj & 7) == 7) asm volatile("" : "+s"(cnt_)); } } } while (0)
        if (nvalid > 256) {
            unsigned P = 0u; int c1 = 0;
            { const int ksm = (65536 + nvalid - 1) / nvalid;
              unsigned ps = 0u;
              for (int bit = 15; bit >= 0; --bit) { const unsigned cand = ps | (1u << bit); int cnt = 0;
#pragma unroll
                  for (int jj = 0; jj < 4; ++jj) cnt += __builtin_popcountll(__ballot(u[jj] >= (cand << 16)));
                  if (cnt >= ksm) ps = cand; }
              unsigned blo, bhi; int chi = 0, c0; SEL_COUNT(ps << 16, c0);
              if (c0 >= 256) { blo = ps; bhi = 0x10000u; unsigned step = 8u;
                  for (;;) { const unsigned cand = blo + step; if (cand > 0xFFFFu) { bhi = 0x10000u; chi = 0; break; }
                      int cc; SEL_COUNT(cand << 16, cc); if (cc >= 256) { blo = cand; step <<= 1; } else { bhi = cand; chi = cc; break; } }
              } else { bhi = ps; chi = c0; blo = 0u; unsigned step = 8u;
                  for (;;) { const unsigned cand = bhi > step ? bhi - step : 0u; int cc; SEL_COUNT(cand << 16, cc);
                      if (cc >= 256) { blo = cand; break; } else { bhi = cand; chi = cc; step <<= 1; } } }
              while (bhi - blo > 1u) { const unsigned mid = (blo + bhi) >> 1; int cm; SEL_COUNT(mid << 16, cm); if (cm >= 256) blo = mid; else { bhi = mid; chi = cm; } }
              P = blo << 16; c1 = chi; }
            constexpr int LCAP = 1024;
            LAS unsigned* lst = (LAS unsigned*)(lds + wid * (LCAP * 4));
            int c2 = 0;
#pragma unroll
            for (int g8 = 0; g8 < 8; ++g8) if (g8 * 16 < nch) {
#pragma unroll
                for (int jj = 0; jj < 16; ++jj) { const unsigned x = u[g8 * 16 + jj] ^ P; const bool fl = x < 65536u; const unsigned long long bal = __ballot(fl);
                    if (bal != 0ull) { const int pos = c2 + (int)__builtin_amdgcn_mbcnt_hi((unsigned)(bal >> 32), __builtin_amdgcn_mbcnt_lo((unsigned)bal, 0u));
                        if (fl && pos < LCAP) lst[pos] = x;
                        c2 += __builtin_popcountll(bal); } } }
            const int need = 256 - c1;
            if (c2 <= LCAP) {
                asm volatile("s_waitcnt lgkmcnt(0)" ::: "memory");
                unsigned L = 0u;
                for (int bit = 15; bit >= 0; --bit) { const unsigned cand = L | (1u << bit); int cnt = 0;
                    for (int i0 = 0; i0 < c2; i0 += 64) { const int i = i0 + lane; cnt += __builtin_popcountll(__ballot(i < c2 && lst[i < c2 ? i : 0] >= cand)); }
                    if (cnt >= need) L = cand; }
                tau = P | L;
            } else {
                tau = P;
                for (int bit = 15; bit >= 0; --bit) { const unsigned cand = tau | (1u << bit); int cnt; SEL_COUNT(cand, cnt); if (cnt >= 256) tau = cand; }
            }
        }
#undef SEL_COUNT
        unsigned* brow = BMb + (size_t)t * 256;
#pragma unroll
        for (int half = 0; half < 2; ++half) { unsigned lo = 0u, hw = 0u;
#pragma unroll
            for (int g4 = 0; g4 < 4; ++g4) { if ((half * 4 + g4) * 16 < nch) {
#pragma unroll
              for (int j16 = 0; j16 < 16; ++j16) { const int jj = g4 * 16 + j16; const unsigned long long bm = __ballot(u[half * 64 + jj] >= tau);
                const unsigned bl_ = (unsigned)bm, bh_ = (unsigned)(bm >> 32);
                asm volatile("s_nop 1\n\tv_writelane_b32 %0, %2, %4\n\tv_writelane_b32 %1, %3, %4" : "+v"(lo), "+v"(hw) : "s"(bl_), "s"(bh_), "n"(jj)); } }
              if (more_rows) SEL_LOADG(half * 4 + g4, kn); }
            *(u32x2*)(brow + (half * 64 + lane) * 2) = (u32x2){lo, hw}; }
    }
#undef SEL_LOADG
    __syncthreads();
}
__device__ __forceinline__ void dil_combine(Frame& F, bf16* O, const bf16* OG) {
    const float* LSE = (const float*)(F.ws + WS_LSE);
    const int gw = F.vcu * NWAVES + F.wave, NGW = F.G * NWAVES, lane = F.lane, h = lane >> 3;
    for (int m0 = gw; m0 < T; m0 += 2 * NGW) {
        int mr[2]; mr[0] = m0; mr[1] = (m0 + NGW < T) ? m0 + NGW : m0; const bool two = m0 + NGW < T;
        float l[2][3]; bf16x8 da[2][3], db[2][3];
#pragma unroll
        for (int q = 0; q < 2; ++q) {
#pragma unroll
            for (int g = 0; g < 3; ++g) { l[q][g] = LSE[((size_t)g * T + mr[q]) * 8 + h];
                const bf16* p = g == 0 ? O + (size_t)mr[q] * DM + 1024 + lane * 16 : OG + ((size_t)(g - 1) * T + mr[q]) * 1024 + lane * 16;
                da[q][g] = *(const bf16x8*)p; db[q][g] = *(const bf16x8*)(p + 8); } }
#pragma unroll
        for (int q = 0; q < 2; ++q) { if (q == 1 && !two) break;
            float w[3];
            const float mx = fmaxf(l[q][0], fmaxf(l[q][1], l[q][2]));
            float ssum = 0.f;
#pragma unroll
            for (int g = 0; g < 3; ++g) { w[g] = __builtin_amdgcn_exp2f(l[q][g] - mx); ssum += w[g]; }
            const float inv = 1.f / ssum;
            float acc[16];
#pragma unroll
            for (int g = 0; g < 3; ++g) { const bf16x8 a = da[q][g], b = db[q][g]; const float wg = w[g] * inv;
#pragma unroll
                for (int j = 0; j < 8; ++j) { const float xa = wg * bf2f((unsigned short)a[j]), xb = wg * bf2f((unsigned short)b[j]);
                    acc[j] = g == 0 ? xa : acc[j] + xa; acc[8 + j] = g == 0 ? xb : acc[8 + j] + xb; } }
            bf16* op = O + (size_t)mr[q] * DM + 1024 + lane * 16;
            *(bf16x8*)op = att::pack8((f32x4){acc[0], acc[1], acc[2], acc[3]}, (f32x4){acc[4], acc[5], acc[6], acc[7]});
            *(bf16x8*)(op + 8) = att::pack8((f32x4){acc[8], acc[9], acc[10], acc[11]}, (f32x4){acc[12], acc[13], acc[14], acc[15]}); }
    }
}
constexpr int MOBA_LPRE_OFF = 4096;
__device__ __forceinline__ int moba_chunk_table(Frame& F, const int* CNT, LAS int* ctab) {
    LAS int* wt = ctab + 512;
    int v = 0;
    LAS unsigned short* lpre = (LAS unsigned short*)((LAS char*)ctab + MOBA_LPRE_OFF);
    if (F.tid < 496) { const int bh = F.tid / 31, j = F.tid - bh * 31; int n = 0;
        int cvs[32]; cvs[0] = 0;
#pragma unroll
        for (int qb = 1; qb < 32; ++qb) cvs[qb] = CNT[(bh * 32 + qb) * 32 + j];
#pragma unroll
        for (int qb = 0; qb < 32; ++qb) { lpre[F.tid * 33 + qb] = (unsigned short)n; n += (qb > j) ? cvs[qb] : 0; }
        lpre[F.tid * 33 + 32] = (unsigned short)n;
        v = (n + 255) >> 8; }
    int incl = v;
#pragma unroll
    for (int o_ = 1; o_ < 64; o_ <<= 1) { const int x_ = __shfl_up(incl, o_); if (F.lane >= o_) incl += x_; }
    if (F.lane == 63) wt[F.wave] = incl;
    __syncthreads();
    int off = 0;
    for (int w_ = 0; w_ < F.wave; ++w_) off += wt[w_];
    ctab[F.tid] = off + incl - v;
    if (F.tid == 511) ctab[512 + 16] = off + incl;
    __syncthreads();
    return ctab[512 + 16];
}
__device__ __forceinline__ void moba_build_list(Frame& F, const unsigned* SEL, const int* CNT, int bh, int j, int c, LAS unsigned* rinfo, LAS int* wc) {
    const int tid = F.tid, lane = F.lane, wid = F.wave;
    if (tid < 256) rinfo[tid] = 0xFFFFFFFFu;
    __syncthreads();
    const int lo = 256 * c, hi_ = lo + 256;
    const int qbl = lane & 31;
    const LAS unsigned short* lp = (const LAS unsigned short*)((const LAS char*)F.lds + 98304 + MOBA_LPRE_OFF) + (bh * 31 + j) * 33 + qbl;
    const int start = (int)lp[0], cq = (int)lp[1] - start;
    const bool ov = cq > 0 && start < hi_ && start + cq > lo;
    unsigned ovm = (unsigned)__ballot(ov && lane < 32);
    for (int k = 0; ovm != 0u; ++k) {
        const int qb = __builtin_ctz(ovm); ovm &= ovm - 1u;
        if ((k & 7) != wid) continue;
        const int base = __shfl(start, qb);
        const u32x4 w4 = *(const u32x4*)(SEL + (size_t)bh * SEQ + qb * 256 + lane * 4);
        int f[4]; int n = 0;
#pragma unroll
        for (int e = 0; e < 4; ++e) { f[e] = (w4[e] >> j) & 1u; n += f[e]; }
        int inc2 = n;
#pragma unroll
        for (int o_ = 1; o_ < 64; o_ <<= 1) { const int v_ = __shfl_up(inc2, o_); if (lane >= o_) inc2 += v_; }
        int pos = base + inc2 - n;
#pragma unroll
        for (int e = 0; e < 4; ++e) { if (f[e]) { if (pos >= lo && pos < hi_) rinfo[pos - lo] = (unsigned)(qb * 256 + lane * 4 + e) | ((unsigned)__builtin_popcount(w4[e] & ((1u << j) - 1u)) << 16); ++pos; } }
    }
    __syncthreads();
}
__device__ __forceinline__ void moba_combine(Frame& F, bf16* O, const bf16* PO, const float* LSEP) {
    const int gw = F.vcu * NWAVES + F.wave, NGW = F.G * NWAVES, lane = F.lane, h = lane >> 3;
    for (int m0 = gw; m0 < T; m0 += 2 * NGW) {
        int mr[2]; mr[0] = m0; mr[1] = (m0 + NGW < T) ? m0 + NGW : m0; const bool two = m0 + NGW < T;
        float l[2][4]; bf16x8 da[2][4], db[2][4];
#pragma unroll
        for (int q = 0; q < 2; ++q) {
#pragma unroll
            for (int s_ = 0; s_ < 4; ++s_) { l[q][s_] = LSEP[((size_t)s_ * T + mr[q]) * 8 + h];
                const bf16* p = s_ == 3 ? O + (size_t)mr[q] * DM + lane * 16 : PO + ((size_t)s_ * T + mr[q]) * 1024 + lane * 16;
                da[q][s_] = *(const bf16x8*)p; db[q][s_] = *(const bf16x8*)(p + 8); } }
#pragma unroll
        for (int q = 0; q < 2; ++q) { if (q == 1 && !two) break;
            float w[4];
            const float mx = fmaxf(fmaxf(l[q][0], l[q][1]), fmaxf(l[q][2], l[q][3]));
            float ssum = 0.f;
#pragma unroll
            for (int s_ = 0; s_ < 4; ++s_) { w[s_] = __builtin_amdgcn_exp2f(l[q][s_] - mx); ssum += w[s_]; }
            const float inv = 1.f / ssum;
            float acc[16];
            { const bf16x8 a = da[q][3], b = db[q][3]; const float wg = w[3] * inv;
#pragma unroll
              for (int j = 0; j < 8; ++j) { acc[j] = wg * bf2f((unsigned short)a[j]); acc[8 + j] = wg * bf2f((unsigned short)b[j]); } }
#pragma unroll
            for (int s_ = 0; s_ < 3; ++s_) { const bool on = w[s_] > 0.f; const bf16x8 a = da[q][s_], b = db[q][s_]; const float wg = w[s_] * inv;
#pragma unroll
                for (int j = 0; j < 8; ++j) { const float xa = wg * bf2f((unsigned short)a[j]), xb = wg * bf2f((unsigned short)b[j]);
                    acc[j] += on ? xa : 0.f; acc[8 + j] += on ? xb : 0.f; } }
            bf16* op = O + (size_t)mr[q] * DM + lane * 16;
            *(bf16x8*)op = att::pack8((f32x4){acc[0], acc[1], acc[2], acc[3]}, (f32x4){acc[4], acc[5], acc[6], acc[7]});
            *(bf16x8*)(op + 8) = att::pack8((f32x4){acc[8], acc[9], acc[10], acc[11]}, (f32x4){acc[12], acc[13], acc[14], acc[15]}); }
    }
}
__global__ void __launch_bounds__(NWAVES * 64, 2) __attribute__((target("no-packed-fp32-ops"))) fwd_kernel(Args args) {
    extern __shared__ __attribute__((aligned(16))) unsigned char lds_raw[];
    Frame F;
    F.lds = (LAS unsigned char*)lds_raw;
    F.tid = threadIdx.x; F.lane = F.tid & 63; F.wave = __builtin_amdgcn_readfirstlane(F.tid >> 6);
    F.G = gridDim.x; { const int bx = blockIdx.x; F.vcu = (F.G % 8 == 0) ? (bx % 8) * (F.G / 8) + bx / 8 : bx; }
    F.ws = args.ws;
    volatile LAS unsigned* MISC = (volatile LAS unsigned*)(F.lds + MISC_OFF);
    for (int u = F.tid; u < (LDS_BYTES - MISC_OFF) / 4; u += NWAVES * 64) ((LAS unsigned*)(F.lds + MISC_OFF))[u] = 0u;
    __syncthreads();
    unsigned* ctl = (unsigned*)(F.ws + WS_CTL);
    XcdBarrier bar = xcd_barrier_post(ctl + CW_BAR, MISC + 8);
    const int lo = args.ph_lo, hi = args.ph_hi;
#ifndef REPMASK
#define REPMASK 0ull
#endif
#define REP(k) ((((REPMASK) >> (k)) & 1ull) ? 2 : 1)
#ifndef ONLY_MODE
#define ONLY_MODE (-1)
#endif
#ifndef PHMASK
#define PHMASK 0xFFFFFFFFull
#endif
#define IN(k) ((((PHMASK) >> (k)) & 1ull) && lo <= (k) && (k) < hi)
#ifdef DIAG_BARWAIT
    unsigned long long diag_acc = 0ull, diag_t0 = 0ull;
#define GRID_BAR() do { const unsigned long long t0_ = __builtin_amdgcn_s_memrealtime(); xcd_barrier(bar); if (DIAG_BARWAIT == 1) diag_acc += __builtin_amdgcn_s_memrealtime() - t0_; } while (0)
#define DT0(m_) do { if (DIAG_BARWAIT == (m_)) diag_t0 = __builtin_amdgcn_s_memrealtime(); } while (0)
#define DT1(m_) do { if (DIAG_BARWAIT == (m_)) diag_acc += __builtin_amdgcn_s_memrealtime() - diag_t0; } while (0)
#else
#define DT0(m_) do { } while (0)
#define DT1(m_) do { } while (0)
#define GRID_BAR() do { xcd_barrier(bar); if (REP(30) == 2) { xcd_barrier(bar); xcd_barrier(bar); } } while (0)
#endif

#define x_in     (args.in[0])
#define ln_mix   (args.in[1])
#define ln_mlp   (args.in[2])
#define ln_final (args.in[3])
#define e_w_in   (args.in[4])
#define e_g_q    (args.in[5])
#define e_g_kv   (args.in[6])
#define e_w_uq   (args.in[7])
#define e_w_ukv  (args.in[8])
#define e_w_out  (args.in[9])
#define o_w_in   (args.in[10])
#define o_w_out  (args.in[11])
#define mlp_w1   (args.in[12])
#define mlp_w2   (args.in[13])
    float* X = args.out;
    bf16* PROJ = (bf16*)(F.ws + WS_PROJ); bf16* PROJ2 = (bf16*)(F.ws + WS_PROJ2);
    const float* c128 = (const float*)(F.ws + WS_COS128); const float* s128 = (const float*)(F.ws + WS_SIN128);
    const float* c64 = (const float*)(F.ws + WS_COS64); const float* s64 = (const float*)(F.ws + WS_SIN64);

    DT0(8);
#ifdef SPIN_TICKS
    { const unsigned long long t0_ = __builtin_amdgcn_s_memrealtime(); while (__builtin_amdgcn_s_memrealtime() - t0_ < (unsigned long long)(SPIN_TICKS)) __builtin_amdgcn_s_sleep(8); }
#endif
    if (IN(0)) { for (int rep = 0; rep < REP(0); ++rep) {
        int crot = 0;
        convert_weight(F, e_w_in, DM, EVEN_IN, (bf16*)(F.ws + WS_WIN_E), nullptr, 2, &crot);
        convert_weight(F, e_w_uq, 512, 1536, (bf16*)(F.ws + WS_WUQ), e_g_q, 3, &crot);
        convert_weight(F, e_w_ukv, 256, 2048, (bf16*)(F.ws + WS_WUKV), e_g_kv, 0, &crot);
        convert_weight(F, e_w_out, DM, DM, (bf16*)(F.ws + WS_WOUT_E), nullptr, 0, &crot);
        convert_weight(F, o_w_in, DM, ODD_IN, (bf16*)(F.ws + WS_WIN_O), ln_mix + DM, 1, &crot);
        convert_weight(F, o_w_out, DM, DM, (bf16*)(F.ws + WS_WOUT_O), nullptr, 0, &crot);
        { u32x4* z = (u32x4*)((bf16*)(F.ws + WS_WIN_E) + (size_t)5024 * DM); const int n16 = 96 * DM * 2 / 16;
            for (int i = F.vcu * 512 + F.tid; i < n16; i += F.G * 512) z[i] = (u32x4){0u, 0u, 0u, 0u}; }
        rope_tables(F);
        rms_rows(F, x_in, ln_mix, (bf16*)(F.ws + WS_H0)); }
        GRID_BAR();
    }
    if (IN(1)) {
        pg8::Gemm g{(const bf16*)(F.ws + WS_H0), (const bf16*)(F.ws + WS_WIN_E), T, EVEN_INP, DM, DM, DM};
        pg8::StaticOrder S; S.init(T, EVEN_INP, F.G, (int)blockIdx.x);
        pg8::EpiRopeEven E{PROJ, EVEN_INP, c128, s128, c64, s64, (float*)(F.ws + WS_SSQ)};
        for (int rep = 0; rep < REP(1); ++rep) { DT0(2); pg8::gemm_phase(F.lds, g, S, E); DT1(2); }
        GRID_BAR();
    }
    if (IN(3)) {
        DT0(4);
        for (int rep = 0; rep < REP(3); ++rep)
        for (int it = blockIdx.x; it < 256; it += F.G) { const int b = it >> 7, p = it & 127;
            indexer_unit(F, b, 255 - p); indexer_unit(F, b, p); }
        DT1(4);
        GRID_BAR();
    }
    if (IN(4)) {
        { pg8::Gemm g{PROJ + EC_CQ, (const bf16*)(F.ws + WS_WUQ), T, 1536, 512, EVEN_INP, 512};
          pg8::StaticOrder S; S.init(T, 1536, F.G, (int)blockIdx.x);
          pg8::EpiUp<0, 8, 512, true> E{(bf16*)(F.ws + WS_Q), 1536, (const float*)(F.ws + WS_SSQ), c64, s64};
          { DT0(2); pg8::gemm_phase(F.lds, g, S, E); DT1(2); } }
        { pg8::Gemm g{PROJ + EC_CKV, (const bf16*)(F.ws + WS_WUKV), T, 2048, 256, EVEN_INP, 256};
          pg8::StaticOrder S; S.init(T, 2048, F.G, (int)blockIdx.x); S.kvbal = (F.G == 256);
          pg8::EpiUp<8, 4, 256, false> E{(bf16*)(F.ws + WS_KV), 2048, (const float*)(F.ws + WS_SSQ), c64, s64};
          { DT0(2); pg8::gemm_phase(F.lds, g, S, E); DT1(2); } }
        GRID_BAR();
    }
    if (IN(5)) { DT0(3);
        bf16* O = (bf16*)(F.ws + WS_H0);
        for (int it = F.vcu; it < 256; it += F.G) { const int bh = it >> 4, pi = it & 15, b = bh >> 3, h = bh & 7;
            const size_t r0 = (size_t)b * SEQ;
            for (int pass = 0; pass < 2 * REP(20); ++pass) { const int qb = (pass & 1) ? pi : 31 - pi;
                att::UnitArgs U{};
                U.Q = (const bf16*)(F.ws + WS_Q) + r0 * 1536 + h * 192; U.qpitch = 1536;
                U.K = (const bf16*)(F.ws + WS_KV) + r0 * 2048 + h * 256; U.kpitch = 2048;
                U.V = U.K + 128; U.vpitch = 2048;
                U.PE = PROJ + r0 * EVEN_INP + EC_KPE; U.pepitch = EVEN_INP;
                U.O = O + r0 * DM + h * 128; U.opitch = DM;
                U.cosT = c64; U.sinT = s64; U.pos0 = 0; U.posstride = 1; U.P0 = qb * 256;
                if (ONLY_MODE < 0 || ONLY_MODE == 0) att::attn_unit<att::MODE_MLA>((LAS char*)F.lds, U); }
            for (int pass = 0; pass < 2 * REP(21); ++pass) { const int qb = (pass & 1) ? pi : 31 - pi;
                att::UnitArgs U{};
                U.Q = PROJ + r0 * EVEN_INP + EC_Q + h * 128; U.qpitch = EVEN_INP;
                U.K = PROJ + r0 * EVEN_INP + EC_K + h * 128; U.kpitch = EVEN_INP;
                U.V = PROJ + r0 * EVEN_INP + EC_V + h * 128; U.vpitch = EVEN_INP;
                U.O = O + r0 * DM + 1024 + h * 128; U.opitch = DM;
                U.cosT = c128; U.sinT = s128; U.pos0 = 0; U.posstride = 1; U.P0 = qb * 256;
                U.BM = (const unsigned*)(F.ws + WS_BM) + r0 * 256;
                if (ONLY_MODE < 0 || ONLY_MODE == 1) att::attn_unit<att::MODE_DSA>((LAS char*)F.lds, U); }
        }
        DT1(3);
        GRID_BAR();
    }
    if (IN(6)) {
        convert_weight(F, mlp_w1 + (size_t)0 * DM * DFF, DM, DFF, (bf16*)(F.ws + WS_W1B), ln_mlp + 0 * DM);
        convert_weight(F, mlp_w2 + (size_t)0 * DM * DFF, DFF, DM, (bf16*)(F.ws + WS_W2B));
        __syncthreads();
        pg8::Gemm g{(const bf16*)(F.ws + WS_H0), (const bf16*)(F.ws + WS_WOUT_E), T, DM, DM, DM, DM};
        pg8::StaticOrder S; S.init(T, DM, F.G, (int)blockIdx.x);
        pg8::EpiResBf16<true> E{x_in, (bf16*)(F.ws + WS_XB), (float*)(F.ws + WS_SSQ), DM};
        for (int rep = 0; rep < REP(6); ++rep) { DT0(2); pg8::gemm_phase(F.lds, g, S, E); DT1(2); }
        GRID_BAR();
    }
#ifdef DIAG_BARWAIT
#define DIAG_PUBLISH(L_) do { if ((L_) == 1) DT1(8); if ((L_) == 1 && F.tid == 0) __hip_atomic_fetch_add((unsigned long long*)(ctl + 8192), diag_acc, __ATOMIC_RELAXED, __HIP_MEMORY_SCOPE_AGENT); } while (0)
#else
#define DIAG_PUBLISH(L_) do { } while (0)
#endif
#define MLP_PHASES(LAYER) do { \
        if (IN(9)) { \
            pg8::Gemm g{(const bf16*)(F.ws + WS_XB), (const bf16*)(F.ws + WS_W1B), T, DFF, DM, DM, DM}; \
            pg8::StaticOrder S; S.init(T, DFF, F.G, (int)blockIdx.x); \
            pg8::EpiBf16<1, true> E{(bf16*)(F.ws + WS_HID), DFF, (const float*)(F.ws + WS_SSQ)}; \
            for (int rep = 0; rep < REP(9); ++rep) { DT0(2); pg8::gemm_phase(F.lds, g, S, E); DT1(2); } \
            GRID_BAR(); \
        } \
        if (IN(10)) { \
            pg8::Gemm g{(const bf16*)(F.ws + WS_HID), (const bf16*)(F.ws + WS_W2B), T, DM, DFF, DFF, DFF}; \
            pg8::StaticOrder S; S.init(T, DM, F.G, (int)blockIdx.x); \
            pg8::EpiResBf16<false> E{(const bf16*)(F.ws + WS_XB), (bf16*)(F.ws + WS_XB), (float*)(F.ws + WS_SSQ), DM}; \
            { DT0(2); pg8::gemm_phase(F.lds, g, S, E); DT1(2); } \
            DIAG_PUBLISH(LAYER); \
            GRID_BAR(); \
        } \
    } while (0)
    MLP_PHASES(0);
            if (IN(12)) {
                pg8::Gemm g{(const bf16*)(F.ws + WS_XB), (const bf16*)(F.ws + WS_WIN_O), T, ODD_IN, DM, DM, DM};
                pg8::StaticOrder S; S.init(T, ODD_IN, F.G, (int)blockIdx.x);
                pg8::EpiRopeOdd E{PROJ2, ODD_IN, c128, s128, (float*)(F.ws + WS_KM), (const float*)(F.ws + WS_SSQ)};
                for (int rep = 0; rep < REP(12); ++rep) { DT0(2); pg8::gemm_phase(F.lds, g, S, E); DT1(2); }
                GRID_BAR();
            }
            if (IN(14)) { DT0(5);
                bf16* O = (bf16*)(F.ws + WS_H1);
                for (int it = F.vcu; it < 256; it += F.G) { const int bh = it >> 4, pi = it & 15, b = bh >> 3, h = bh & 7;
                    const size_t r0 = (size_t)b * SEQ;
                    for (int pass = 0; pass < 2 * (REP(22) == 2 ? 5 : 1); ++pass) { const int qb = (pass & 1) ? pi : 31 - pi;
                        att::UnitArgs U{};
                        U.Q = PROJ2 + r0 * ODD_IN + OC_QC + h * 128; U.qpitch = ODD_IN;
                        U.K = PROJ2 + r0 * ODD_IN + OC_KC + h * 128; U.kpitch = ODD_IN;
                        U.V = PROJ2 + r0 * ODD_IN + OC_VC + h * 128; U.vpitch = ODD_IN;
                        U.O = O + r0 * DM + h * 128; U.opitch = DM;
                        U.cosT = c128; U.sinT = s128; U.pos0 = 0; U.posstride = 1; U.P0 = qb * 256; U.own = qb;
                        U.KMP = (const float*)(F.ws + WS_KM) + (size_t)bh * 32 * 512;
                        U.LSE = (float*)(F.ws + WS_MLSE) + r0 * 8 + h; U.lse_stride = 8; U.lslot = (size_t)T * 8;
                        U.SEL = (unsigned*)(F.ws + WS_SEL) + (size_t)bh * SEQ; U.CNT = (int*)(F.ws + WS_CNT) + (bh * 32 + qb) * 32;
                        if (ONLY_MODE < 0 || ONLY_MODE == 2) att::attn_unit<att::MODE_MOWN>((LAS char*)F.lds, U); }
                    for (int k6 = 0; k6 < 6 * REP(23); ++k6) { const int k = k6 % 6; const int w = k * 16 + pi, gi = w >> 5, u = w & 31;
                        const int d = gi == 0 ? 1 : (gi == 1 ? 4 : 16);
                        const int r = gi == 0 ? 0 : (gi == 1 ? (u >> 3) : (u >> 1)), qb = gi == 0 ? u : (gi == 1 ? (u & 7) : (u & 1));
                        att::UnitArgs U{};
                        const bf16* base = PROJ2 + (r0 + r) * ODD_IN + h * 128;
                        U.Q = base + OC_QD; U.K = base + OC_KD; U.V = base + OC_VD; U.qpitch = U.kpitch = U.vpitch = (size_t)d * ODD_IN;
                        if (gi == 0) { U.O = O + r0 * DM + 1024 + h * 128; U.opitch = DM; }
                        else { U.O = (bf16*)(F.ws + WS_OG) + ((size_t)(gi - 1) * T + r0 + r) * 1024 + h * 128; U.opitch = (size_t)d * 1024; }
                        U.LSE = (float*)(F.ws + WS_LSE) + ((size_t)gi * T + r0 + r) * 8 + h; U.lse_stride = d * 8;
                        U.cosT = c128; U.sinT = s128; U.pos0 = r; U.posstride = d; U.P0 = qb * 256;
                        if (ONLY_MODE < 0 || ONLY_MODE == 3) att::attn_unit<att::MODE_DIL>((LAS char*)F.lds, U); }
                }
                DT1(5);
                GRID_BAR();
            }
            if (IN(17)) { DT0(7); dil_combine(F, (bf16*)(F.ws + WS_H1), (const bf16*)(F.ws + WS_OG));
                const unsigned* SEL = (const unsigned*)(F.ws + WS_SEL); const int* CNT = (const int*)(F.ws + WS_CNT);
                LAS int* ctab = (LAS int*)(F.lds + 98304);
                LAS unsigned* rinfo = (LAS unsigned*)(F.lds + att::OFF_TL); LAS int* wc = (LAS int*)(F.lds + att::OFF_LB);
                for (int rep = 0; rep < REP(17); ++rep) {
                const int total = moba_chunk_table(F, CNT, ctab);
                for (int id = F.vcu; id < total; id += F.G) {
                    int lo_ = 0, hi_ = 496;
                    while (hi_ - lo_ > 1) { const int mid = (lo_ + hi_) >> 1; if (ctab[mid] <= id) lo_ = mid; else hi_ = mid; }
                    const int li = lo_, c = id - ctab[li], bh = li / 31, j = li - bh * 31, b = bh >> 3, h = bh & 7;
                    const size_t r0 = (size_t)b * SEQ;
                    att::UnitArgs U{};
                    U.Q = PROJ2 + r0 * ODD_IN + OC_QC + h * 128; U.qpitch = ODD_IN;
                    U.K = PROJ2 + r0 * ODD_IN + OC_KC + h * 128; U.kpitch = ODD_IN;
                    U.V = PROJ2 + r0 * ODD_IN + OC_VC + h * 128; U.vpitch = ODD_IN;
                    U.O = (bf16*)(F.ws + WS_MPO) + r0 * 1024 + h * 128; U.opitch = 1024; U.oslot = (size_t)T * 1024;
                    U.LSE = (float*)(F.ws + WS_MLSE) + r0 * 8 + h; U.lse_stride = 8; U.lslot = (size_t)T * 8;
                    U.cosT = c128; U.sinT = s128; U.pos0 = 0; U.posstride = 1; U.P0 = 0; U.own = j;
                    att::attn_preload_msel((LAS char*)F.lds, U);
                    moba_build_list(F, SEL, CNT, bh, j, c, rinfo, wc);
                    att::attn_unit<att::MODE_MSEL>((LAS char*)F.lds, U);
                } }
                DT1(7);
                GRID_BAR();
            }
            if (IN(15)) { DT0(6); moba_combine(F, (bf16*)(F.ws + WS_H1), (const bf16*)(F.ws + WS_MPO), (const float*)(F.ws + WS_MLSE)); DT1(6); GRID_BAR(); }
            if (IN(16)) {
                convert_weight(F, mlp_w1 + (size_t)1 * DM * DFF, DM, DFF, (bf16*)(F.ws + WS_W1B), ln_mlp + 1 * DM);
                convert_weight(F, mlp_w2 + (size_t)1 * DM * DFF, DFF, DM, (bf16*)(F.ws + WS_W2B));
                __syncthreads();
                pg8::Gemm g{(const bf16*)(F.ws + WS_H1), (const bf16*)(F.ws + WS_WOUT_O), T, DM, DM, DM, DM};
                pg8::StaticOrder S; S.init(T, DM, F.G, (int)blockIdx.x);
                pg8::EpiResBf16<false> E{(const bf16*)(F.ws + WS_XB), (bf16*)(F.ws + WS_XB), (float*)(F.ws + WS_SSQ), DM};
                { DT0(2); pg8::gemm_phase(F.lds, g, S, E); DT1(2); }
                GRID_BAR();
            }
    MLP_PHASES(1);
#undef MLP_PHASES
#ifdef DIAG_BARWAIT
    float diag_scale = 1.f;
    { unsigned long long* dw = (unsigned long long*)(ctl + 8192);
      const unsigned long long tot = __hip_atomic_load(dw, __ATOMIC_RELAXED, __HIP_MEMORY_SCOPE_AGENT);
      const float avg_us = floorf((float)tot * 0.01f / (float)F.G / 8.f) * 8.f; diag_scale = 1.f + sqrtf(avg_us * (DIAG_BARWAIT == 2 ? 2e-7f : (DIAG_BARWAIT == 8 ? 1e-7f : 1e-6f))); }
    if (IN(19)) rms_rows_final(F, (const bf16*)(F.ws + WS_XB), (const float*)(F.ws + WS_SSQ), X, ln_final, diag_scale);
#else
    if (IN(19)) rms_rows_final(F, (const bf16*)(F.ws + WS_XB), (const float*)(F.ws + WS_SSQ), X, ln_final);
#endif
#undef IN
#undef GRID_BAR
#undef x_in
#undef ln_mix
#undef ln_mlp
#undef ln_final
#undef e_w_in
#undef e_g_q
#undef e_g_kv
#undef e_w_uq
#undef e_w_ukv
#undef e_w_out
#undef o_w_in
#undef o_w_out
#undef mlp_w1
#undef mlp_w2
}

extern "C" void kernel_launch(void* const* d_in, const int* in_sizes, int n_in, void* d_out, int out_size, void* d_ws, size_t ws_size, hipStream_t stream) {
    static int grid = 0;
    if (grid == 0) {
        if (n_in != 14 || out_size != T * DM || ws_size < WS_END) { fprintf(stderr, "kernel_launch: unexpected shapes (n_in %d out %d ws %zu)\n", n_in, out_size, ws_size); grid = -1; return; }
        int dev = 0, cus = 0, per_cu = 0;
        if (hipGetDevice(&dev) != hipSuccess || hipDeviceGetAttribute(&cus, hipDeviceAttributeMultiprocessorCount, dev) != hipSuccess) { grid = -1; return; }
        if (hipFuncSetAttribute((const void*)fwd_kernel, hipFuncAttributeMaxDynamicSharedMemorySize, LDS_BYTES) != hipSuccess) { fprintf(stderr, "kernel_launch: hipFuncSetAttribute failed\n"); grid = -1; return; }
        if (hipOccupancyMaxActiveBlocksPerMultiprocessor(&per_cu, (const void*)fwd_kernel, NWAVES * 64, LDS_BYTES) != hipSuccess || per_cu < 1)
            fprintf(stderr, "kernel_launch: occupancy query reports %d\n", per_cu);
        (void)hipGetLastError();
        grid = cus;
    }
    if (grid < 0) return;
    (void)hipMemsetAsync((char*)d_ws + WS_CTL, 0, CTL_ZERO_BYTES, stream);
    Args a{};
    for (int i = 0; i < 14; ++i) a.in[i] = (const float*)d_in[i];
    a.out = (float*)d_out; a.ws = (unsigned char*)d_ws; a.ph_lo = 0; a.ph_hi = 64;
    hipLaunchKernelGGL(fwd_kernel, dim3(grid), dim3(NWAVES * 64), LDS_BYTES, stream, a);
}
```

```cpp
#include <hip/hip_runtime.h>
#include <cstdio>
#include <cstdint>

#define GAS __attribute__((address_space(1)))
#define LAS __attribute__((address_space(3)))
typedef unsigned short bf16;
typedef short bf16x8 __attribute__((ext_vector_type(8)));
typedef short s16x4 __attribute__((ext_vector_type(4)));
typedef float f32x4 __attribute__((ext_vector_type(4)));
typedef float f32x2 __attribute__((ext_vector_type(2)));
typedef float f32x16 __attribute__((ext_vector_type(16)));
typedef unsigned u32x4 __attribute__((ext_vector_type(4)));
typedef unsigned u32x2 __attribute__((ext_vector_type(2)));

constexpr int DM = 2048, BATCH = 2, SEQ = 8192, T = BATCH * SEQ, DFF = 8192;
constexpr int EVEN_IN = 5008, EVEN_INP = 5120, ODD_IN = 6144;
constexpr float NORM_EPS = 1e-6f;
constexpr int EC_CQ = 0, EC_CKV = 512, EC_KPE = 768, EC_Q = 832, EC_K = 1856, EC_V = 2880, EC_QI = 3904, EC_KI = 4928, EC_WI = 4992;
constexpr int OC_QC = 0, OC_KC = 1024, OC_VC = 2048, OC_QD = 3072, OC_KD = 4096, OC_VD = 5120;

constexpr size_t MiB = 1u << 20;
constexpr size_t WS_CTL = 0, CTL_ZERO_BYTES = 32768;
constexpr size_t WS_COS128 = 1 * MiB, WS_SIN128 = 3 * MiB, WS_COS64 = 5 * MiB, WS_SIN64 = 6 * MiB;
constexpr size_t WS_KM = 7 * MiB;
constexpr size_t WS_WOUT_O = 8 * MiB, WS_WIN_E = 16 * MiB, WS_WUQ = 36 * MiB, WS_WUKV = 38 * MiB, WS_WOUT_E = 39 * MiB, WS_WIN_O = 47 * MiB;
constexpr size_t WS_BM = 71 * MiB;
constexpr size_t WS_PROJ = 87 * MiB;
constexpr size_t WS_H0 = 247 * MiB;
constexpr size_t WS_SC = 247 * MiB;
constexpr size_t WS_Q = 311 * MiB, WS_KV = 359 * MiB;
constexpr size_t WS_H2 = 87 * MiB, WS_HID = 151 * MiB, WS_W1B = 407 * MiB, WS_W2B = 439 * MiB;
constexpr size_t WS_XB = 87 * MiB;
constexpr size_t WS_PROJ2 = 151 * MiB;
constexpr size_t WS_H1 = 343 * MiB;
constexpr size_t WS_SSQ = 509 * MiB;
constexpr size_t WS_OG = 16 * MiB;
constexpr size_t WS_MPO = 407 * MiB;
constexpr size_t WS_LSE = 503 * MiB;
constexpr size_t WS_MLSE = 505 * MiB;
constexpr size_t WS_SEL = 507 * MiB;
constexpr size_t WS_CNT = 508 * MiB;
constexpr size_t WS_END = 512 * MiB;
constexpr int CW_TMO = 0, CW_BAR = 4096;

constexpr int RING_BYTES = 131072;
constexpr int MISC_OFF = 147200;
constexpr int LDS_BYTES = 147456;
constexpr int NWAVES = 8;

__device__ __forceinline__ unsigned cvt_pk_bf16(float lo, float hi) { unsigned r; asm volatile("v_cvt_pk_bf16_f32 %0, %1, %2" : "=v"(r) : "v"(lo), "v"(hi)); return r; }
__device__ __forceinline__ float bf2f(unsigned short b) { return __builtin_bit_cast(float, ((unsigned)b) << 16); }
__device__ __forceinline__ float wave_sum(float v) {
#pragma unroll
    for (int o = 1; o < 64; o <<= 1) v += __shfl_xor(v, o);
    return v;
}
#define LDS_WAIT() asm volatile("s_waitcnt lgkmcnt(0)" ::: "memory")
#define VM_WAIT() asm volatile("s_waitcnt vmcnt(0)" ::: "memory")

namespace pg8 {
constexpr int BM = 256, BK = 64, HALF = 128, HTB = HALF * BK * 2, STAGE_BYTES = 8 * HTB, NXCD = 8, WGM = 4;
__host__ __device__ __forceinline__ int lds_byte(int r, int c) { const int st = (r >> 4) * 2 + (c >> 5), rr = r & 15, cc = c & 31, ob = rr * 64 + cc * 2; return st * 1024 + (ob ^ (((ob >> 9) & 1) << 5)); }
__host__ __device__ __forceinline__ void stage_rc(int b, int& R, int& C) { const int st = b / 1024, sb = b % 1024, swz = sb ^ (((sb >> 9) & 1) << 5); R = (st >> 1) * 16 + swz / 64; C = (st & 1) * 32 + (swz % 64) / 2; }
__host__ __device__ __forceinline__ int perm32(int rho) { const int n = rho >> 4, i = rho & 15; return 8 * (i >> 2) + 4 * n + (i & 3); }

struct Unit { int pm, pn; };
struct Gemm { const bf16* A; const bf16* Bt; int M, N, K, lda, ldb; };

struct StaticOrder {
    int nM, nN, nwg, G, c, kvbal;
    __host__ __device__ __forceinline__ void init(int M, int N, int G_, int c_) { nM = M / BM; nN = N / BM; nwg = nM * nN; G = G_; c = c_; kvbal = 0; }
    __host__ __device__ __forceinline__ bool next(int i, Unit& u) const {
        long L = (long)i * G + c;
        if (kvbal) {
            if (c < 128) L = i == 0 ? c : nwg; else L = i < 3 ? 128 + 3 * (c - 128) + i : nwg; }
        if (L >= nwg) return false;
        int wgid = (int)L; { const int q = nwg / NXCD, r = nwg % NXCD, xcd = wgid % NXCD, off = wgid / NXCD; wgid = (xcd < r ? xcd * (q + 1) : r * (q + 1) + (xcd - r) * q) + off; }
        const int nig = WGM * nN, gid = wgid / nig, fm = gid * WGM, gsz = (nM - fm) < WGM ? (nM - fm) : WGM;
        u.pm = fm + ((wgid % nig) % gsz); u.pn = (wgid % nig) / gsz; return true;
    }
};

template <int ACT  , bool SCALED = false> struct EpiBf16 {
    static constexpr bool PERM = true;
    static constexpr bool HAS_PRE = SCALED;
    bf16* O; int ldc; const float* ssq;
    __device__ __forceinline__ void pre_issue(const Unit& u, int wr, int wc, int fr, int fq, f32x4 (&raw)[2][2]) const {
        const int row0 = u.pm * BM + wr * 64 + fr + wc * 16;
#pragma unroll
        for (int ai = 0; ai < 2; ++ai) { const float* sp = ssq + (size_t)(row0 + ai * HALF) * 32 + fq * 8; raw[ai][0] = *(const f32x4*)sp; raw[ai][1] = *(const f32x4*)(sp + 4); }
    }
    __device__ __forceinline__ void pre_finish(const f32x4 (&raw)[2][2], float (&rs)[2]) const {
#pragma unroll
        for (int ai = 0; ai < 2; ++ai) { const f32x4 a = raw[ai][0], b = raw[ai][1];
            float s = ((a[0] + a[1]) + (a[2] + a[3])) + ((b[0] + b[1]) + (b[2] + b[3]));
            s += __shfl_xor(s, 16); s += __shfl_xor(s, 32);
            rs[ai] = __builtin_amdgcn_rsqf(s * (1.f / DM) + NORM_EPS); }
    }
    __device__ __forceinline__ void half(const f32x4 (&acc)[2][2][4][2], const Unit& u, int ai, int wr, int wc, int fr, int fq, const float (&rs)[4]) const {
        const int row0 = u.pm * BM + wr * 64 + fr; const int col0 = u.pn * BM + wc * 32 + 8 * fq;
#pragma unroll
        for (int m = 0; m < 4; ++m) { bf16* rowp = O + (size_t)(row0 + ai * HALF + m * 16) * ldc + col0;
#pragma unroll
            for (int bj = 0; bj < 2; ++bj) { f32x4 v0 = acc[ai][bj][m][0], v1 = acc[ai][bj][m][1];
                if constexpr (SCALED) { v0 = v0 * rs[m]; v1 = v1 * rs[m]; }
                if (ACT == 1) {
#pragma unroll
                    for (int j = 0; j < 4; ++j) { const float a = fmaxf(v0[j], 0.f), b = fmaxf(v1[j], 0.f); v0[j] = a * a; v1[j] = b * b; } }
                u32x4 w; w.x = cvt_pk_bf16(v0[0], v0[1]); w.y = cvt_pk_bf16(v0[2], v0[3]); w.z = cvt_pk_bf16(v1[0], v1[1]); w.w = cvt_pk_bf16(v1[2], v1[3]);
                *(u32x4*)(rowp + bj * HALF) = w; } }
    }
};
struct EpiRopeOdd {
    static constexpr bool PERM = true;
    static constexpr bool HAS_PRE = false;
    bf16* O; int ldc; const float* cosT; const float* sinT; float* KMP; const float* ssq;
    __device__ __forceinline__ void operator()(const f32x4 (&acc)[2][2][4][2], const Unit& u, int wr, int wc, int fr, int fq) const {
        const int row0 = u.pm * BM + wr * 64 + fr; const int col0 = u.pn * BM + wc * 32 + 8 * fq;
        const bool roped = (u.pn < 8) || (u.pn >= 12 && u.pn < 20);
        const bool ksum = (u.pn >= 4 && u.pn < 8);
        float colsum[2][2][8];
#pragma unroll
        for (int ai = 0; ai < 2; ++ai)
#pragma unroll
            for (int bj = 0; bj < 2; ++bj)
#pragma unroll
                for (int e = 0; e < 8; ++e) colsum[ai][bj][e] = 0.f;
        struct Ld { f32x4 a, b, cs[2], sn[2]; };
        Ld L[2];
#define ERO_ISSUE(g_, D_) do { const int row_ = row0 + ((g_) >> 2) * HALF + ((g_) & 3) * 16; const float* sp_ = ssq + (size_t)row_ * 32 + fq * 8; D_.a = *(const f32x4*)sp_; D_.b = *(const f32x4*)(sp_ + 4); \
            if (roped) { const int pos_ = row_ & (SEQ - 1); _Pragma("unroll") for (int bj_ = 0; bj_ < 2; ++bj_) { const int i0_ = ((col0 + bj_ * HALF) & 127) >> 1; \
                D_.cs[bj_] = *(const f32x4*)(cosT + (size_t)pos_ * 64 + i0_); D_.sn[bj_] = *(const f32x4*)(sinT + (size_t)pos_ * 64 + i0_); } } } while (0)
        ERO_ISSUE(0, L[0]);
#pragma unroll
        for (int g8 = 0; g8 < 8; ++g8) { const int ai = g8 >> 2, m = g8 & 3; const int row = row0 + ai * HALF + m * 16; bf16* rowp = O + (size_t)row * ldc + col0;
                if (g8 + 1 < 8) ERO_ISSUE(g8 + 1, L[(g8 + 1) & 1]);
                asm volatile("" ::: "memory");
                const Ld& D = L[g8 & 1];
                float rs;
                { const f32x4 a = D.a, b = D.b;
                  float s = ((a[0] + a[1]) + (a[2] + a[3])) + ((b[0] + b[1]) + (b[2] + b[3])); s += __shfl_xor(s, 16); s += __shfl_xor(s, 32);
                  rs = __builtin_amdgcn_rsqf(s * (1.f / DM) + NORM_EPS); }
#pragma unroll
                for (int bj = 0; bj < 2; ++bj) { f32x4 v0 = acc[ai][bj][m][0] * rs, v1 = acc[ai][bj][m][1] * rs;
                    if (roped) { const f32x4 c = D.cs[bj], s = D.sn[bj];
                        const f32x4 r0 = {v0[0] * c[0] - v0[1] * s[0], v0[0] * s[0] + v0[1] * c[0], v0[2] * c[1] - v0[3] * s[1], v0[2] * s[1] + v0[3] * c[1]};
                        const f32x4 r1 = {v1[0] * c[2] - v1[1] * s[2], v1[0] * s[2] + v1[1] * c[2], v1[2] * c[3] - v1[3] * s[3], v1[2] * s[3] + v1[3] * c[3]};
                        v0 = r0; v1 = r1; }
                    if (ksum) {
#pragma unroll
                        for (int e = 0; e < 4; ++e) { colsum[ai][bj][e] += v0[e]; colsum[ai][bj][4 + e] += v1[e]; } }
                    u32x4 w; w.x = cvt_pk_bf16(v0[0], v0[1]); w.y = cvt_pk_bf16(v0[2], v0[3]); w.z = cvt_pk_bf16(v1[0], v1[1]); w.w = cvt_pk_bf16(v1[2], v1[3]);
                    *(u32x4*)(rowp + bj * HALF) = w; } }
#undef ERO_ISSUE
        if (ksum) {
            const int b = u.pm >> 5, jb = u.pm & 31;
#pragma unroll
            for (int ai = 0; ai < 2; ++ai)
#pragma unroll
                for (int bj = 0; bj < 2; ++bj) {
#pragma unroll
                    for (int e = 0; e < 8; ++e) { float s = colsum[ai][bj][e]; s += __shfl_xor(s, 1); s += __shfl_xor(s, 2); s += __shfl_xor(s, 4); s += __shfl_xor(s, 8); colsum[ai][bj][e] = s; }
                    if (fr == 0) { const int col = col0 + bj * HALF - 1024, hh = col >> 7, d = col & 127;
                        float* kp = KMP + ((((size_t)b * 8 + hh) * 32 + jb) * 4 + (ai * 2 + wr)) * 128 + d;
                        *(f32x4*)kp = (f32x4){colsum[ai][bj][0], colsum[ai][bj][1], colsum[ai][bj][2], colsum[ai][bj][3]};
                        *(f32x4*)(kp + 4) = (f32x4){colsum[ai][bj][4], colsum[ai][bj][5], colsum[ai][bj][6], colsum[ai][bj][7]}; } }
        }
    }
};
struct EpiRopeEven {
    static constexpr bool PERM = true;
    static constexpr bool HAS_PRE = false;
    bf16* O; int ldc; const float* c128; const float* s128; const float* c64; const float* s64; float* ssq;
    __device__ __forceinline__ void operator()(const f32x4 (&acc)[2][2][4][2], const Unit& u, int wr, int wc, int fr, int fq) const {
        const int row0 = u.pm * BM + wr * 64 + fr; const int col0 = u.pn * BM + wc * 32 + 8 * fq;
        int cls[2], i0[2];
#pragma unroll
        for (int bj = 0; bj < 2; ++bj) { const int colw = u.pn * BM + bj * HALF + wc * 32, col = col0 + bj * HALF;
            cls[bj] = (colw >= 832 && colw < 2880) ? 1 : (((colw >= 768 && colw < 832) || (colw >= 3904 && colw < 4992)) ? 2 : 0);
            i0[bj] = cls[bj] == 1 ? (((col - 832) & 127) >> 1) : ((col & 63) >> 1); }
        const bool dossq = u.pn < 3;
        struct Ld { f32x4 c[2], s[2]; };
        Ld L[2];
#define ERE_ISSUE(g_, D_) do { const int pos_ = (row0 + ((g_) >> 2) * HALF + ((g_) & 3) * 16) & (SEQ - 1); _Pragma("unroll") for (int bj_ = 0; bj_ < 2; ++bj_) { \
            if (cls[bj_] == 1) { D_.c[bj_] = *(const f32x4*)(c128 + (size_t)pos_ * 64 + i0[bj_]); D_.s[bj_] = *(const f32x4*)(s128 + (size_t)pos_ * 64 + i0[bj_]); } \
            else if (cls[bj_] == 2) { D_.c[bj_] = *(const f32x4*)(c64 + (size_t)pos_ * 32 + i0[bj_]); D_.s[bj_] = *(const f32x4*)(s64 + (size_t)pos_ * 32 + i0[bj_]); } } } while (0)
        ERE_ISSUE(0, L[0]);
#pragma unroll
        for (int g8 = 0; g8 < 8; ++g8) { const int ai = g8 >> 2, m = g8 & 3; const int row = row0 + ai * HALF + m * 16; bf16* rowp = O + (size_t)row * ldc + col0;
                if (g8 + 1 < 8) ERE_ISSUE(g8 + 1, L[(g8 + 1) & 1]);
                asm volatile("" ::: "memory");
                const Ld& D = L[g8 & 1];
                float ss = 0.f;
#pragma unroll
                for (int bj = 0; bj < 2; ++bj) { f32x4 v0 = acc[ai][bj][m][0], v1 = acc[ai][bj][m][1];
                    if (cls[bj] != 0) { const f32x4 c = D.c[bj], s = D.s[bj];
                        const f32x4 r0 = {v0[0] * c[0] - v0[1] * s[0], v0[0] * s[0] + v0[1] * c[0], v0[2] * c[1] - v0[3] * s[1], v0[2] * s[1] + v0[3] * c[1]};
                        const f32x4 r1 = {v1[0] * c[2] - v1[1] * s[2], v1[0] * s[2] + v1[1] * c[2], v1[2] * c[3] - v1[3] * s[3], v1[2] * s[3] + v1[3] * c[3]};
                        v0 = r0; v1 = r1; }
                    if (dossq) ss += ((v0[0] * v0[0] + v0[1] * v0[1]) + (v0[2] * v0[2] + v0[3] * v0[3])) + ((v1[0] * v1[0] + v1[1] * v1[1]) + (v1[2] * v1[2] + v1[3] * v1[3]));
                    u32x4 w; w.x = cvt_pk_bf16(v0[0], v0[1]); w.y = cvt_pk_bf16(v0[2], v0[3]); w.z = cvt_pk_bf16(v1[0], v1[1]); w.w = cvt_pk_bf16(v1[2], v1[3]);
                    *(u32x4*)(rowp + bj * HALF) = w; }
                if (dossq) { ss += __shfl_xor(ss, 16); ss += __shfl_xor(ss, 32); if (fq == 0) ssq[(size_t)row * 16 + u.pn * 4 + wc] = ss; } }
#undef ERE_ISSUE
    }
};
template <int P0, int NP, int NCOL, bool ROPEQ> struct EpiUp {
    static constexpr bool PERM = true;
    static constexpr bool HAS_PRE = false;
    bf16* O; int ldc; const float* ssq; const float* c64; const float* s64;
    __device__ __forceinline__ void operator()(const f32x4 (&acc)[2][2][4][2], const Unit& u, int wr, int wc, int fr, int fq) const {
        const int row0 = u.pm * BM + wr * 64 + fr; const int col0 = u.pn * BM + wc * 32 + 8 * fq;
        bool rp[2]; int i0[2];
#pragma unroll
        for (int bj = 0; bj < 2; ++bj) { const int colw = u.pn * BM + bj * HALF + wc * 32, col = col0 + bj * HALF; const int o = colw % 192;
            rp[bj] = ROPEQ && o >= 128; i0[bj] = ((col % 192) - 128) >> 1; }
        struct Ld { f32x4 p[NP / 4], c[2], sn[2]; };
        Ld L[2];
#define EUP_ISSUE(g_, D_) do { const int row_ = row0 + ((g_) >> 2) * HALF + ((g_) & 3) * 16; const int pos_ = row_ & (SEQ - 1); \
            _Pragma("unroll") for (int q4_ = 0; q4_ < NP / 4; ++q4_) D_.p[q4_] = *(const f32x4*)(ssq + (size_t)row_ * 16 + P0 + 4 * q4_); \
            _Pragma("unroll") for (int bj_ = 0; bj_ < 2; ++bj_) if (rp[bj_]) { D_.c[bj_] = *(const f32x4*)(c64 + (size_t)pos_ * 32 + i0[bj_]); D_.sn[bj_] = *(const f32x4*)(s64 + (size_t)pos_ * 32 + i0[bj_]); } } while (0)
        EUP_ISSUE(0, L[0]);
#pragma unroll
        for (int g8 = 0; g8 < 8; ++g8) { const int ai = g8 >> 2, m = g8 & 3; const int row = row0 + ai * HALF + m * 16; bf16* rowp = O + (size_t)row * ldc + col0;
                if (g8 + 1 < 8) EUP_ISSUE(g8 + 1, L[(g8 + 1) & 1]);
                asm volatile("" ::: "memory");
                const Ld& D = L[g8 & 1];
                float s = 0.f;
#pragma unroll
                for (int q4 = 0; q4 < NP / 4; ++q4) { const f32x4 a = D.p[q4]; s += (a[0] + a[1]) + (a[2] + a[3]); }
                const float rs = __builtin_amdgcn_rsqf(s * (1.f / NCOL) + NORM_EPS);
#pragma unroll
                for (int bj = 0; bj < 2; ++bj) { f32x4 v0 = acc[ai][bj][m][0] * rs, v1 = acc[ai][bj][m][1] * rs;
                    if (rp[bj]) { const f32x4 c = D.c[bj], sn = D.sn[bj];
                        const f32x4 r0 = {v0[0] * c[0] - v0[1] * sn[0], v0[0] * sn[0] + v0[1] * c[0], v0[2] * c[1] - v0[3] * sn[1], v0[2] * sn[1] + v0[3] * c[1]};
                        const f32x4 r1 = {v1[0] * c[2] - v1[1] * sn[2], v1[0] * sn[2] + v1[1] * c[2], v1[2] * c[3] - v1[3] * sn[3], v1[2] * sn[3] + v1[3] * c[3]};
                        v0 = r0; v1 = r1; }
                    u32x4 w; w.x = cvt_pk_bf16(v0[0], v0[1]); w.y = cvt_pk_bf16(v0[2], v0[3]); w.z = cvt_pk_bf16(v1[0], v1[1]); w.w = cvt_pk_bf16(v1[2], v1[3]);
                    *(u32x4*)(rowp + bj * HALF) = w; } }
#undef EUP_ISSUE
    }
};
struct EpiResF32 {
    static constexpr bool PERM = false;
    static constexpr bool HAS_PRE = false;
    const float* base; float* out; int ldc;
    __device__ __forceinline__ void operator()(const f32x4 (&acc)[2][2][4][2], const Unit& u, int wr, int wc, int fr, int fq) const {
        const int row0 = u.pm * BM + wr * 64 + fr, col0 = u.pn * BM + wc * 32 + 4 * fq;
#pragma unroll
        for (int ai = 0; ai < 2; ++ai)
#pragma unroll
            for (int m = 0; m < 4; ++m) { const size_t off = (size_t)(row0 + ai * HALF + m * 16) * ldc + col0;
                f32x4 bs[2][2];
#pragma unroll
                for (int bj = 0; bj < 2; ++bj)
#pragma unroll
                    for (int n = 0; n < 2; ++n) bs[bj][n] = *(const f32x4*)(base + off + bj * HALF + n * 16);
#pragma unroll
                for (int bj = 0; bj < 2; ++bj)
#pragma unroll
                    for (int n = 0; n < 2; ++n) *(f32x4*)(out + off + bj * HALF + n * 16) = acc[ai][bj][m][n] + bs[bj][n];
                asm volatile("" ::: "memory"); }
    }
};

template <bool XB> struct EpiResF32X {
    static constexpr bool PERM = true;
    static constexpr bool HAS_PRE = false;
    const float* base; float* out; bf16* xb; float* ssq; int ldc;
    __device__ __forceinline__ void operator()(const f32x4 (&acc)[2][2][4][2], const Unit& u, int wr, int wc, int fr, int fq) const {
        const int row0 = u.pm * BM + wr * 64 + fr, col0 = u.pn * BM + wc * 32 + 8 * fq;
        f32x4 vn[2][2];
#define ERX_LOAD(g_) do { const size_t off_ = (size_t)(row0 + ((g_) >> 2) * HALF + ((g_) & 3) * 16) * ldc + col0; \
            _Pragma("unroll") for (int bj = 0; bj < 2; ++bj) _Pragma("unroll") for (int n = 0; n < 2; ++n) vn[bj][n] = *(const f32x4*)(base + off_ + bj * HALF + n * 4); } while (0)
        ERX_LOAD(0);
#pragma unroll
        for (int g = 0; g < 8; ++g) { const int ai = g >> 2, m = g & 3; const int row = row0 + ai * HALF + m * 16; const size_t off = (size_t)row * ldc + col0;
            f32x4 v[2][2];
#pragma unroll
            for (int bj = 0; bj < 2; ++bj)
#pragma unroll
                for (int n = 0; n < 2; ++n) v[bj][n] = vn[bj][n];
            if (g < 7) ERX_LOAD(g + 1);
            asm volatile("" ::: "memory");
            float ss = 0.f;
#pragma unroll
            for (int bj = 0; bj < 2; ++bj) { const f32x4 o0 = acc[ai][bj][m][0] + v[bj][0], o1 = acc[ai][bj][m][1] + v[bj][1];
                *(f32x4*)(out + off + bj * HALF) = o0; *(f32x4*)(out + off + bj * HALF + 4) = o1;
                if constexpr (XB) { u32x4 w; w.x = cvt_pk_bf16(o0[0], o0[1]); w.y = cvt_pk_bf16(o0[2], o0[3]); w.z = cvt_pk_bf16(o1[0], o1[1]); w.w = cvt_pk_bf16(o1[2], o1[3]);
                    *(u32x4*)(xb + off + bj * HALF) = w;
                    ss += ((o0[0] * o0[0] + o0[1] * o0[1]) + (o0[2] * o0[2] + o0[3] * o0[3])) + ((o1[0] * o1[0] + o1[1] * o1[1]) + (o1[2] * o1[2] + o1[3] * o1[3])); } }
            if constexpr (XB) { ss += __shfl_xor(ss, 16); ss += __shfl_xor(ss, 32);
                if (fq == 0) ssq[(size_t)row * 32 + u.pn * 4 + wc] = ss; }
        }
#undef ERX_LOAD
    }
};

template <bool BASE_F32> struct EpiResBf16 {
    static constexpr bool PERM = true;
    static constexpr bool HAS_PRE = false;
    const void* base; bf16* xb; float* ssq; int ldc;
    __device__ __forceinline__ void operator()(const f32x4 (&acc)[2][2][4][2], const Unit& u, int wr, int wc, int fr, int fq) const {
        const int row0 = u.pm * BM + wr * 64 + fr, col0 = u.pn * BM + wc * 32 + 8 * fq;
        f32x4 vn[2][2];
#define ERB_LOAD(g_) do { const size_t off_ = (size_t)(row0 + ((g_) >> 2) * HALF + ((g_) & 3) * 16) * ldc + col0; \
            _Pragma("unroll") for (int bj = 0; bj < 2; ++bj) { \
                if constexpr (BASE_F32) { vn[bj][0] = *(const f32x4*)((const float*)base + off_ + bj * HALF); vn[bj][1] = *(const f32x4*)((const float*)base + off_ + bj * HALF + 4); } \
                else { const u32x4 w_ = *(const u32x4*)((const bf16*)base + off_ + bj * HALF); \
                    vn[bj][0] = (f32x4){__uint_as_float(w_.x << 16), __uint_as_float(w_.x & 0xffff0000u), __uint_as_float(w_.y << 16), __uint_as_float(w_.y & 0xffff0000u)}; \
                    vn[bj][1] = (f32x4){__uint_as_float(w_.z << 16), __uint_as_float(w_.z & 0xffff0000u), __uint_as_float(w_.w << 16), __uint_as_float(w_.w & 0xffff0000u)}; } } } while (0)
        ERB_LOAD(0);
#pragma unroll
        for (int g = 0; g < 8; ++g) { const int ai = g >> 2, m = g & 3; const int row = row0 + ai * HALF + m * 16; const size_t off = (size_t)row * ldc + col0;
            f32x4 v[2][2];
#pragma unroll
            for (int bj = 0; bj < 2; ++bj)
#pragma unroll
                for (int n = 0; n < 2; ++n) v[bj][n] = vn[bj][n];
            if (g < 7) ERB_LOAD(g + 1);
            asm volatile("" ::: "memory");
            float ss = 0.f;
#pragma unroll
            for (int bj = 0; bj < 2; ++bj) { const f32x4 o0 = acc[ai][bj][m][0] + v[bj][0], o1 = acc[ai][bj][m][1] + v[bj][1];
                u32x4 w; w.x = cvt_pk_bf16(o0[0], o0[1]); w.y = cvt_pk_bf16(o0[2], o0[3]); w.z = cvt_pk_bf16(o1[0], o1[1]); w.w = cvt_pk_bf16(o1[2], o1[3]);
                *(u32x4*)(xb + off + bj * HALF) = w;
                ss += ((o0[0] * o0[0] + o0[1] * o0[1]) + (o0[2] * o0[2] + o0[3] * o0[3])) + ((o1[0] * o1[0] + o1[1] * o1[1]) + (o1[2] * o1[2] + o1[3] * o1[3])); }
            ss += __shfl_xor(ss, 16); ss += __shfl_xor(ss, 32);
            if (fq == 0) ssq[(size_t)row * 32 + u.pn * 4 + wc] = ss;
        }
#undef ERB_LOAD
    }
};

template <class Epi>
__device__ __forceinline__ void gemm_phase(LAS unsigned char* lds, const Gemm g, const StaticOrder& S, const Epi& E) {
    const int tid = threadIdx.x, wid = __builtin_amdgcn_readfirstlane(tid >> 6), lane = tid & 63, wr = wid >> 2, wc = wid & 3, fr = lane & 15, fq = lane >> 4;
    const int K = g.K, nt = K / BK;
    unsigned voffA[2], voffB[2];
#pragma unroll
    for (int i = 0; i < 2; ++i) { int R, C; stage_rc(tid * 16 + i * 8192, R, C); const int Rb = Epi::PERM ? ((R & ~31) + perm32(R & 31)) : R;
        voffA[i] = (unsigned)(R * g.lda + C) * 2u; voffB[i] = (unsigned)(Rb * g.ldb + C) * 2u; }
    const size_t kstep = (size_t)(BK * 2);
    const size_t hA = (size_t)HALF * g.lda * 2, hB = (size_t)HALF * g.ldb * 2;
    const size_t tA = 2 * hA, tB = 2 * hB;
    const unsigned ldsw = (unsigned)wid * 1024u;
    const int aoff = lds_byte(wr * 64 + fr, fq * 8), boff = lds_byte(wc * 32 + fr, fq * 8);
#define PG8_SA(b, h) (((b) * 2 + (h)) * HTB)
#define PG8_SB(b, h) ((4 + (b) * 2 + (h)) * HTB)
#define PG8_STAGE(bufoff, gbase, voff) do { _Pragma("unroll") for (int _i = 0; _i < 2; ++_i) \
        __builtin_amdgcn_global_load_lds((const unsigned*)((const char*)(gbase) + (voff)[_i]), (LAS unsigned*)(lds + (bufoff) + ldsw + _i * 8192), 16, 0, 0); } while (0)
#define PG8_LDA(dst, b, h) do { _Pragma("unroll") for (int m = 0; m < 4; ++m) _Pragma("unroll") for (int k = 0; k < 2; ++k) dst[m][k] = *(const LAS bf16x8*)(lds + PG8_SA(b, h) + aoff + m * 2048 + k * 1024); } while (0)
#define PG8_LDB(dst, b, h) do { _Pragma("unroll") for (int n = 0; n < 2; ++n) _Pragma("unroll") for (int k = 0; k < 2; ++k) dst[n][k] = *(const LAS bf16x8*)(lds + PG8_SB(b, h) + boff + n * 2048 + k * 1024); } while (0)
#define PG8_MMA(ai, bj, At, Bt) do { __builtin_amdgcn_s_setprio(1); _Pragma("unroll") for (int m = 0; m < 4; ++m) _Pragma("unroll") for (int n = 0; n < 2; ++n) _Pragma("unroll") for (int k = 0; k < 2; ++k) \
        acc[ai][bj][m][n] = __builtin_amdgcn_mfma_f32_16x16x32_bf16(Bt[n][k], At[m][k], acc[ai][bj][m][n], 0, 0, 0); __builtin_amdgcn_s_setprio(0); } while (0)
#define PG8_WAIT_V(n) asm volatile("s_waitcnt vmcnt(" #n ")" ::: "memory")
#define PG8_WAIT_L(n) asm volatile("s_waitcnt lgkmcnt(" #n ")" ::: "memory")
#define PG8_BAR __builtin_amdgcn_s_barrier()
#define PG8_SCHED __builtin_amdgcn_sched_barrier(0)
    Unit cur, nxt; int ui = 0;
    if (!S.next(0, cur)) return;
    f32x4 acc[2][2][4][2];
#pragma unroll
    for (int a = 0; a < 2; ++a)
#pragma unroll
        for (int b = 0; b < 2; ++b)
#pragma unroll
            for (int m = 0; m < 4; ++m)
#pragma unroll
                for (int n = 0; n < 2; ++n) acc[a][b][m][n] = (f32x4){0.f, 0.f, 0.f, 0.f};
    bf16x8 At[4][2], B0[2][2], B1[2][2];
    LAS float* rsl = (LAS float*)(lds + 131072) + wr * 128 + fr;
#define PG8_RS_PUT(buf_, rs_) do { if (fq == 0) { rsl[(buf_) * 256 + wc * 16] = rs_[0]; rsl[(buf_) * 256 + 64 + wc * 16] = rs_[1]; } } while (0)
#define PG8_RS_GET(buf_, ai_, rs_) do { _Pragma("unroll") for (int m_ = 0; m_ < 4; ++m_) rs_[m_] = rsl[(buf_) * 256 + (ai_) * 64 + m_ * 16]; } while (0)
    if constexpr (Epi::HAS_PRE) { f32x4 raw0[2][2]; float r0[2]; E.pre_issue(cur, wr, wc, fr, fq, raw0); E.pre_finish(raw0, r0); PG8_RS_PUT(0, r0); }
    const char* cA = (const char*)g.A + (size_t)cur.pm * tA; const char* cB = (const char*)g.Bt + (size_t)cur.pn * tB;
    PG8_STAGE(PG8_SB(0, 0), cB, voffB); PG8_STAGE(PG8_SB(0, 1), cB + hB, voffB); PG8_STAGE(PG8_SA(0, 0), cA, voffA); PG8_STAGE(PG8_SA(0, 1), cA + hA, voffA);
    if (wr == 1) PG8_BAR;
    PG8_WAIT_V(2); PG8_BAR;
    PG8_STAGE(PG8_SB(1, 0), cB + kstep, voffB); PG8_STAGE(PG8_SA(1, 0), cA + kstep, voffA); PG8_STAGE(PG8_SB(1, 1), cB + hB + kstep, voffB);
    PG8_WAIT_V(6); PG8_BAR;
    for (;;) {
        const bool has_next = S.next(ui + 1, nxt);
        const char* nA = has_next ? (const char*)g.A + (size_t)nxt.pm * tA : cA; const char* nB = has_next ? (const char*)g.Bt + (size_t)nxt.pn * tB : cB;
        for (int t = 0; t < nt; t += 2) {
            const bool last = (t == nt - 2);
            const char* a1 = cA + (size_t)(t + 1) * kstep;
            const char* a2 = last ? nA : cA + (size_t)(t + 2) * kstep; const char* b2 = last ? nB : cB + (size_t)(t + 2) * kstep;
            const char* a3 = a2 + kstep; const char* b3 = b2 + kstep;
            PG8_LDB(B0, 0, 0); PG8_LDB(B1, 0, 1); PG8_SCHED; PG8_LDA(At, 0, 0); PG8_STAGE(PG8_SA(1, 1), a1 + hA, voffA);
            PG8_WAIT_V(8); PG8_WAIT_L(0); PG8_BAR; PG8_MMA(0, 0, At, B0); PG8_MMA(0, 1, At, B1); PG8_BAR; PG8_SCHED;
            PG8_LDA(At, 0, 1); PG8_STAGE(PG8_SB(0, 0), b2, voffB); PG8_STAGE(PG8_SB(0, 1), b2 + hB, voffB); PG8_STAGE(PG8_SA(0, 0), a2, voffA);
            PG8_WAIT_V(8); PG8_WAIT_L(0); PG8_BAR; PG8_MMA(1, 0, At, B0); PG8_MMA(1, 1, At, B1); PG8_BAR; PG8_SCHED;
            PG8_LDB(B0, 1, 0); PG8_LDB(B1, 1, 1); PG8_SCHED; PG8_LDA(At, 1, 0); PG8_STAGE(PG8_SA(0, 1), a2 + hA, voffA);
            PG8_WAIT_V(8); PG8_WAIT_L(0); PG8_BAR; PG8_MMA(0, 0, At, B0); PG8_MMA(0, 1, At, B1); PG8_BAR; PG8_SCHED;
            PG8_LDA(At, 1, 1); PG8_STAGE(PG8_SB(1, 0), b3, voffB); PG8_STAGE(PG8_SB(1, 1), b3 + hB, voffB); PG8_STAGE(PG8_SA(1, 0), a3, voffA);
            PG8_WAIT_V(8); PG8_WAIT_L(0); PG8_BAR; PG8_MMA(1, 0, At, B0); PG8_MMA(1, 1, At, B1); PG8_BAR; PG8_SCHED;
        }
        if (wr == 0) PG8_BAR;
        if constexpr (Epi::HAS_PRE) { f32x4 raw[2][2]; float rc[4], rn[2]; const int buf = ui & 1;
            if (has_next) E.pre_issue(nxt, wr, wc, fr, fq, raw);
            PG8_RS_GET(buf, 0, rc); PG8_SCHED; E.half(acc, cur, 0, wr, wc, fr, fq, rc); PG8_SCHED;
            PG8_RS_GET(buf, 1, rc); PG8_SCHED; E.half(acc, cur, 1, wr, wc, fr, fq, rc); PG8_SCHED;
            if (has_next) { E.pre_finish(raw, rn); PG8_RS_PUT(buf ^ 1, rn); } }
        else E(acc, cur, wr, wc, fr, fq);
        if (!has_next) break;
#pragma unroll
        for (int a = 0; a < 2; ++a)
#pragma unroll
            for (int b = 0; b < 2; ++b)
#pragma unroll
                for (int m = 0; m < 4; ++m)
#pragma unroll
                    for (int n = 0; n < 2; ++n) acc[a][b][m][n] = (f32x4){0.f, 0.f, 0.f, 0.f};
        cur = nxt; cA = nA; cB = nB; ++ui;
        if (wr == 1) PG8_BAR;
    }
    PG8_WAIT_V(0);
    PG8_BAR;
#undef PG8_SA
#undef PG8_SB
#undef PG8_STAGE
#undef PG8_LDA
#undef PG8_LDB
#undef PG8_MMA
#undef PG8_WAIT_V
#undef PG8_WAIT_L
#undef PG8_BAR
#undef PG8_SCHED
#undef PG8_RS_PUT
#undef PG8_RS_GET
}
}

#define XB_TMO      128
#define XB_XCNT(j)  (256  + 64 * (j))
#define XB_XSUB(j)  (1280 + 64 * (j))
#define XB_XGEN(j)  (2304 + 64 * (j))
#define XB_TOP      3328
#define XB_TOPGEN   3392
#define XCD_BAR_WORDS 3456
#define XB_SPIN_CAP (1u << 18)

__device__ __forceinline__ unsigned xb_ld(unsigned* p)              { return __hip_atomic_load(p, __ATOMIC_RELAXED, __HIP_MEMORY_SCOPE_AGENT); }
__device__ __forceinline__ unsigned xb_add(unsigned* p, unsigned v) { return __hip_atomic_fetch_add(p, v, __ATOMIC_RELAXED, __HIP_MEMORY_SCOPE_AGENT); }
__device__ __forceinline__ unsigned xb_xcc_id() { return (unsigned)__builtin_amdgcn_s_getreg((3 << 11) | 20) & 0xFu; }
#define XB_SPIN(cond, bar) do { unsigned _sp = 0; while (cond) { __builtin_amdgcn_s_sleep(1); \
    if ((++_sp & 255u) == 0u) { if (xb_ld(&(bar)[XB_TMO])) break; if (_sp > XB_SPIN_CAP) { atomicAdd(&(bar)[XB_TMO], 1u); break; } } } } while (0)

struct XcdBarrier { unsigned* bar; unsigned x; volatile LAS unsigned* st; };

__device__ __forceinline__ XcdBarrier xcd_barrier_post(unsigned* bar, volatile LAS unsigned* st) {
    XcdBarrier b; b.bar = bar; b.x = xb_xcc_id(); b.st = st;
    if (threadIdx.x == 0) (void)xb_add(&bar[XB_XCNT(b.x)], 1u);
    return b;
}
__device__ __forceinline__ void xcd_barrier_complete(unsigned* bar, unsigned x, unsigned& nloc, unsigned& nx) {
    const unsigned G = gridDim.x * gridDim.y * gridDim.z;
    unsigned sum, cnt, mine, sp = 0u;
    for (;;) {
        sum = 0u; cnt = 0u; mine = 0u;
#pragma unroll
        for (unsigned j = 0; j < 16; ++j) { const unsigned c = xb_ld(&bar[XB_XCNT(j)]); sum += c; cnt += (c > 0u) ? 1u : 0u; mine = (j == x) ? c : mine; }
        if (sum == G) break;
        __builtin_amdgcn_s_sleep(1);
        if ((++sp & 255u) == 0u) { if (xb_ld(&bar[XB_TMO])) break; if (sp > XB_SPIN_CAP) { atomicAdd(&bar[XB_TMO], 1u); break; } }
    }
    nloc = mine > 0u ? mine : 1u; nx = cnt > 0u ? cnt : 1u;
}
__device__ __forceinline__ void xcd_barrier(const XcdBarrier& b) {
    asm volatile("s_waitcnt vmcnt(0)" ::: "memory");
    __syncthreads();
    if (threadIdx.x == 0) {
        unsigned* bar = b.bar;
        __builtin_amdgcn_s_waitcnt(0);
        unsigned nloc = b.st[0], nx = b.st[1];
        if (nloc == 0u) { xcd_barrier_complete(bar, b.x, nloc, nx); b.st[0] = nloc; b.st[1] = nx; }
        const unsigned old = xb_add(&bar[XB_XSUB(b.x)], 1u);
        const unsigned gen = old / nloc;
        if (old + 1u == (gen + 1u) * nloc) {
            __builtin_amdgcn_fence(__ATOMIC_RELEASE, "agent");
            asm volatile("s_waitcnt vmcnt(0)" ::: "memory");
            const unsigned og = xb_add(&bar[XB_TOP], 1u);
            const unsigned tg = og / nx;
            if (og + 1u == (tg + 1u) * nx) xb_add(&bar[XB_TOPGEN], 1u);
            else XB_SPIN(xb_ld(&bar[XB_TOPGEN]) == tg, bar);
            __builtin_amdgcn_fence(__ATOMIC_ACQUIRE, "agent");
            xb_add(&bar[XB_XGEN(b.x)], 1u);
            asm volatile("s_waitcnt vmcnt(0)" ::: "memory");
        } else {
            XB_SPIN(xb_ld(&bar[XB_XGEN(b.x)]) == gen, bar);
            __builtin_amdgcn_fence(__ATOMIC_ACQUIRE, "agent");
            asm volatile("s_waitcnt vmcnt(0)" ::: "memory");
        }
    }
    __syncthreads();
}

struct Args { const float* in[14]; float* out; unsigned char* ws; int ph_lo, ph_hi; };
struct Frame {
    LAS unsigned char* lds;
    int tid, lane, wave, vcu, G;
    unsigned char* ws;
};

__device__ __forceinline__ int rope_colmap(int kind, int n) {
    if (kind == 1) { if (n < 2048 || (n >= 3072 && n < 5120)) { const int o = n & 127; return n - o + 2 * (o & 63) + (o >> 6); } return n; }
    if (kind == 2) {
        if (n >= 832 && n < 2880) { const int o = (n - 832) & 127; return n - o + 2 * (o & 63) + (o >> 6); }
        if ((n >= 768 && n < 832) || (n >= 3904 && n < 4992)) { const int o = n & 63; return n - o + 2 * (o & 31) + (o >> 5); }
        return n; }
    if (kind == 3) { const int o = n % 192; if (o >= 128) { const int p = o - 128; return n - p + 2 * (p & 31) + (p >> 5); } return n; }
    return n;
}
__device__ __forceinline__ void tr_load(const float* W, int K, int N, int item, int lane, const float* gain, float (&v)[32], f32x4& g0, f32x4& g1) {
    const int nblk = (N + 31) / 32, kb = item / nblk, nb = item % nblk, k0 = 64 * kb, n0 = 32 * nb;
    const int nn = n0 + (lane & 31);
    const float* wp = W + (size_t)(k0 + (lane >> 5)) * N + (nn < N ? nn : N - 1);
#pragma unroll
    for (int i = 0; i < 32; ++i) v[i] = wp[(size_t)(2 * i) * N];
    if (gain) { const f32x4* gp = (const f32x4*)(gain + k0 + 8 * (lane & 7)); g0 = gp[0]; g1 = gp[1]; }
    else { g0 = (f32x4){1.f, 1.f, 1.f, 1.f}; g1 = g0; }
}
__device__ __forceinline__ void tr_store(int K, int N, bf16* WT, LAS float* scr, int item, int lane, const float (&v)[32], const f32x4 g0, const f32x4 g1, int permkind) {
    const int nblk = (N + 31) / 32, kb = item / nblk, nb = item % nblk, k0 = 64 * kb, n0 = 32 * nb;
    const int nn = n0 + (lane & 31);
#pragma unroll
    for (int i = 0; i < 32; ++i) { const int kk = 2 * i + (lane >> 5); scr[kk * 33 + (lane & 31)] = (nn < N) ? v[i] : 0.f; }
    LDS_WAIT(); asm volatile("" ::: "memory");
    const int c = lane & 7;
#pragma unroll
    for (int j = 0; j < 4; ++j) { const int n = (lane >> 3) + 8 * j; const LAS float* s = scr + (8 * c) * 33 + n;
        u32x4 o; o.x = cvt_pk_bf16(s[0 * 33] * g0.x, s[1 * 33] * g0.y); o.y = cvt_pk_bf16(s[2 * 33] * g0.z, s[3 * 33] * g0.w);
        o.z = cvt_pk_bf16(s[4 * 33] * g1.x, s[5 * 33] * g1.y); o.w = cvt_pk_bf16(s[6 * 33] * g1.z, s[7 * 33] * g1.w);
        *(u32x4*)(WT + (size_t)rope_colmap(permkind, n0 + n) * K + k0 + 8 * c) = o; }
    LDS_WAIT(); asm volatile("" ::: "memory");
}
__device__ __forceinline__ void convert_weight(Frame& F, const float* W, int K, int N, bf16* WT, const float* gain = nullptr, int permkind = 0, int* rot = nullptr) {
    LAS float* scr = (LAS float*)(F.lds + F.wave * 16384);
    const int NGW = F.G * NWAVES; int gw = F.vcu * NWAVES + F.wave;
    const int nitems = (K / 64) * ((N + 31) / 32);
    if (rot) { gw -= *rot; if (gw < 0) gw += NGW; *rot = (*rot + nitems) % NGW; }
    float v[32]; f32x4 g0, g1;
    int it = gw;
    if (it < nitems) tr_load(W, K, N, it, F.lane, gain, v, g0, g1);
    for (; it < nitems; it += NGW) {
        float vn[32]; f32x4 gn0 = g0, gn1 = g1; const int itn = it + NGW;
        if (itn < nitems) tr_load(W, K, N, itn, F.lane, gain, vn, gn0, gn1);
        else {
#pragma unroll
            for (int i = 0; i < 32; ++i) vn[i] = 0.f; }
        tr_store(K, N, WT, scr, it, F.lane, v, g0, g1, permkind);
#pragma unroll
        for (int i = 0; i < 32; ++i) v[i] = vn[i];
        g0 = gn0; g1 = gn1;
    }
}
__device__ __forceinline__ void rms_row_to_bf16(const float* xrow, const float* g, bf16* orow, int lane) {
    const f32x4* xr = (const f32x4*)xrow + lane; const f32x4* gr = (const f32x4*)g + lane;
    f32x4 v[8]; float s = 0.f;
#pragma unroll
    for (int j = 0; j < 8; ++j) { v[j] = xr[64 * j]; s += (v[j].x * v[j].x + v[j].y * v[j].y) + (v[j].z * v[j].z + v[j].w * v[j].w); }
    const float rs = 1.0f / sqrtf(wave_sum(s) * (1.f / DM) + NORM_EPS);
    u32x2* o8 = (u32x2*)orow + lane;
#pragma unroll
    for (int j = 0; j < 8; ++j) { const f32x4 gg = gr[64 * j]; u32x2 w; w.x = cvt_pk_bf16(v[j].x * rs * gg.x, v[j].y * rs * gg.y); w.y = cvt_pk_bf16(v[j].z * rs * gg.z, v[j].w * rs * gg.w); o8[64 * j] = w; }
}
__device__ __forceinline__ void rms_rows(Frame& F, const float* X, const float* g, bf16* H) {
    const int gw = F.vcu * NWAVES + F.wave, NGW = F.G * NWAVES;
    for (int m = gw; m < T; m += NGW) rms_row_to_bf16(X + (size_t)m * DM, g, H + (size_t)m * DM, F.lane);
}
__device__ __forceinline__ void rms_rows_final(Frame& F, const bf16* XB, const float* ssq, float* out, const float* g, float oscale = 1.f) {
    const int gw = F.vcu * NWAVES + F.wave, NGW = F.G * NWAVES;
    const f32x4* gr = (const f32x4*)g;
    for (int m = gw; m < T; m += 2 * NGW) {
        const int m1 = m + NGW; const bool two = m1 < T; const int mb = two ? m1 : m;
        const float sva = (F.lane < 32) ? ssq[(size_t)m * 32 + F.lane] : 0.f;
        const float svb = (F.lane < 32) ? ssq[(size_t)mb * 32 + F.lane] : 0.f;
        const u32x4* xa = (const u32x4*)(XB + (size_t)m * DM) + F.lane; const u32x4* xb = (const u32x4*)(XB + (size_t)mb * DM) + F.lane;
        u32x4 wa[4], wb[4];
#pragma unroll
        for (int j = 0; j < 4; ++j) { wa[j] = xa[64 * j]; wb[j] = xb[64 * j]; }
        const float rsa = (1.0f / sqrtf(wave_sum(sva) * (1.f / DM) + NORM_EPS)) * oscale;
        const float rsb = (1.0f / sqrtf(wave_sum(svb) * (1.f / DM) + NORM_EPS)) * oscale;
        f32x4* oa = (f32x4*)(out + (size_t)m * DM); f32x4* ob = (f32x4*)(out + (size_t)mb * DM);
#pragma unroll
        for (int j = 0; j < 4; ++j) { const int c4 = (F.lane + 64 * j) * 2;
            const f32x4 g0 = gr[c4], g1 = gr[c4 + 1];
            { const u32x4 w = wa[j];
              const f32x4 a = {__uint_as_float(w.x << 16), __uint_as_float(w.x & 0xffff0000u), __uint_as_float(w.y << 16), __uint_as_float(w.y & 0xffff0000u)};
              const f32x4 b = {__uint_as_float(w.z << 16), __uint_as_float(w.z & 0xffff0000u), __uint_as_float(w.w << 16), __uint_as_float(w.w & 0xffff0000u)};
              oa[c4] = a * rsa * g0; oa[c4 + 1] = b * rsa * g1; }
            if (two) { const u32x4 w = wb[j];
              const f32x4 a = {__uint_as_float(w.x << 16), __uint_as_float(w.x & 0xffff0000u), __uint_as_float(w.y << 16), __uint_as_float(w.y & 0xffff0000u)};
              const f32x4 b = {__uint_as_float(w.z << 16), __uint_as_float(w.z & 0xffff0000u), __uint_as_float(w.w << 16), __uint_as_float(w.w & 0xffff0000u)};
              ob[c4] = a * rsb * g0; ob[c4 + 1] = b * rsb * g1; } }
    }
}
__device__ __forceinline__ void rope_tables(Frame& F) {
    float* c128 = (float*)(F.ws + WS_COS128); float* s128 = (float*)(F.ws + WS_SIN128);
    float* c64 = (float*)(F.ws + WS_COS64); float* s64 = (float*)(F.ws + WS_SIN64);
    const int gt = F.vcu * 512 + F.tid, NT_ = F.G * 512;
    for (int e = gt; e < SEQ * 64 + SEQ * 32; e += NT_) {
        int pos, i, dim; float* cp; float* sp;
        if (e < SEQ * 64) { pos = e >> 6; i = e & 63; dim = 128; cp = c128 + e; sp = s128 + e; }
        else { const int e2 = e - SEQ * 64; pos = e2 >> 5; i = e2 & 31; dim = 64; cp = c64 + e2; sp = s64 + e2; }
        const float ex = (float)(2 * i) / (float)dim;
        const float inv = (float)exp(-(double)ex * 9.210340371976184);
        const float ang = (float)pos * inv;
        const double rev = (double)ang * 0.15915494309189535;
        const double fr = rev - rint(rev);
        const float a = (float)(fr * 6.283185307179586);
        *cp = __cosf(a); *sp = __sinf(a);
    }
}

namespace att {
constexpr int SHM_V = 64 * 128 * 2, SHM_K = 64 * 128 * 2, SHM_PE = 64 * 64 * 2;
constexpr int OFF_V = 0, OFF_K = 2 * SHM_V, OFF_PE = OFF_K + 2 * SHM_K, OFF_WS = OFF_PE + 2 * SHM_PE;
constexpr int OFF_TL = OFF_WS + 2048;
constexpr int OFF_KM = 90112;
constexpr int OFF_LB = OFF_TL + 1024;
constexpr int OFF_QPE = 98304;
enum { MODE_MLA = 0, MODE_DSA = 1, MODE_MOWN = 2, MODE_DIL = 3, MODE_MSEL = 4 };
constexpr float THR = 8.f;

#define KSWZ(row, colB) ((row) * 256 + ((colB) ^ (((row) & 7) << 4)))
#define SBAR() __builtin_amdgcn_sched_barrier(0)
__device__ __forceinline__ int v_st(int k, int c) { const int kk = (k & ~0xC) | ((k & 4) << 1) | ((k & 8) >> 1); return ((kk >> 3) * 4 + (c >> 5)) * 512 + ((kk & 7) * 32 + (c & 31)) * 2; }
__device__ __forceinline__ int v_rd_base(int lane) { return ((lane & 3) << 3) | (((lane >> 2) & 3) << 6) | (((lane >> 4) & 1) << 5) | (((lane >> 5) & 1) << 8); }
constexpr int v_rd_off(int d0, int ks, int half) { return d0 * 512 + ks * 4096 + half * 2048; }
__device__ __forceinline__ int crow(int r, int hi) { return (r & 3) + 8 * (r >> 2) + 4 * hi; }
__device__ __forceinline__ bf16x8 pack8(f32x4 a, f32x4 b) {
    u32x4 w = {cvt_pk_bf16(a[0], a[1]), cvt_pk_bf16(a[2], a[3]), cvt_pk_bf16(b[0], b[1]), cvt_pk_bf16(b[2], b[3])};
    return *reinterpret_cast<bf16x8*>(&w);
}
__device__ __forceinline__ void rope_pair(bf16x8& a, bf16x8& b, const float* cs, const float* sn, float scale = 1.0f) {
    const f32x4 c0 = *(const f32x4*)cs * scale, c1 = *(const f32x4*)(cs + 4) * scale, s0 = *(const f32x4*)sn * scale, s1 = *(const f32x4*)(sn + 4) * scale;
    f32x4 y1a, y1b, y2a, y2b;
#pragma unroll
    for (int j = 0; j < 4; ++j) {
        const float x1 = bf2f((unsigned short)a[j]), x2 = bf2f((unsigned short)b[j]);
        y1a[j] = x1 * c0[j] - x2 * s0[j]; y2a[j] = x1 * s0[j] + x2 * c0[j];
        const float z1 = bf2f((unsigned short)a[4 + j]), z2 = bf2f((unsigned short)b[4 + j]);
        y1b[j] = z1 * c1[j] - z2 * s1[j]; y2b[j] = z1 * s1[j] + z2 * c1[j];
    }
    a = pack8(y1a, y1b); b = pack8(y2a, y2b);
}
__device__ __forceinline__ void mask_tile(f32x16& p0, f32x16& p1, int dq, unsigned W) {
    const float NEG = -__builtin_inff();
#pragma unroll
    for (int r = 0; r < 16; ++r) {
        const int c = (r & 3) + 8 * (r >> 2);
        if ((unsigned)(dq - c) >= W) p0[r] = NEG;
        if ((unsigned)(dq - c - 32) >= W) p1[r] = NEG;
    }
}
__device__ __forceinline__ void mask_bits(f32x16& p0, f32x16& p1, unsigned w0s, unsigned w1s) {
    const float NEG = -__builtin_inff();
#pragma unroll
    for (int r = 0; r < 16; ++r) {
        const int c = (r & 3) + 8 * (r >> 2);
        if (!((w0s >> c) & 1u)) p0[r] = NEG;
        if (!((w1s >> c) & 1u)) p1[r] = NEG;
    }
}
template <int MODE>
__device__ __forceinline__ void partialSM(f32x16& p0, f32x16& p1, float& m_reg, float& mn, float& alpha) {
    constexpr float SCALE = (MODE == MODE_MLA) ? 0.07216878364870322f : 0.08838834764831845f;
    float pmax = p0[0];
#pragma unroll
    for (int r = 1; r < 16; ++r) pmax = fmaxf(pmax, p0[r]);
#pragma unroll
    for (int r = 0; r < 16; ++r) pmax = fmaxf(pmax, p1[r]);
    { auto rr = __builtin_amdgcn_permlane32_swap(__float_as_uint(pmax), __float_as_uint(pmax), false, false);
      pmax = fmaxf(__uint_as_float(rr[0]), __uint_as_float(rr[1])); }
    constexpr float C2 = 1.4426950408889634f * SCALE;
    if (__builtin_expect(__all((pmax - m_reg) * SCALE <= THR), 1)) { mn = m_reg; alpha = 1.f; }
    else { mn = fmaxf(m_reg, pmax); alpha = __builtin_amdgcn_exp2f((m_reg - mn) * C2); m_reg = mn; }
    const float mnL = -mn * C2;
#pragma unroll
    for (int r = 0; r < 16; ++r) p0[r] = fmaf(p0[r], C2, mnL);
#pragma unroll
    for (int r = 0; r < 16; ++r) p1[r] = fmaf(p1[r], C2, mnL);
#pragma unroll
    for (int r = 0; r < 16; ++r) p0[r] = __builtin_amdgcn_exp2f(p0[r]);
}
template <bool BITS>
__device__ __forceinline__ void finishSM(f32x16& p0, f32x16& p1, float alpha, float& l_reg, bf16x8& pa0, bf16x8& pa1, bf16x8& pa2, bf16x8& pa3, unsigned w0s, unsigned w1s) {
#pragma unroll
    for (int r = 0; r < 16; ++r) p1[r] = __builtin_amdgcn_exp2f(p1[r]);
    if constexpr (BITS) {
#pragma unroll
        for (int r = 0; r < 16; ++r) { const int c = (r & 3) + 8 * (r >> 2);
            p0[r] = __uint_as_float(__float_as_uint(p0[r]) & (unsigned)__builtin_amdgcn_sbfe((int)w0s, c, 1));
            p1[r] = __uint_as_float(__float_as_uint(p1[r]) & (unsigned)__builtin_amdgcn_sbfe((int)w1s, c, 1)); } }
    float ps = 0;
#pragma unroll
    for (int r = 0; r < 16; ++r) ps += p0[r];
#pragma unroll
    for (int r = 0; r < 16; ++r) ps += p1[r];
    { auto rr = __builtin_amdgcn_permlane32_swap(__float_as_uint(ps), __float_as_uint(ps), false, false);
      ps = __uint_as_float(rr[0]) + __uint_as_float(rr[1]); }
    l_reg = l_reg * alpha + ps;
#define PK4(P, B_, OUT) do { unsigned a0 = cvt_pk_bf16(P[B_+0], P[B_+1]), a1 = cvt_pk_bf16(P[B_+2], P[B_+3]);                          \
        unsigned b0 = cvt_pk_bf16(P[B_+4], P[B_+5]), b1 = cvt_pk_bf16(P[B_+6], P[B_+7]);                                             \
        auto r0 = __builtin_amdgcn_permlane32_swap(a0, b0, false, false); auto r1 = __builtin_amdgcn_permlane32_swap(a1, b1, false, false); \
        u32x4 w = {r0[0], r1[0], r0[1], r1[1]}; OUT = *reinterpret_cast<bf16x8*>(&w); } while (0)
    PK4(p0, 0, pa0); PK4(p0, 8, pa1); PK4(p1, 0, pa2); PK4(p1, 8, pa3);
#undef PK4
}
template <int KB>
__device__ __forceinline__ void qkt(f32x16& p0, f32x16& p1, LAS const char* K_lds, int r32, int hi, const bf16x8* qr) {
    p0 = f32x16{}; p1 = f32x16{};
    int kb[4];
#pragma unroll
    for (int dd = 0; dd < 4; ++dd) kb[dd] = (int)(unsigned)(uintptr_t)K_lds + KSWZ(r32, (dd * 16 + hi * 8) * 2);
#define KRD(dst, av, off) asm volatile("ds_read_b128 %0, %1 offset:%2" : "=&v"(dst) : "v"(av), "n"(off) : "memory")
#define QKT_LD(X0, X1, d0_) do { KRD(X0, kb[(d0_) & 3], KB * SHM_K + ((d0_) >> 2) * 128); KRD(X1, kb[(d0_) & 3], KB * SHM_K + ((d0_) >> 2) * 128 + 32 * 256); } while (0)
#define QKT_W(n_) do { asm volatile("s_waitcnt lgkmcnt(" #n_ ")" ::: "memory"); SBAR(); } while (0)
#define QKT_MM(X0, X1, d0_) do { p0 = __builtin_amdgcn_mfma_f32_32x32x16_bf16(X0, qr[d0_], p0, 0, 0, 0); p1 = __builtin_amdgcn_mfma_f32_32x32x16_bf16(X1, qr[d0_], p1, 0, 0, 0); SBAR(); } while (0)
    bf16x8 a0, a1, b0, b1, c0, c1;
    QKT_LD(a0, a1, 0); QKT_LD(b0, b1, 1);
    QKT_LD(c0, c1, 2); QKT_W(4); QKT_MM(a0, a1, 0);
    QKT_LD(a0, a1, 3); QKT_W(4); QKT_MM(b0, b1, 1);
    QKT_LD(b0, b1, 4); QKT_W(4); QKT_MM(c0, c1, 2);
    QKT_LD(c0, c1, 5); QKT_W(4); QKT_MM(a0, a1, 3);
    QKT_LD(a0, a1, 6); QKT_W(4); QKT_MM(b0, b1, 4);
    QKT_LD(b0, b1, 7); QKT_W(4); QKT_MM(c0, c1, 5);
    QKT_W(2); QKT_MM(a0, a1, 6);
    QKT_W(0); QKT_MM(b0, b1, 7);
#undef QKT_LD
#undef QKT_MM
#undef QKT_W
#undef KRD
}
template <int KB>
__device__ __forceinline__ void qkt_pe(f32x16& p0, f32x16& p1, LAS const char* PE_lds, int r32, int hi, const bf16x8* qr  ) {
#pragma unroll
    for (int dd = 0; dd < 4; ++dd) { LAS const char* a = PE_lds + KB * SHM_PE + r32 * 128 + ((dd * 32 + hi * 16) ^ ((r32 & 7) << 4));
        bf16x8 b0 = *reinterpret_cast<LAS const bf16x8*>(a);
        bf16x8 b1 = *reinterpret_cast<LAS const bf16x8*>(a + 32 * 128);
        p0 = __builtin_amdgcn_mfma_f32_32x32x16_bf16(b0, qr[dd], p0, 0, 0, 0);
        p1 = __builtin_amdgcn_mfma_f32_32x32x16_bf16(b1, qr[dd], p1, 0, 0, 0); }
}
template <int KB>
__device__ __forceinline__ void qkt_pe_lq(f32x16& p0, f32x16& p1, LAS const char* PE_lds, int r32, int hi, LAS const char* qpe  ) {
#pragma unroll
    for (int dd = 0; dd < 4; ++dd) { LAS const char* a = PE_lds + KB * SHM_PE + r32 * 128 + ((dd * 32 + hi * 16) ^ ((r32 & 7) << 4));
        const bf16x8 q = *reinterpret_cast<LAS const bf16x8*>(qpe + dd * 1024);
        bf16x8 b0 = *reinterpret_cast<LAS const bf16x8*>(a);
        bf16x8 b1 = *reinterpret_cast<LAS const bf16x8*>(a + 32 * 128);
        p0 = __builtin_amdgcn_mfma_f32_32x32x16_bf16(b0, q, p0, 0, 0, 0);
        p1 = __builtin_amdgcn_mfma_f32_32x32x16_bf16(b1, q, p1, 0, 0, 0); }
}
template <int VB>
__device__ __forceinline__ void pv_tile(f32x16* o, int vb0, bf16x8 pa0, bf16x8 pa1, bf16x8 pa2, bf16x8 pa3) {
#define TRRD(dst, off) asm volatile("ds_read_b64_tr_b16 %0, %1 offset:%2" : "=&v"(dst) : "v"(vb0), "i"(off) : "memory")
#define PV_RD(S, d0) do { constexpr int b_ = VB * SHM_V + v_rd_off(d0, 0, 0); \
        TRRD(S[0], b_); TRRD(S[1], b_ + 2048); TRRD(S[2], b_ + 4096); TRRD(S[3], b_ + 6144); TRRD(S[4], b_ + 8192); TRRD(S[5], b_ + 10240); TRRD(S[6], b_ + 12288); TRRD(S[7], b_ + 14336); } while (0)
#define PV_MM(S, d0) do { \
        o[d0] = __builtin_amdgcn_mfma_f32_32x32x16_bf16(pa0, (bf16x8){S[0][0], S[0][1], S[0][2], S[0][3], S[1][0], S[1][1], S[1][2], S[1][3]}, o[d0], 0, 0, 0);   \
        o[d0] = __builtin_amdgcn_mfma_f32_32x32x16_bf16(pa1, (bf16x8){S[2][0], S[2][1], S[2][2], S[2][3], S[3][0], S[3][1], S[3][2], S[3][3]}, o[d0], 0, 0, 0);   \
        o[d0] = __builtin_amdgcn_mfma_f32_32x32x16_bf16(pa2, (bf16x8){S[4][0], S[4][1], S[4][2], S[4][3], S[5][0], S[5][1], S[5][2], S[5][3]}, o[d0], 0, 0, 0);   \
        o[d0] = __builtin_amdgcn_mfma_f32_32x32x16_bf16(pa3, (bf16x8){S[6][0], S[6][1], S[6][2], S[6][3], S[7][0], S[7][1], S[7][2], S[7][3]}, o[d0], 0, 0, 0); } while (0)
    s16x4 sa[8], sb[8];
    PV_RD(sa, 0);
    PV_RD(sb, 1); asm volatile("s_waitcnt lgkmcnt(8)" ::: "memory"); SBAR(); PV_MM(sa, 0); SBAR();
    PV_RD(sa, 2); asm volatile("s_waitcnt lgkmcnt(8)" ::: "memory"); SBAR(); PV_MM(sb, 1); SBAR();
    PV_RD(sb, 3); asm volatile("s_waitcnt lgkmcnt(8)" ::: "memory"); SBAR(); PV_MM(sa, 2); SBAR();
    asm volatile("s_waitcnt lgkmcnt(0)" ::: "memory"); SBAR(); PV_MM(sb, 3);
#undef PV_RD
#undef PV_MM
#undef TRRD
}

struct UnitArgs {
#ifdef DIAG_SEG
    unsigned long long* dacc;
#endif
    const bf16* Q; size_t qpitch;
    const bf16* K; size_t kpitch;
    const bf16* PE; size_t pepitch;
    const bf16* V; size_t vpitch;
    bf16* O; size_t opitch;
    float* LSE; int lse_stride;
    const float* cosT; const float* sinT;
    int pos0, posstride;
    int P0;
    const unsigned* BM;
    const float* KMP;
    int own;
    unsigned* SEL; int* CNT;
    size_t oslot, lslot;
};

__device__ __forceinline__ void attn_preload_msel(LAS char* lds, const UnitArgs& U) {
    int tid_ = threadIdx.x; asm volatile("" : "+v"(tid_));
    const int tid = tid_, wid = __builtin_amdgcn_readfirstlane(tid >> 6), lane = tid & 63;
    LAS char* V_lds = lds + OFF_V; LAS char* K_lds = lds + OFF_K;
    unsigned koff, voff;
    { const int row = 4 * wid + (lane >> 4), colB = ((lane & 15) * 16) ^ ((row & 7) << 4); koff = (unsigned)((row * U.kpitch) * 2 + colB); }
    { const int kk = (wid >> 1) * 8 + ((lane & 31) >> 2), k = (kk & ~0xC) | ((kk & 4) << 1) | ((kk & 8) >> 1), c = (2 * (wid & 1) + (lane >> 5)) * 32 + (lane & 3) * 8;
      voff = (unsigned)((k * U.vpitch + c) * 2); }
    const int kb = U.own * 256;
    const char* kt_ = (const char*)U.K + (size_t)kb * U.kpitch * 2; const char* vt_ = (const char*)U.V + (size_t)kb * U.vpitch * 2;
    __builtin_amdgcn_global_load_lds((const unsigned*)(kt_ + koff), (LAS unsigned*)(K_lds + wid * 1024), 16, 0, 0);
    __builtin_amdgcn_global_load_lds((const unsigned*)(kt_ + (size_t)64 * U.kpitch + koff), (LAS unsigned*)(K_lds + 8192 + wid * 1024), 16, 0, 0);
    __builtin_amdgcn_global_load_lds((const unsigned*)(vt_ + voff), (LAS unsigned*)(V_lds + wid * 1024), 16, 0, 0);
    __builtin_amdgcn_global_load_lds((const unsigned*)(vt_ + (size_t)64 * U.vpitch + voff), (LAS unsigned*)(V_lds + 8192 + wid * 1024), 16, 0, 0);
}
template <int MODE>
__device__ __forceinline__ void attn_unit(LAS char* lds, const UnitArgs& U) {
    constexpr bool MLA = MODE == MODE_MLA, DSA = MODE == MODE_DSA, MOWN = MODE == MODE_MOWN, MSEL = MODE == MODE_MSEL, DIL = MODE == MODE_DIL;
    constexpr float SCALE = MLA ? 0.07216878364870322f : 0.08838834764831845f;
    constexpr float C2 = 1.4426950408889634f * SCALE;
#ifdef DIAG_SEG
    unsigned long long dseg_t = __builtin_amdgcn_s_memrealtime();
#define DSEG(k_) do { const unsigned long long n_ = __builtin_amdgcn_s_memrealtime(); if (DIAG_SEG == (k_) && U.dacc) *U.dacc += n_ - dseg_t; dseg_t = n_; } while (0)
#else
#define DSEG(k_) do { } while (0)
#endif
    int tid_ = threadIdx.x; asm volatile("" : "+v"(tid_));
    const int tid = tid_, wid = __builtin_amdgcn_readfirstlane(tid >> 6), lane = tid & 63, r32 = lane & 31, hi = lane >> 5;
    LAS char* V_lds = lds + OFF_V; LAS char* K_lds = lds + OFF_K; LAS char* PE_lds = lds + OFF_PE;
    LAS float* wsf = (LAS float*)(lds + OFF_WS) + wid * 64; LAS float* li_l = wsf; LAS float* al_l = wsf + 32;
    LAS unsigned* rinfo = (LAS unsigned*)(lds + OFF_TL);
    const int qlo = U.P0 + wid * 32;
    int qrow = qlo + r32; bool rvalid = true;
    if constexpr (MSEL) { const unsigned inf_ = rinfo[wid * 32 + r32]; rvalid = inf_ != 0xFFFFFFFFu; qrow = rvalid ? (int)(inf_ & 0xFFFFu) : 0; }
    const int qm = qrow - 4 * hi;
    constexpr bool PIPE = false;
    int NT = 4, kb_first = 0;
    if constexpr (MLA || DSA) { NT = (U.P0 + 255) / 64 + 1; }
    if constexpr (DIL) { const int lowk = U.P0 - 128; const int j_lo = lowk > 0 ? lowk / 64 : 0; kb_first = j_lo * 64; NT = (U.P0 + 255) / 64 + 1 - j_lo; }
    if constexpr (MOWN || MSEL) { kb_first = U.own * 256; NT = 4; }
    unsigned koff, voff, peoff = 0u;
    { const int row = 4 * wid + (lane >> 4), colB = ((lane & 15) * 16) ^ ((row & 7) << 4); koff = (unsigned)((row * U.kpitch) * 2 + colB); }
    { const int kk = (wid >> 1) * 8 + ((lane & 31) >> 2), k = (kk & ~0xC) | ((kk & 4) << 1) | ((kk & 8) >> 1), c = (2 * (wid & 1) + (lane >> 5)) * 32 + (lane & 3) * 8;
      voff = (unsigned)((k * U.vpitch + c) * 2); }
    if constexpr (MLA) { const int row = 8 * wid + (lane >> 3), colB = ((lane & 7) * 16) ^ ((row & 7) << 4); peoff = (unsigned)((row * U.pepitch) * 2 + colB); }
    const unsigned bmoff = (unsigned)qrow * 1024u;
    const int vb0 = (int)(unsigned)(uintptr_t)V_lds + v_rd_base(lane);
    u32x2 mw_n = (u32x2){0u, 0u}, mw_c = (u32x2){0u, 0u};
#define KBASE(t) (kb_first + (t) * 64)
#define SLOAD(kb_, bf) do { const char* kt_ = (const char*)U.K + (size_t)(kb_) * U.kpitch * 2; const char* vt_ = (const char*)U.V + (size_t)(kb_) * U.vpitch * 2; \
        __builtin_amdgcn_global_load_lds((const unsigned*)(kt_ + koff), (LAS unsigned*)(K_lds + (bf) * SHM_K + wid * 1024), 16, 0, 0); \
        __builtin_amdgcn_global_load_lds((const unsigned*)(kt_ + (size_t)64 * U.kpitch + koff), (LAS unsigned*)(K_lds + (bf) * SHM_K + 8192 + wid * 1024), 16, 0, 0); \
        __builtin_amdgcn_global_load_lds((const unsigned*)(vt_ + voff), (LAS unsigned*)(V_lds + (bf) * SHM_V + wid * 1024), 16, 0, 0); \
        __builtin_amdgcn_global_load_lds((const unsigned*)(vt_ + (size_t)64 * U.vpitch + voff), (LAS unsigned*)(V_lds + (bf) * SHM_V + 8192 + wid * 1024), 16, 0, 0); \
        if constexpr (MLA) __builtin_amdgcn_global_load_lds((const unsigned*)((const char*)U.PE + (size_t)(kb_) * U.pepitch * 2 + peoff), (LAS unsigned*)(PE_lds + (bf) * SHM_PE + wid * 1024), 16, 0, 0); \
        if constexpr (DSA) mw_n = *(const u32x2*)((const char*)U.BM + (size_t)((kb_) >> 5) * 4 + bmoff); } while (0)
    if constexpr (!PIPE && !MSEL) { const int kb0 = KBASE(0); SLOAD(kb0, 0); }
    bf16x8 qr[8];
    LAS const char* qpe = lds + OFF_QPE + wid * 4096 + lane * 16;
    { const bf16* qp = U.Q + (size_t)qrow * U.qpitch + hi * 8;
#pragma unroll
      for (int d0 = 0; d0 < 8; ++d0) qr[d0] = *(const bf16x8*)(qp + d0 * 16);
      if constexpr (MLA) {
#pragma unroll
          for (int dd = 0; dd < 4; ++dd) *(LAS bf16x8*)(lds + OFF_QPE + wid * 4096 + lane * 16 + dd * 1024) = *(const bf16x8*)(qp + (8 + dd) * 16);
          asm volatile("s_waitcnt lgkmcnt(0)" ::: "memory"); }
    }
    if constexpr (MOWN) {
        const int own = U.own;
        LAS char* KM = lds + OFF_KM;
        { const int jb = tid >> 4, d8 = (tid & 15) * 8; const float* kp = U.KMP + (jb * 512 + d8);
          f32x4 a0 = (f32x4){0.f, 0.f, 0.f, 0.f}, a1 = a0;
#pragma unroll
          for (int pq = 0; pq < 4; ++pq) { a0 += *(const f32x4*)(kp + pq * 128); a1 += *(const f32x4*)(kp + pq * 128 + 4); }
          *(LAS bf16x8*)(KM + jb * 256 + d8 * 2) = pack8(a0 * (1.f / 256.f), a1 * (1.f / 256.f)); }
        __syncthreads();
        f32x16 g = f32x16{};
#pragma unroll
        for (int d0 = 0; d0 < 8; ++d0) { const bf16x8 a = *(const LAS bf16x8*)(KM + r32 * 256 + (d0 * 16 + hi * 8) * 2);
            g = __builtin_amdgcn_mfma_f32_32x32x16_bf16(a, qr[d0], g, 0, 0, 0); }
        const float NEG = -__builtin_inff();
#pragma unroll
        for (int r = 0; r < 16; ++r) if (crow(r, hi) >= own) g[r] = NEG;
        unsigned selbits = 0;
#pragma unroll
        for (int round = 0; round < 3; ++round) {
            float bv = NEG; int bi = 64;
#pragma unroll
            for (int r = 0; r < 16; ++r) { const int j = crow(r, hi); if (g[r] > bv) { bv = g[r]; bi = j; } }
            const float ov = __shfl_xor(bv, 32); const int oi = __shfl_xor(bi, 32);
            const bool take_other = (ov > bv) || (ov == bv && oi < bi);
            const float wv = take_other ? ov : bv; const int wi = take_other ? oi : bi;
            if (wv > NEG) { selbits |= 1u << wi;
#pragma unroll
                for (int r = 0; r < 16; ++r) if (crow(r, hi) == wi) g[r] = NEG; }
        }
        const int nsel = __builtin_popcount(selbits);
        if (hi == 0) { U.SEL[qrow] = selbits;
#pragma unroll
            for (int s_ = 0; s_ < 3; ++s_) if (s_ >= nsel) U.LSE[(size_t)s_ * U.lslot + (size_t)qrow * U.lse_stride] = NEG; }
        LAS int* cw = (LAS int*)(lds + OFF_TL);
#pragma unroll 4
        for (int j = 0; j < 32; ++j) { const int c_ = __builtin_popcountll(__ballot(hi == 0 && ((selbits >> j) & 1u))); if (lane == 0) cw[wid * 32 + j] = c_; }
        __syncthreads();
        if (tid < 32) { int s_ = 0;
#pragma unroll
            for (int w_ = 0; w_ < 8; ++w_) s_ += cw[w_ * 32 + tid];
            U.CNT[tid] = s_; }
        __syncthreads();
    }
    float m_reg = -1e30f, l_reg = 0.f; f32x16 o[4] = {};
#define RESC(a) do { if (__any((a) < 1.f)) { if (hi == 0) al_l[r32] = (a); asm volatile("s_waitcnt lgkmcnt(0)" ::: "memory"); \
        _Pragma("unroll") for (int d_ = 0; d_ < 4; ++d_) _Pragma("unroll") for (int r = 0; r < 16; ++r) o[d_][r] *= al_l[crow(r, hi)]; } } while (0)
    const bool wact = MSEL ? (bool)__any(rvalid) : true;
#define STEP(t_, B_, NB_) do { const int kb_ = KBASE(t_); const bool more_ = (t_) + 1 < NT; \
        if (more_) { const int kbn_ = KBASE((t_) + 1); SLOAD(kbn_, NB_); } \
        bool act_ = wact; \
        if constexpr (MLA || DSA || MOWN) act_ = kb_ <= qlo + 31; \
        if constexpr (DIL) act_ = (kb_ <= qlo + 31) && (kb_ + 63 >= qlo - 128); \
        if (act_) { f32x16 p0, p1; qkt<B_>(p0, p1, K_lds, r32, hi, qr); \
            if constexpr (MLA) qkt_pe_lq<B_>(p0, p1, PE_lds, r32, hi, qpe); \
            if constexpr (MLA || MOWN) { if (kb_ + 63 > qlo) mask_tile(p0, p1, qm - kb_, 0x7fffffffu); } \
            if constexpr (DIL) { if (kb_ + 63 > qlo || kb_ <= qlo + 31 - 129) mask_tile(p0, p1, qm - kb_, 129u); } \
            float mn_, al_; partialSM<MODE>(p0, p1, m_reg, mn_, al_); RESC(al_); \
            bf16x8 pa0, pa1, pa2, pa3; finishSM<DSA>(p0, p1, al_, l_reg, pa0, pa1, pa2, pa3, mw_c.x >> (4 * hi), mw_c.y >> (4 * hi)); SBAR(); \
            pv_tile<B_>(o, vb0, pa0, pa1, pa2, pa3); } \
        VM_WAIT(); mw_c = mw_n; \
        __syncthreads(); } while (0)
    if (wid >= 4) __builtin_amdgcn_s_setprio(1);
    if constexpr (!PIPE) {
    { VM_WAIT(); mw_c = mw_n; }
    __syncthreads();
    DSEG(1);
    for (int t = 0; t < NT; t += 2) {
        STEP(t, 0, 1);
        if (t + 1 < NT) STEP(t + 1, 1, 0);
    }
    DSEG(2);
    } else {
#define SLOAD_K(kb_, bf) do { const char* kt_ = (const char*)U.K + (size_t)(kb_) * U.kpitch * 2; \
        __builtin_amdgcn_global_load_lds((const unsigned*)(kt_ + koff), (LAS unsigned*)(K_lds + (bf) * SHM_K + wid * 1024), 16, 0, 0); \
        __builtin_amdgcn_global_load_lds((const unsigned*)(kt_ + (size_t)64 * U.kpitch + koff), (LAS unsigned*)(K_lds + (bf) * SHM_K + 8192 + wid * 1024), 16, 0, 0); \
        if constexpr (MLA) __builtin_amdgcn_global_load_lds((const unsigned*)((const char*)U.PE + (size_t)(kb_) * U.pepitch * 2 + peoff), (LAS unsigned*)(PE_lds + (bf) * SHM_PE + wid * 1024), 16, 0, 0); } while (0)
#define SLOAD_V(kb_, bf) do { const char* vt_ = (const char*)U.V + (size_t)(kb_) * U.vpitch * 2; \
        __builtin_amdgcn_global_load_lds((const unsigned*)(vt_ + voff), (LAS unsigned*)(V_lds + (bf) * SHM_V + wid * 1024), 16, 0, 0); \
        __builtin_amdgcn_global_load_lds((const unsigned*)(vt_ + (size_t)64 * U.vpitch + voff), (LAS unsigned*)(V_lds + (bf) * SHM_V + 8192 + wid * 1024), 16, 0, 0); } while (0)
#define LOADMW(kb_) (*(const u32x2*)((const char*)U.BM + (size_t)((kb_) >> 5) * 4 + bmoff))
#define ACT_OF(kb_) ((MLA || DSA) ? ((kb_) <= qlo + 31) : (DIL ? (((kb_) <= qlo + 31) && ((kb_) + 63 >= qlo - 128)) : wact))
#define XPART1(PX0, PX1, KB_) do { qkt<KB_>(PX0, PX1, K_lds, r32, hi, qr); if constexpr (MLA) qkt_pe_lq<KB_>(PX0, PX1, PE_lds, r32, hi, qpe); } while (0)
#define XPART2(PX0, PX1, alX, kbx_) do { \
        if constexpr (MLA) { if ((kbx_) + 63 > qlo) mask_tile(PX0, PX1, qm - (kbx_), 0x7fffffffu); } \
        if constexpr (DIL) { if ((kbx_) + 63 > qlo || (kbx_) <= qlo + 31 - 129) mask_tile(PX0, PX1, qm - (kbx_), 129u); } \
        float mn_; partialSM<MODE>(PX0, PX1, m_reg, mn_, alX); } while (0)
#define HS(PX0, PX1, alX, actX, mwX, PY0, PY1, alY, actY, mwY, t_, KB_, VB_) do { const int kbx_ = KBASE(t_); \
        if ((t_) + 1 < NT) { const int kbn_ = KBASE((t_) + 1); SLOAD_K(kbn_, (KB_) ^ 1); } \
        SLOAD_V(kbx_, KB_); \
        actX = ACT_OF(kbx_); alX = 1.f; \
        bf16x8 pa0, pa1, pa2, pa3; \
        if (actX) XPART1(PX0, PX1, KB_); \
        if (actY) finishSM<DSA>(PY0, PY1, alY, l_reg, pa0, pa1, pa2, pa3, mwY.x >> (4 * hi), mwY.y >> (4 * hi)); \
        if constexpr (DSA) { if ((t_) + 1 < NT) mwY = LOADMW(KBASE((t_) + 1)); } \
        if (actY) { SBAR(); pv_tile<VB_>(o, vb0, pa0, pa1, pa2, pa3); } \
        if (actX) { XPART2(PX0, PX1, alX, kbx_); RESC(alX); } \
        VM_WAIT(); __syncthreads(); } while (0)
    f32x16 pA0, pA1, pB0, pB1; float alA = 1.f, alB = 1.f; bool actA = false, actB = false; u32x2 mwA = (u32x2){0u, 0u}, mwB = mwA;
    { const int kb0 = KBASE(0); SLOAD_K(kb0, 0); if constexpr (DSA) mwA = LOADMW(kb0); VM_WAIT(); }
    __syncthreads();
    {
        const int kb0 = KBASE(0);
        if (NT > 1) { const int kb1 = KBASE(1); SLOAD_K(kb1, 1); if constexpr (DSA) mwB = LOADMW(kb1); }
        SLOAD_V(kb0, 0);
        actA = ACT_OF(kb0);
        if (actA) { XPART1(pA0, pA1, 0); XPART2(pA0, pA1, alA, kb0); }
        VM_WAIT(); __syncthreads();
    }
    for (int t = 1; t < NT; t += 2) {
        HS(pB0, pB1, alB, actB, mwB, pA0, pA1, alA, actA, mwA, t, 1, 0);
        if (t + 1 < NT) HS(pA0, pA1, alA, actA, mwA, pB0, pB1, alB, actB, mwB, t + 1, 0, 1);
    }
    {
        bf16x8 pa0, pa1, pa2, pa3;
        if (NT & 1) { if (actA) { finishSM<DSA>(pA0, pA1, alA, l_reg, pa0, pa1, pa2, pa3, mwA.x >> (4 * hi), mwA.y >> (4 * hi)); SBAR(); pv_tile<0>(o, vb0, pa0, pa1, pa2, pa3); } }
        else { if (actB) { finishSM<DSA>(pB0, pB1, alB, l_reg, pa0, pa1, pa2, pa3, mwB.x >> (4 * hi), mwB.y >> (4 * hi)); SBAR(); pv_tile<1>(o, vb0, pa0, pa1, pa2, pa3); } }
    }
    __syncthreads();
#undef SLOAD_K
#undef SLOAD_V
#undef LOADMW
#undef ACT_OF
#undef XPART1
#undef XPART2
#undef HS
    }
    __builtin_amdgcn_s_setprio(0);
    if (hi == 0) li_l[r32] = l_reg;
    asm volatile("s_waitcnt lgkmcnt(0)" ::: "memory");
    float rli[16];
#pragma unroll
    for (int r = 0; r < 16; ++r) rli[r] = __builtin_amdgcn_rcpf(li_l[crow(r, hi)]);
    const bool oddl = (r32 & 1) != 0; const int pcol = oddl ? 31 + r32 : r32;
    if constexpr (MSEL) {
        if (wact) {
#pragma unroll
            for (int r = 0; r < 16; ++r) { const unsigned inf_ = rinfo[wid * 32 + crow(r, hi)];
                if (inf_ != 0xFFFFFFFFu) { bf16* rb = U.O + (size_t)(inf_ >> 16) * U.oslot + (size_t)(inf_ & 0xFFFFu) * U.opitch;
#pragma unroll
                    for (int dp = 0; dp < 2; ++dp) { const float va = o[2 * dp][r] * rli[r], vb = o[2 * dp + 1][r] * rli[r];
                        const float rv = __shfl_xor(oddl ? va : vb, 1);
                        *(unsigned*)(rb + dp * 64 + pcol) = cvt_pk_bf16(oddl ? rv : va, oddl ? vb : rv); } } }
            if (hi == 0 && rvalid) { const unsigned inf_ = rinfo[wid * 32 + r32];
                U.LSE[(size_t)(inf_ >> 16) * U.lslot + (size_t)(inf_ & 0xFFFFu) * U.lse_stride] = m_reg * C2 + __builtin_amdgcn_logf(l_reg); }
        }
    } else {
      { const unsigned lane_off = (unsigned)((4 * hi * U.opitch + pcol) * 2);
        const char* obase = (const char*)(U.O + (size_t)qlo * U.opitch);
#pragma unroll
        for (int r = 0; r < 16; ++r) { const char* rb = obase + (size_t)((r & 3) + 8 * (r >> 2)) * U.opitch * 2;
#pragma unroll
          for (int dp = 0; dp < 2; ++dp) { const float va = o[2 * dp][r] * rli[r], vb = o[2 * dp + 1][r] * rli[r];
              const float rv = __shfl_xor(oddl ? va : vb, 1);
              *(unsigned*)(rb + dp * 128 + lane_off) = cvt_pk_bf16(oddl ? rv : va, oddl ? vb : rv); } } }
      if constexpr (DIL) { if (hi == 0) U.LSE[(size_t)qrow * U.lse_stride] = m_reg * C2 + __builtin_amdgcn_logf(l_reg); }
      if constexpr (MOWN) { if (hi == 0) U.LSE[(size_t)3 * U.lslot + (size_t)qrow * U.lse_stride] = m_reg * C2 + __builtin_amdgcn_logf(l_reg); }
    }
    __syncthreads();
    DSEG(3);
#undef DSEG
#undef KBASE
#undef SLOAD
#undef RESC
#undef STEP
}
}

__device__ __forceinline__ void rope_row_heads128(bf16* kbase, const float* cs, const float* sn, int lane) {
    const int h = lane >> 3, i0 = (lane & 7) * 8;
    bf16* p = kbase + h * 128 + i0;
    bf16x8 a = *(const bf16x8*)p, b = *(const bf16x8*)(p + 64);
    att::rope_pair(a, b, cs + i0, sn + i0);
    *(bf16x8*)p = a; *(bf16x8*)(p + 64) = b;
}
__device__ __forceinline__ void post_even(Frame& F, const float* g_q, const float* g_kv, size_t ws_off = WS_PROJ) {
    bf16* PROJ = (bf16*)(F.ws + ws_off);
    const float* c128 = (const float*)(F.ws + WS_COS128); const float* s128 = (const float*)(F.ws + WS_SIN128);
    const float* c64 = (const float*)(F.ws + WS_COS64); const float* s64 = (const float*)(F.ws + WS_SIN64);
    const int gw = F.vcu * NWAVES + F.wave, NGW = F.G * NWAVES, lane = F.lane;
    for (int m = gw; m < T; m += NGW) {
        bf16* row = PROJ + (size_t)m * EVEN_INP; const int pos = m & (SEQ - 1);
        {
            bf16x8 v = *(const bf16x8*)(row + EC_CQ + lane * 8); float f[8], s = 0.f;
#pragma unroll
            for (int j = 0; j < 8; ++j) { f[j] = bf2f((unsigned short)v[j]); s += f[j] * f[j]; }
            const float rs = 1.0f / sqrtf(wave_sum(s) * (1.f / 512.f) + NORM_EPS);
            const f32x4 g0 = *(const f32x4*)(g_q + lane * 8), g1 = *(const f32x4*)(g_q + lane * 8 + 4);
            f32x4 o0 = {f[0] * rs * g0[0], f[1] * rs * g0[1], f[2] * rs * g0[2], f[3] * rs * g0[3]}, o1 = {f[4] * rs * g1[0], f[5] * rs * g1[1], f[6] * rs * g1[2], f[7] * rs * g1[3]};
            *(bf16x8*)(row + EC_CQ + lane * 8) = att::pack8(o0, o1); }
        {
            const u32x2 v = *(const u32x2*)(row + EC_CKV + lane * 4);
            const float f0 = bf2f((unsigned short)(v.x & 0xffff)), f1 = bf2f((unsigned short)(v.x >> 16)), f2 = bf2f((unsigned short)(v.y & 0xffff)), f3 = bf2f((unsigned short)(v.y >> 16));
            const float rs = 1.0f / sqrtf(wave_sum(f0 * f0 + f1 * f1 + f2 * f2 + f3 * f3) * (1.f / 256.f) + NORM_EPS);
            const f32x4 g0 = *(const f32x4*)(g_kv + lane * 4);
            u32x2 w; w.x = cvt_pk_bf16(f0 * rs * g0[0], f1 * rs * g0[1]); w.y = cvt_pk_bf16(f2 * rs * g0[2], f3 * rs * g0[3]);
            *(u32x2*)(row + EC_CKV + lane * 4) = w; }
        {
            const int i = lane & 31; bf16* p = row + ((lane < 32) ? EC_KPE : EC_KI) + i;
            const float x1 = bf2f(p[0]), x2 = bf2f(p[32]); const float c = c64[pos * 32 + i], s = s64[pos * 32 + i];
            const unsigned y = cvt_pk_bf16(x1 * c - x2 * s, x1 * s + x2 * c);
            p[0] = (bf16)(y & 0xffff); p[32] = (bf16)(y >> 16); }
        rope_row_heads128(row + EC_K, c128 + (size_t)pos * 64, s128 + (size_t)pos * 64, lane);
    }
}
__device__ __forceinline__ void post_odd(Frame& F) {
    bf16* PROJ = (bf16*)(F.ws + WS_PROJ2);
    const float* c128 = (const float*)(F.ws + WS_COS128); const float* s128 = (const float*)(F.ws + WS_SIN128);
    float* KMP = (float*)(F.ws + WS_KM);
    LAS float* red = (LAS float*)F.lds;
    const int lane = F.lane, h = lane >> 3, i0 = (lane & 7) * 8;
    for (int u = F.vcu; u < T / 64; u += F.G) {
        float sa[8], sb[8];
#pragma unroll
        for (int j = 0; j < 8; ++j) { sa[j] = 0.f; sb[j] = 0.f; }
        for (int rr = 0; rr < 8; ++rr) {
            const int m = u * 64 + F.wave * 8 + rr; const int pos = m & (SEQ - 1);
            bf16* row = PROJ + (size_t)m * ODD_IN;
            const float* cs = c128 + (size_t)pos * 64; const float* sn = s128 + (size_t)pos * 64;
            { bf16* p = row + OC_KC + h * 128 + i0; bf16x8 a = *(const bf16x8*)p, b = *(const bf16x8*)(p + 64);
              const f32x4 c0 = *(const f32x4*)(cs + i0), c1 = *(const f32x4*)(cs + i0 + 4), s0 = *(const f32x4*)(sn + i0), s1 = *(const f32x4*)(sn + i0 + 4);
              f32x4 y1a, y1b, y2a, y2b;
#pragma unroll
              for (int j = 0; j < 4; ++j) { const float x1 = bf2f((unsigned short)a[j]), x2 = bf2f((unsigned short)b[j]); y1a[j] = x1 * c0[j] - x2 * s0[j]; y2a[j] = x1 * s0[j] + x2 * c0[j];
                  const float z1 = bf2f((unsigned short)a[4 + j]), z2 = bf2f((unsigned short)b[4 + j]); y1b[j] = z1 * c1[j] - z2 * s1[j]; y2b[j] = z1 * s1[j] + z2 * c1[j];
                  sa[j] += y1a[j]; sa[4 + j] += y1b[j]; sb[j] += y2a[j]; sb[4 + j] += y2b[j]; }
              *(bf16x8*)p = att::pack8(y1a, y1b); *(bf16x8*)(p + 64) = att::pack8(y2a, y2b); }
            rope_row_heads128(row + OC_KD, cs, sn, lane);
        }
#pragma unroll
        for (int j = 0; j < 8; ++j) { red[F.wave * 1024 + h * 128 + i0 + j] = sa[j]; red[F.wave * 1024 + h * 128 + 64 + i0 + j] = sb[j]; }
        __syncthreads();
        { const int b = u / 128, jq = u % 128, jb = jq >> 2, q4 = jq & 3;
#pragma unroll
          for (int cc = 0; cc < 2; ++cc) { const int col = F.tid + cc * 512; float s = 0.f;
#pragma unroll
              for (int w = 0; w < 8; ++w) s += red[w * 1024 + col];
              const int hh = col >> 7, d = col & 127;
              KMP[((((size_t)b * 8 + hh) * 32 + jb) * 4 + q4) * 128 + d] = s; } }
        __syncthreads();
    }
}

#ifndef REPMASK
#define REPMASK 0ull
#endif
#define IDX_REP_A ((((REPMASK) >> 24) & 1ull) ? 2 : 1)
#define IDX_REP_B ((((REPMASK) >> 25) & 1ull) ? 2 : 1)
__device__ __forceinline__ void indexer_unit(Frame& F, int b, int i) {
    const bf16* PR = (const bf16*)(F.ws + WS_PROJ) + (size_t)b * SEQ * EVEN_INP;
    const float* c64 = (const float*)(F.ws + WS_COS64); const float* s64 = (const float*)(F.ws + WS_SIN64);
    float* SCw = (float*)(F.ws + WS_SC + (size_t)blockIdx.x * MiB);
    unsigned* BMb = (unsigned*)(F.ws + WS_BM) + (size_t)b * SEQ * 256;
    LAS unsigned char* lds = F.lds;
    const int tid = F.tid, wid = F.wave, lane = F.lane, r32 = lane & 31, hi = lane >> 5;
    const int t0 = 32 * i;
    LAS float* sgl = (LAS float*)(lds + 139264);
    {
        const int row = tid & 31, h = tid >> 5; const int pos = t0 + row;
        const float wv = bf2f(PR[(size_t)pos * EVEN_INP + EC_WI + h]) * 0.03125f;
        sgl[h * 32 + row] = wv < 0.f ? -1.f : 1.f;
        const bf16* qp = PR + (size_t)pos * EVEN_INP + EC_QI + h * 64;
        bf16x8 f[8];
#pragma unroll
        for (int p = 0; p < 8; ++p) f[p] = *(const bf16x8*)(qp + p * 8);
        { const float aw = fabsf(wv);
#pragma unroll
          for (int p = 0; p < 8; ++p) { f32x4 lo, hi4;
#pragma unroll
              for (int e = 0; e < 4; ++e) { lo[e] = bf2f((unsigned short)f[p][e]) * aw; hi4[e] = bf2f((unsigned short)f[p][4 + e]) * aw; }
              f[p] = att::pack8(lo, hi4); } }
#pragma unroll
        for (int p = 0; p < 8; ++p) *(LAS bf16x8*)(lds + ((((h * 4 + (p >> 1)) * 2 + (p & 1)) * 32 + row) * 16)) = f[p];
    }
    __syncthreads();
    {
        const int row = tid & 31, dg = tid >> 5, ks = dg >> 2, hi2 = (dg >> 1) & 1, e0 = (dg & 1) * 4;
        float acc4[4] = {0.f, 0.f, 0.f, 0.f};
#pragma unroll
        for (int h = 0; h < 16; ++h) { const u32x2 v = *(const LAS u32x2*)(lds + ((((h * 4 + ks) * 2 + hi2) * 32 + row) * 16) + e0 * 2); const float sg = sgl[h * 32 + row];
            acc4[0] += sg * bf2f((unsigned short)(v.x & 0xffff)); acc4[1] += sg * bf2f((unsigned short)(v.x >> 16));
            acc4[2] += sg * bf2f((unsigned short)(v.y & 0xffff)); acc4[3] += sg * bf2f((unsigned short)(v.y >> 16)); }
        u32x2 o2; o2.x = cvt_pk_bf16(acc4[0], acc4[1]); o2.y = cvt_pk_bf16(acc4[2], acc4[3]);
        *(LAS u32x2*)(lds + ((((16 * 4 + ks) * 2 + hi2) * 32 + row) * 16) + e0 * 2) = o2;
    }
    __syncthreads();
    const int nkeys = 32 * (i + 1), nsteps = (nkeys + 63) / 64;
    LAS float* tls = (LAS float*)(lds + 69632 + wid * 8704);
    for (int rep_ = 0; rep_ < IDX_REP_A; ++rep_) {
    bf16x8 ka[4], kb[4];
#define IDX_LDK(G_) do { const bf16* kp = PR + (size_t)(64 * (G_) + r32) * EVEN_INP + EC_KI + hi * 8; \
        _Pragma("unroll") for (int ks = 0; ks < 4; ++ks) { ka[ks] = *(const bf16x8*)(kp + ks * 16); kb[ks] = *(const bf16x8*)(kp + (size_t)32 * EVEN_INP + ks * 16); } } while (0)
    if (wid < nsteps) IDX_LDK(wid);
    for (int g = wid; g < nsteps; g += 8) {
        const int k0 = 64 * g;
        f32x16 s0 = f32x16{}, s1 = f32x16{};
        LAS const unsigned char* qb_ = lds + (hi * 32 + r32) * 16;
#define IDX_LDQ(Q, H) do { _Pragma("unroll") for (int ks = 0; ks < 4; ++ks) Q[ks] = *(const LAS bf16x8*)(qb_ + (H) * 4096 + ks * 1024); } while (0)
#define IDX_MMA(A0, A1, Q) do { A0 = f32x16{}; A1 = f32x16{}; _Pragma("unroll") for (int ks = 0; ks < 4; ++ks) { \
            A0 = __builtin_amdgcn_mfma_f32_32x32x16_bf16(ka[ks], Q[ks], A0, 0, 0, 0); A1 = __builtin_amdgcn_mfma_f32_32x32x16_bf16(kb[ks], Q[ks], A1, 0, 0, 0); } } while (0)
#define IDX_ACC(A0, A1, W) do { _Pragma("unroll") for (int r = 0; r < 16; ++r) { s0[r] = fmaf(W, __builtin_fabsf(A0[r]), s0[r]); s1[r] = fmaf(W, __builtin_fabsf(A1[r]), s1[r]); } } while (0)
        f32x16 a0, a1, b0, b1; bf16x8 qx[4], qy[4];
        IDX_LDQ(qx, 0); IDX_LDQ(qy, 1);
        IDX_MMA(a0, a1, qx);
#pragma unroll 1
        for (int h = 0; h < 16; h += 2) {
            const float w0 = sgl[h * 32 + r32], w1 = sgl[(h + 1) * 32 + r32];
            IDX_LDQ(qx, h + 2);
            __builtin_amdgcn_sched_barrier(0);
            IDX_MMA(b0, b1, qy);
            __builtin_amdgcn_sched_barrier(0);
            IDX_ACC(a0, a1, w0);
            __builtin_amdgcn_sched_barrier(0);
            if (h + 3 < 17) IDX_LDQ(qy, h + 3);
            __builtin_amdgcn_sched_barrier(0);
            IDX_MMA(a0, a1, qx);
            __builtin_amdgcn_sched_barrier(0);
            IDX_ACC(b0, b1, w1);
            __builtin_amdgcn_sched_barrier(0);
        }
#undef IDX_LDQ
        __builtin_amdgcn_sched_barrier(0);
        if (g + 8 < nsteps) IDX_LDK(g + 8);
        __builtin_amdgcn_sched_barrier(0);
#undef IDX_LDK
#pragma unroll
        for (int r = 0; r < 16; ++r) { s0[r] = 0.5f * (s0[r] + a0[r]); s1[r] = 0.5f * (s1[r] + a1[r]); }
#undef IDX_MMA
#undef IDX_ACC
#pragma unroll
        for (int q4 = 0; q4 < 4; ++q4) {
            *(LAS f32x4*)(tls + r32 * 68 + 8 * q4 + 4 * hi) = (f32x4){s0[4 * q4], s0[4 * q4 + 1], s0[4 * q4 + 2], s0[4 * q4 + 3]};
            *(LAS f32x4*)(tls + r32 * 68 + 32 + 8 * q4 + 4 * hi) = (f32x4){s1[4 * q4], s1[4 * q4 + 1], s1[4 * q4 + 2], s1[4 * q4 + 3]}; }
        LDS_WAIT(); asm volatile("" ::: "memory");
#pragma unroll
        for (int ps = 0; ps < 8; ++ps) { const int row = ps * 4 + (lane >> 4), c4 = (lane & 15) * 4;
            const f32x4 v = *(const LAS f32x4*)(tls + row * 68 + c4);
            u32x4 uu;
#pragma unroll
            for (int e = 0; e < 4; ++e) { const unsigned x = __float_as_uint(v[e]); const unsigned y = (x & 0x80000000u) ? ~x : (x | 0x80000000u);
                uu[e] = (k0 + c4 + e <= t0 + row) ? y : 0u; }
            *(u32x4*)(SCw + (size_t)row * 8192 + k0 + c4) = uu; }
        LDS_WAIT(); asm volatile("" ::: "memory");
    } }
    {
        const int kz0 = 64 * nsteps, kz1 = (kz0 + 1023) & ~1023, n4 = (kz1 - kz0) >> 2;
        for (int idx = tid; idx < 32 * n4; idx += 512) { const int row = idx / n4, c = idx - row * n4;
            *(u32x4*)(SCw + (size_t)row * 8192 + kz0 + 4 * c) = (u32x4){0u, 0u, 0u, 0u}; } }
    VM_WAIT();
    __syncthreads();
    __builtin_amdgcn_fence(__ATOMIC_ACQUIRE, "agent");
    VM_WAIT();
    unsigned u[128];
#define SEL_LOADG(g8_, kk_) do { const int rho_ = wid * 4 + (kk_), nch_ = (t0 + rho_ + 1 + 63) >> 6; \
        if ((g8_) * 16 < nch_) { const float* sg0 = SCw + (size_t)rho_ * 8192 + lane + (g8_) * 1024; asm volatile("" : "+v"(sg0));     \
            const GAS unsigned* sg = (const GAS unsigned*)sg0; \
            _Pragma("unroll") for (int jj = 0; jj < 16; ++jj) u[(g8_) * 16 + jj] = sg[64 * jj]; } \
        else { _Pragma("unroll") for (int jj = 0; jj < 16; ++jj) u[(g8_) * 16 + jj] = 0u; } } while (0)
#pragma unroll
    for (int g8 = 0; g8 < 8; ++g8) SEL_LOADG(g8, 0);
    for (int k_ = 0; k_ < 4 * IDX_REP_B; ++k_) { const int k = k_ & 3;
        const int rho = wid * 4 + k, t = t0 + rho, nvalid = t + 1, nch = (nvalid + 63) >> 6;
        const bool more_rows = k_ + 1 < 4 * IDX_REP_B; const int kn = (k_ + 1) & 3;
        unsigned tau = 1u;
#define SEL_COUNT(cand_, cnt_) do { cnt_ = 0; _Pragma("unroll") for (int g8 = 0; g8 < 8; ++g8) if (g8 * 16 < nch) { \
            _Pragma("unroll") for (int jj = 0; jj < 16; ++jj) { cnt_ += __builtin_popcountll(__ballot(u[g8 * 16 + jj] >= (cand_))); if ((jj & 7) == 7) asm volatile("" : "+s"(cnt_)); } } } while (0)
        if (nvalid > 256) {
            unsigned P = 0u; int c1 = 0;
            { const int ksm = (65536 + nvalid - 1) / nvalid;
              unsigned ps = 0u;
              for (int bit = 15; bit >= 0; --bit) { const unsigned cand = ps | (1u << bit); int cnt = 0;
#pragma unroll
                  for (int jj = 0; jj < 4; ++jj) cnt += __builtin_popcountll(__ballot(u[jj] >= (cand << 16)));
                  if (cnt >= ksm) ps = cand; }
              unsigned blo, bhi; int chi = 0, c0; SEL_COUNT(ps << 16, c0);
              if (c0 >= 256) { blo = ps; bhi = 0x10000u; unsigned step = 8u;
                  for (;;) { const unsigned cand = blo + step; if (cand > 0xFFFFu) { bhi = 0x10000u; chi = 0; break; }
                      int cc; SEL_COUNT(cand << 16, cc); if (cc >= 256) { blo = cand; step <<= 1; } else { bhi = cand; chi = cc; break; } }
              } else { bhi = ps; chi = c0; blo = 0u; unsigned step = 8u;
                  for (;;) { const unsigned cand = bhi > step ? bhi - step : 0u; int cc; SEL_COUNT(cand << 16, cc);
                      if (cc >= 256) { blo = cand; break; } else { bhi = cand; chi = cc; step <<= 1; } } }
              while (bhi - blo > 1u) { const unsigned mid = (blo + bhi) >> 1; int cm; SEL_COUNT(mid << 16, cm); if (cm >= 256) blo = mid; else { bhi = mid; chi = cm; } }
              P = blo << 16; c1 = chi; }
            constexpr int LCAP = 1024;
            LAS unsigned* lst = (LAS unsigned*)(lds + wid * (LCAP * 4));
            int c2 = 0;
#pragma unroll
            for (int g8 = 0; g8 < 8; ++g8) if (g8 * 16 < nch) {
#pragma unroll
                for (int jj = 0; jj < 16; ++jj) { const unsigned x = u[g8 * 16 + jj] ^ P; const bool fl = x < 65536u; const unsigned long long bal = __ballot(fl);
                    if (bal != 0ull) { const int pos = c2 + (int)__builtin_amdgcn_mbcnt_hi((unsigned)(bal >> 32), __builtin_amdgcn_mbcnt_lo((unsigned)bal, 0u));
                        if (fl && pos < LCAP) lst[pos] = x;
                        c2 += __builtin_popcountll(bal); } } }
            const int need = 256 - c1;
            if (c2 <= LCAP) {
                asm volatile("s_waitcnt lgkmcnt(0)" ::: "memory");
                unsigned L = 0u;
                for (int bit = 15; bit >= 0; --bit) { const unsigned cand = L | (1u << bit); int cnt = 0;
                    for (int i0 = 0; i0 < c2; i0 += 64) { const int i = i0 + lane; cnt += __builtin_popcountll(__ballot(i < c2 && lst[i < c2 ? i : 0] >= cand)); }
                    if (cnt >= need) L = cand; }
                tau = P | L;
            } else {
                tau = P;
                for (int bit = 15; bit >= 0; --bit) { const unsigned cand = tau | (1u << bit); int cnt; SEL_COUNT(cand, cnt); if (cnt >= 256) tau = cand; }
            }
        }
#undef SEL_COUNT
        unsigned* brow = BMb + (size_t)t * 256;
#pragma unroll
        for (int half = 0; half < 2; ++half) { unsigned lo = 0u, hw = 0u;
#pragma unroll
            for (int g4 = 0; g4 < 4; ++g4) { if ((half * 4 + g4) * 16 < nch) {
#pragma unroll
              for (int j16 = 0; j16 < 16; ++j16) { const int jj = g4 * 16 + j16; const unsigned long long bm = __ballot(u[half * 64 + jj] >= tau);
                const unsigned bl_ = (unsigned)bm, bh_ = (unsigned)(bm >> 32);
                asm volatile("s_nop 1\n\tv_writelane_b32 %0, %2, %4\n\tv_writelane_b32 %1, %3, %4" : "+v"(lo), "+v"(hw) : "s"(bl_), "s"(bh_), "n"(jj)); } }
              if (more_rows) SEL_LOADG(half * 4 + g4, kn); }
            *(u32x2*)(brow + (half * 64 + lane) * 2) = (u32x2){lo, hw}; }
    }
#undef SEL_LOADG
    __syncthreads();
}
__device__ __forceinline__ void dil_combine(Frame& F, bf16* O, const bf16* OG) {
    const float* LSE = (const float*)(F.ws + WS_LSE);
    const int gw = F.vcu * NWAVES + F.wave, NGW = F.G * NWAVES, lane = F.lane, h = lane >> 3;
    for (int m0 = gw; m0 < T; m0 += 2 * NGW) {
        int mr[2]; mr[0] = m0; mr[1] = (m0 + NGW < T) ? m0 + NGW : m0; const bool two = m0 + NGW < T;
        float l[2][3]; bf16x8 da[2][3], db[2][3];
#pragma unroll
        for (int q = 0; q < 2; ++q) {
#pragma unroll
            for (int g = 0; g < 3; ++g) { l[q][g] = LSE[((size_t)g * T + mr[q]) * 8 + h];
                const bf16* p = g == 0 ? O + (size_t)mr[q] * DM + 1024 + lane * 16 : OG + ((size_t)(g - 1) * T + mr[q]) * 1024 + lane * 16;
                da[q][g] = *(const bf16x8*)p; db[q][g] = *(const bf16x8*)(p + 8); } }
#pragma unroll
        for (int q = 0; q < 2; ++q) { if (q == 1 && !two) break;
            float w[3];
            const float mx = fmaxf(l[q][0], fmaxf(l[q][1], l[q][2]));
            float ssum = 0.f;
#pragma unroll
            for (int g = 0; g < 3; ++g) { w[g] = __builtin_amdgcn_exp2f(l[q][g] - mx); ssum += w[g]; }
            const float inv = 1.f / ssum;
            float acc[16];
#pragma unroll
            for (int g = 0; g < 3; ++g) { const bf16x8 a = da[q][g], b = db[q][g]; const float wg = w[g] * inv;
#pragma unroll
                for (int j = 0; j < 8; ++j) { const float xa = wg * bf2f((unsigned short)a[j]), xb = wg * bf2f((unsigned short)b[j]);
                    acc[j] = g == 0 ? xa : acc[j] + xa; acc[8 + j] = g == 0 ? xb : acc[8 + j] + xb; } }
            bf16* op = O + (size_t)mr[q] * DM + 1024 + lane * 16;
            *(bf16x8*)op = att::pack8((f32x4){acc[0], acc[1], acc[2], acc[3]}, (f32x4){acc[4], acc[5], acc[6], acc[7]});
            *(bf16x8*)(op + 8) = att::pack8((f32x4){acc[8], acc[9], acc[10], acc[11]}, (f32x4){acc[12], acc[13], acc[14], acc[15]}); }
    }
}
constexpr int MOBA_LPRE_OFF = 4096;
__device__ __forceinline__ int moba_chunk_table(Frame& F, const int* CNT, LAS int* ctab) {
    LAS int* wt = ctab + 512;
    int v = 0;
    LAS unsigned short* lpre = (LAS unsigned short*)((LAS char*)ctab + MOBA_LPRE_OFF);
    if (F.tid < 496) { const int bh = F.tid / 31, j = F.tid - bh * 31; int n = 0;
        int cvs[32]; cvs[0] = 0;
#pragma unroll
        for (int qb = 1; qb < 32; ++qb) cvs[qb] = CNT[(bh * 32 + qb) * 32 + j];
#pragma unroll
        for (int qb = 0; qb < 32; ++qb) { lpre[F.tid * 33 + qb] = (unsigned short)n; n += (qb > j) ? cvs[qb] : 0; }
        lpre[F.tid * 33 + 32] = (unsigned short)n;
        v = (n + 255) >> 8; }
    int incl = v;
#pragma unroll
    for (int o_ = 1; o_ < 64; o_ <<= 1) { const int x_ = __shfl_up(incl, o_); if (F.lane >= o_) incl += x_; }
    if (F.lane == 63) wt[F.wave] = incl;
    __syncthreads();
    int off = 0;
    for (int w_ = 0; w_ < F.wave; ++w_) off += wt[w_];
    ctab[F.tid] = off + incl - v;
    if (F.tid == 511) ctab[512 + 16] = off + incl;
    __syncthreads();
    return ctab[512 + 16];
}
__device__ __forceinline__ void moba_build_list(Frame& F, const unsigned* SEL, const int* CNT, int bh, int j, int c, LAS unsigned* rinfo, LAS int* wc) {
    const int tid = F.tid, lane = F.lane, wid = F.wave;
    if (tid < 256) rinfo[tid] = 0xFFFFFFFFu;
    __syncthreads();
    const int lo = 256 * c, hi_ = lo + 256;
    const int qbl = lane & 31;
    const LAS unsigned short* lp = (const LAS unsigned short*)((const LAS char*)F.lds + 98304 + MOBA_LPRE_OFF) + (bh * 31 + j) * 33 + qbl;
    const int start = (int)lp[0], cq = (int)lp[1] - start;
    const bool ov = cq > 0 && start < hi_ && start + cq > lo;
    unsigned ovm = (unsigned)__ballot(ov && lane < 32);
    for (int k = 0; ovm != 0u; ++k) {
        const int qb = __builtin_ctz(ovm); ovm &= ovm - 1u;
        if ((k & 7) != wid) continue;
        const int base = __shfl(start, qb);
        const u32x4 w4 = *(const u32x4*)(SEL + (size_t)bh * SEQ + qb * 256 + lane * 4);
        int f[4]; int n = 0;
#pragma unroll
        for (int e = 0; e < 4; ++e) { f[e] = (w4[e] >> j) & 1u; n += f[e]; }
        int inc2 = n;
#pragma unroll
        for (int o_ = 1; o_ < 64; o_ <<= 1) { const int v_ = __shfl_up(inc2, o_); if (lane >= o_) inc2 += v_; }
        int pos = base + inc2 - n;
#pragma unroll
        for (int e = 0; e < 4; ++e) { if (f[e]) { if (pos >= lo && pos < hi_) rinfo[pos - lo] = (unsigned)(qb * 256 + lane * 4 + e) | ((unsigned)__builtin_popcount(w4[e] & ((1u << j) - 1u)) << 16); ++pos; } }
    }
    __syncthreads();
}
__device__ __forceinline__ void moba_combine(Frame& F, bf16* O, const bf16* PO, const float* LSEP) {
    const int gw = F.vcu * NWAVES + F.wave, NGW = F.G * NWAVES, lane = F.lane, h = lane >> 3;
    for (int m0 = gw; m0 < T; m0 += 2 * NGW) {
        int mr[2]; mr[0] = m0; mr[1] = (m0 + NGW < T) ? m0 + NGW : m0; const bool two = m0 + NGW < T;
        float l[2][4]; bf16x8 da[2][4], db[2][4];
#pragma unroll
        for (int q = 0; q < 2; ++q) {
#pragma unroll
            for (int s_ = 0; s_ < 4; ++s_) { l[q][s_] = LSEP[((size_t)s_ * T + mr[q]) * 8 + h];
                const bf16* p = s_ == 3 ? O + (size_t)mr[q] * DM + lane * 16 : PO + ((size_t)s_ * T + mr[q]) * 1024 + lane * 16;
                da[q][s_] = *(const bf16x8*)p; db[q][s_] = *(const bf16x8*)(p + 8); } }
#pragma unroll
        for (int q = 0; q < 2; ++q) { if (q == 1 && !two) break;
            float w[4];
            const float mx = fmaxf(fmaxf(l[q][0], l[q][1]), fmaxf(l[q][2], l[q][3]));
            float ssum = 0.f;
#pragma unroll
            for (int s_ = 0; s_ < 4; ++s_) { w[s_] = __builtin_amdgcn_exp2f(l[q][s_] - mx); ssum += w[s_]; }
            const float inv = 1.f / ssum;
            float acc[16];
            { const bf16x8 a = da[q][3], b = db[q][3]; const float wg = w[3] * inv;
#pragma unroll
              for (int j = 0; j < 8; ++j) { acc[j] = wg * bf2f((unsigned short)a[j]); acc[8 + j] = wg * bf2f((unsigned short)b[j]); } }
#pragma unroll
            for (int s_ = 0; s_ < 3; ++s_) { const bool on = w[s_] > 0.f; const bf16x8 a = da[q][s_], b = db[q][s_]; const float wg = w[s_] * inv;
#pragma unroll
                for (int j = 0; j < 8; ++j) { const float xa = wg * bf2f((unsigned short)a[j]), xb = wg * bf2f((unsigned short)b[j]);
                    acc[j] += on ? xa : 0.f; acc[8 + j] += on ? xb : 0.f; } }
            bf16* op = O + (size_t)mr[q] * DM + lane * 16;
            *(bf16x8*)op = att::pack8((f32x4){acc[0], acc[1], acc[2], acc[3]}, (f32x4){acc[4], acc[5], acc[6], acc[7]});
            *(bf16x8*)(op + 8) = att::pack8((f32x4){acc[8], acc[9], acc[10], acc[11]}, (f32x4){acc[12], acc[13], acc[14], acc[15]}); }
    }
}
__global__ void __launch_bounds__(NWAVES * 64, 2) __attribute__((target("no-packed-fp32-ops"))) fwd_kernel(Args args) {
    extern __shared__ __attribute__((aligned(16))) unsigned char lds_raw[];
    Frame F;
    F.lds = (LAS unsigned char*)lds_raw;
    F.tid = threadIdx.x; F.lane = F.tid & 63; F.wave = __builtin_amdgcn_readfirstlane(F.tid >> 6);
    F.G = gridDim.x; { const int bx = blockIdx.x; F.vcu = (F.G % 8 == 0) ? (bx % 8) * (F.G / 8) + bx / 8 : bx; }
    F.ws = args.ws;
    volatile LAS unsigned* MISC = (volatile LAS unsigned*)(F.lds + MISC_OFF);
    for (int u = F.tid; u < (LDS_BYTES - MISC_OFF) / 4; u += NWAVES * 64) ((LAS unsigned*)(F.lds + MISC_OFF))[u] = 0u;
    __syncthreads();
    unsigned* ctl = (unsigned*)(F.ws + WS_CTL);
    XcdBarrier bar = xcd_barrier_post(ctl + CW_BAR, MISC + 8);
    const int lo = args.ph_lo, hi = args.ph_hi;
#ifndef REPMASK
#define REPMASK 0ull
#endif
#define REP(k) ((((REPMASK) >> (k)) & 1ull) ? 2 : 1)
#ifndef ONLY_MODE
#define ONLY_MODE (-1)
#endif
#ifndef PHMASK
#define PHMASK 0xFFFFFFFFull
#endif
#define IN(k) ((((PHMASK) >> (k)) & 1ull) && lo <= (k) && (k) < hi)
#ifdef DIAG_BARWAIT
    unsigned long long diag_acc = 0ull, diag_t0 = 0ull;
#define GRID_BAR() do { const unsigned long long t0_ = __builtin_amdgcn_s_memrealtime(); xcd_barrier(bar); if (DIAG_BARWAIT == 1) diag_acc += __builtin_amdgcn_s_memrealtime() - t0_; } while (0)
#define DT0(m_) do { if (DIAG_BARWAIT == (m_)) diag_t0 = __builtin_amdgcn_s_memrealtime(); } while (0)
#define DT1(m_) do { if (DIAG_BARWAIT == (m_)) diag_acc += __builtin_amdgcn_s_memrealtime() - diag_t0; } while (0)
#else
#define DT0(m_) do { } while (0)
#define DT1(m_) do { } while (0)
#define GRID_BAR() do { xcd_barrier(bar); if (REP(30) == 2) { xcd_barrier(bar); xcd_barrier(bar); } } while (0)
#endif

#define x_in     (args.in[0])
#define ln_mix   (args.in[1])
#define ln_mlp   (args.in[2])
#define ln_final (args.in[3])
#define e_w_in   (args.in[4])
#define e_g_q    (args.in[5])
#define e_g_kv   (args.in[6])
#define e_w_uq   (args.in[7])
#define e_w_ukv  (args.in[8])
#define e_w_out  (args.in[9])
#define o_w_in   (args.in[10])
#define o_w_out  (args.in[11])
#define mlp_w1   (args.in[12])
#define mlp_w2   (args.in[13])
    float* X = args.out;
    bf16* PROJ = (bf16*)(F.ws + WS_PROJ); bf16* PROJ2 = (bf16*)(F.ws + WS_PROJ2);
    const float* c128 = (const float*)(F.ws + WS_COS128); const float* s128 = (const float*)(F.ws + WS_SIN128);
    const float* c64 = (const float*)(F.ws + WS_COS64); const float* s64 = (const float*)(F.ws + WS_SIN64);

    DT0(8);
#ifdef SPIN_TICKS
    { const unsigned long long t0_ = __builtin_amdgcn_s_memrealtime(); while (__builtin_amdgcn_s_memrealtime() - t0_ < (unsigned long long)(SPIN_TICKS)) __builtin_amdgcn_s_sleep(8); }
#endif
    if (IN(0)) { for (int rep = 0; rep < REP(0); ++rep) {
        int crot = 0;
        convert_weight(F, e_w_in, DM, EVEN_IN, (bf16*)(F.ws + WS_WIN_E), nullptr, 2, &crot);
        convert_weight(F, e_w_uq, 512, 1536, (bf16*)(F.ws + WS_WUQ), e_g_q, 3, &crot);
        convert_weight(F, e_w_ukv, 256, 2048, (bf16*)(F.ws + WS_WUKV), e_g_kv, 0, &crot);
        convert_weight(F, e_w_out, DM, DM, (bf16*)(F.ws + WS_WOUT_E), nullptr, 0, &crot);
        convert_weight(F, o_w_in, DM, ODD_IN, (bf16*)(F.ws + WS_WIN_O), ln_mix + DM, 1, &crot);
        convert_weight(F, o_w_out, DM, DM, (bf16*)(F.ws + WS_WOUT_O), nullptr, 0, &crot);
        { u32x4* z = (u32x4*)((bf16*)(F.ws + WS_WIN_E) + (size_t)5024 * DM); const int n16 = 96 * DM * 2 / 16;
            for (int i = F.vcu * 512 + F.tid; i < n16; i += F.G * 512) z[i] = (u32x4){0u, 0u, 0u, 0u}; }
        rope_tables(F);
        rms_rows(F, x_in, ln_mix, (bf16*)(F.ws + WS_H0)); }
        GRID_BAR();
    }
    if (IN(1)) {
        pg8::Gemm g{(const bf16*)(F.ws + WS_H0), (const bf16*)(F.ws + WS_WIN_E), T, EVEN_INP, DM, DM, DM};
        pg8::StaticOrder S; S.init(T, EVEN_INP, F.G, (int)blockIdx.x);
        pg8::EpiRopeEven E{PROJ, EVEN_INP, c128, s128, c64, s64, (float*)(F.ws + WS_SSQ)};
        for (int rep = 0; rep < REP(1); ++rep) { DT0(2); pg8::gemm_phase(F.lds, g, S, E); DT1(2); }
        GRID_BAR();
    }
    if (IN(3)) {
        DT0(4);
        for (int rep = 0; rep < REP(3); ++rep)
        for (int it = blockIdx.x; it < 256; it += F.G) { const int b = it >> 7, p = it & 127;
            indexer_unit(F, b, 255 - p); indexer_unit(F, b, p); }
        DT1(4);
        GRID_BAR();
    }
    if (IN(4)) {
        { pg8::Gemm g{PROJ + EC_CQ, (const bf16*)(F.ws + WS_WUQ), T, 1536, 512, EVEN_INP, 512};
          pg8::StaticOrder S; S.init(T, 1536, F.G, (int)blockIdx.x);
          pg8::EpiUp<0, 8, 512, true> E{(bf16*)(F.ws + WS_Q), 1536, (const float*)(F.ws + WS_SSQ), c64, s64};
          { DT0(2); pg8::gemm_phase(F.lds, g, S, E); DT1(2); } }
        { pg8::Gemm g{PROJ + EC_CKV, (const bf16*)(F.ws + WS_WUKV), T, 2048, 256, EVEN_INP, 256};
          pg8::StaticOrder S; S.init(T, 2048, F.G, (int)blockIdx.x); S.kvbal = (F.G == 256);
          pg8::EpiUp<8, 4, 256, false> E{(bf16*)(F.ws + WS_KV), 2048, (const float*)(F.ws + WS_SSQ), c64, s64};
          { DT0(2); pg8::gemm_phase(F.lds, g, S, E); DT1(2); } }
        GRID_BAR();
    }
    if (IN(5)) { DT0(3);
        bf16* O = (bf16*)(F.ws + WS_H0);
        for (int it = F.vcu; it < 256; it += F.G) { const int bh = it >> 4, pi = it & 15, b = bh >> 3, h = bh & 7;
            const size_t r0 = (size_t)b * SEQ;
            for (int pass = 0; pass < 2 * REP(20); ++pass) { const int qb = (pass & 1) ? pi : 31 - pi;
                att::UnitArgs U{};
                U.Q = (const bf16*)(F.ws + WS_Q) + r0 * 1536 + h * 192; U.qpitch = 1536;
                U.K = (const bf16*)(F.ws + WS_KV) + r0 * 2048 + h * 256; U.kpitch = 2048;
                U.V = U.K + 128; U.vpitch = 2048;
                U.PE = PROJ + r0 * EVEN_INP + EC_KPE; U.pepitch = EVEN_INP;
                U.O = O + r0 * DM + h * 128; U.opitch = DM;
                U.cosT = c64; U.sinT = s64; U.pos0 = 0; U.posstride = 1; U.P0 = qb * 256;
                if (ONLY_MODE < 0 || ONLY_MODE == 0) att::attn_unit<att::MODE_MLA>((LAS char*)F.lds, U); }
            for (int pass = 0; pass < 2 * REP(21); ++pass) { const int qb = (pass & 1) ? pi : 31 - pi;
                att::UnitArgs U{};
                U.Q = PROJ + r0 * EVEN_INP + EC_Q + h * 128; U.qpitch = EVEN_INP;
                U.K = PROJ + r0 * EVEN_INP + EC_K + h * 128; U.kpitch = EVEN_INP;
                U.V = PROJ + r0 * EVEN_INP + EC_V + h * 128; U.vpitch = EVEN_INP;
                U.O = O + r0 * DM + 1024 + h * 128; U.opitch = DM;
                U.cosT = c128; U.sinT = s128; U.pos0 = 0; U.posstride = 1; U.P0 = qb * 256;
                U.BM = (const unsigned*)(F.ws + WS_BM) + r0 * 256;

#if defined(DIAG_SEG) && DIAG_UNITS == 4
                    U.dacc = &diag_acc;
#endif
                    if (ONLY_MODE < 0 || ONLY_MODE == 1) att::attn_unit<att::MODE_DSA>((LAS char*)F.lds, U); }
        }
        DT1(3);
        GRID_BAR();
    }
    if (IN(6)) {
        convert_weight(F, mlp_w1 + (size_t)0 * DM * DFF, DM, DFF, (bf16*)(F.ws + WS_W1B), ln_mlp + 0 * DM);
        convert_weight(F, mlp_w2 + (size_t)0 * DM * DFF, DFF, DM, (bf16*)(F.ws + WS_W2B));
        __syncthreads();
        pg8::Gemm g{(const bf16*)(F.ws + WS_H0), (const bf16*)(F.ws + WS_WOUT_E), T, DM, DM, DM, DM};
        pg8::StaticOrder S; S.init(T, DM, F.G, (int)blockIdx.x);
        pg8::EpiResBf16<true> E{x_in, (bf16*)(F.ws + WS_XB), (float*)(F.ws + WS_SSQ), DM};
        for (int rep = 0; rep < REP(6); ++rep) { DT0(2); pg8::gemm_phase(F.lds, g, S, E); DT1(2); }
        GRID_BAR();
    }
#ifdef DIAG_BARWAIT
#define DIAG_PUBLISH(L_) do { if ((L_) == 1) DT1(8); if ((L_) == 1 && F.tid == 0) __hip_atomic_fetch_add((unsigned long long*)(ctl + 8000), diag_acc, __ATOMIC_RELAXED, __HIP_MEMORY_SCOPE_AGENT); } while (0)
#else
#define DIAG_PUBLISH(L_) do { } while (0)
#endif
#define MLP_PHASES(LAYER) do { \
        if (IN(9)) { \
            pg8::Gemm g{(const bf16*)(F.ws + WS_XB), (const bf16*)(F.ws + WS_W1B), T, DFF, DM, DM, DM}; \
            pg8::StaticOrder S; S.init(T, DFF, F.G, (int)blockIdx.x); \
            pg8::EpiBf16<1, true> E{(bf16*)(F.ws + WS_HID), DFF, (const float*)(F.ws + WS_SSQ)}; \
            for (int rep = 0; rep < REP(9); ++rep) { DT0(2); pg8::gemm_phase(F.lds, g, S, E); DT1(2); } \
            GRID_BAR(); \
        } \
        if (IN(10)) { \
            pg8::Gemm g{(const bf16*)(F.ws + WS_HID), (const bf16*)(F.ws + WS_W2B), T, DM, DFF, DFF, DFF}; \
            pg8::StaticOrder S; S.init(T, DM, F.G, (int)blockIdx.x); \
            pg8::EpiResBf16<false> E{(const bf16*)(F.ws + WS_XB), (bf16*)(F.ws + WS_XB), (float*)(F.ws + WS_SSQ), DM}; \
            { DT0(2); pg8::gemm_phase(F.lds, g, S, E); DT1(2); } \
            DIAG_PUBLISH(LAYER); \
            GRID_BAR(); \
        } \
    } while (0)
    MLP_PHASES(0);
            if (IN(12)) {
                pg8::Gemm g{(const bf16*)(F.ws + WS_XB), (const bf16*)(F.ws + WS_WIN_O), T, ODD_IN, DM, DM, DM};
                pg8::StaticOrder S; S.init(T, ODD_IN, F.G, (int)blockIdx.x);
                pg8::EpiRopeOdd E{PROJ2, ODD_IN, c128, s128, (float*)(F.ws + WS_KM), (const float*)(F.ws + WS_SSQ)};
                for (int rep = 0; rep < REP(12); ++rep) { DT0(2); pg8::gemm_phase(F.lds, g, S, E); DT1(2); }
                GRID_BAR();
            }
            if (IN(14)) { DT0(5);
                bf16* O = (bf16*)(F.ws + WS_H1);
                for (int it = F.vcu; it < 256; it += F.G) { const int bh = it >> 4, pi = it & 15, b = bh >> 3, h = bh & 7;
                    const size_t r0 = (size_t)b * SEQ;
                    for (int pass = 0; pass < 2 * (REP(22) == 2 ? 5 : 1); ++pass) { const int qb = (pass & 1) ? pi : 31 - pi;
                        att::UnitArgs U{};
                        U.Q = PROJ2 + r0 * ODD_IN + OC_QC + h * 128; U.qpitch = ODD_IN;
                        U.K = PROJ2 + r0 * ODD_IN + OC_KC + h * 128; U.kpitch = ODD_IN;
                        U.V = PROJ2 + r0 * ODD_IN + OC_VC + h * 128; U.vpitch = ODD_IN;
                        U.O = O + r0 * DM + h * 128; U.opitch = DM;
                        U.cosT = c128; U.sinT = s128; U.pos0 = 0; U.posstride = 1; U.P0 = qb * 256; U.own = qb;
                        U.KMP = (const float*)(F.ws + WS_KM) + (size_t)bh * 32 * 512;
                        U.LSE = (float*)(F.ws + WS_MLSE) + r0 * 8 + h; U.lse_stride = 8; U.lslot = (size_t)T * 8;
                        U.SEL = (unsigned*)(F.ws + WS_SEL) + (size_t)bh * SEQ; U.CNT = (int*)(F.ws + WS_CNT) + (bh * 32 + qb) * 32;

#if defined(DIAG_SEG) && DIAG_UNITS == 3
                    U.dacc = &diag_acc;
#endif
                    if (ONLY_MODE < 0 || ONLY_MODE == 2) att::attn_unit<att::MODE_MOWN>((LAS char*)F.lds, U); }
                    for (int k6 = 0; k6 < 6 * REP(23); ++k6) { const int k = k6 % 6; const int w = k * 16 + pi, gi = w >> 5, u = w & 31;
                        const int d = gi == 0 ? 1 : (gi == 1 ? 4 : 16);
                        const int r = gi == 0 ? 0 : (gi == 1 ? (u >> 3) : (u >> 1)), qb = gi == 0 ? u : (gi == 1 ? (u & 7) : (u & 1));
                        att::UnitArgs U{};
                        const bf16* base = PROJ2 + (r0 + r) * ODD_IN + h * 128;
                        U.Q = base + OC_QD; U.K = base + OC_KD; U.V = base + OC_VD; U.qpitch = U.kpitch = U.vpitch = (size_t)d * ODD_IN;
                        if (gi == 0) { U.O = O + r0 * DM + 1024 + h * 128; U.opitch = DM; }
                        else { U.O = (bf16*)(F.ws + WS_OG) + ((size_t)(gi - 1) * T + r0 + r) * 1024 + h * 128; U.opitch = (size_t)d * 1024; }
                        U.LSE = (float*)(F.ws + WS_LSE) + ((size_t)gi * T + r0 + r) * 8 + h; U.lse_stride = d * 8;
                        U.cosT = c128; U.sinT = s128; U.pos0 = r; U.posstride = d; U.P0 = qb * 256;

#if defined(DIAG_SEG) && DIAG_UNITS == 2
                    U.dacc = &diag_acc;
#endif
                    if (ONLY_MODE < 0 || ONLY_MODE == 3) att::attn_unit<att::MODE_DIL>((LAS char*)F.lds, U); }
                }
                DT1(5);
                GRID_BAR();
            }
            if (IN(17)) { DT0(7); DT0(20); dil_combine(F, (bf16*)(F.ws + WS_H1), (const bf16*)(F.ws + WS_OG)); DT1(20);
                const unsigned* SEL = (const unsigned*)(F.ws + WS_SEL); const int* CNT = (const int*)(F.ws + WS_CNT);
                LAS int* ctab = (LAS int*)(F.lds + 98304);
                LAS unsigned* rinfo = (LAS unsigned*)(F.lds + att::OFF_TL); LAS int* wc = (LAS int*)(F.lds + att::OFF_LB);
                for (int rep = 0; rep < REP(17); ++rep) {
                DT0(21); const int total = moba_chunk_table(F, CNT, ctab); DT1(21);
                for (int id = F.vcu; id < total; id += F.G) {
                    DT0(22);
                    int lo_ = 0, hi_ = 496;
                    while (hi_ - lo_ > 1) { const int mid = (lo_ + hi_) >> 1; if (ctab[mid] <= id) lo_ = mid; else hi_ = mid; }
                    const int li = lo_, c = id - ctab[li], bh = li / 31, j = li - bh * 31, b = bh >> 3, h = bh & 7;
                    const size_t r0 = (size_t)b * SEQ;
                    att::UnitArgs U{};
                    U.Q = PROJ2 + r0 * ODD_IN + OC_QC + h * 128; U.qpitch = ODD_IN;
                    U.K = PROJ2 + r0 * ODD_IN + OC_KC + h * 128; U.kpitch = ODD_IN;
                    U.V = PROJ2 + r0 * ODD_IN + OC_VC + h * 128; U.vpitch = ODD_IN;
                    U.O = (bf16*)(F.ws + WS_MPO) + r0 * 1024 + h * 128; U.opitch = 1024; U.oslot = (size_t)T * 1024;
                    U.LSE = (float*)(F.ws + WS_MLSE) + r0 * 8 + h; U.lse_stride = 8; U.lslot = (size_t)T * 8;
                    U.cosT = c128; U.sinT = s128; U.pos0 = 0; U.posstride = 1; U.P0 = 0; U.own = j;

#if defined(DIAG_SEG) && DIAG_UNITS == 1
                    U.dacc = &diag_acc;
#endif
                    att::attn_preload_msel((LAS char*)F.lds, U);
                    moba_build_list(F, SEL, CNT, bh, j, c, rinfo, wc);
                    DT1(22);
                    att::attn_unit<att::MODE_MSEL>((LAS char*)F.lds, U);
                } }
                DT1(7);
                GRID_BAR();
            }
            if (IN(15)) { DT0(6); moba_combine(F, (bf16*)(F.ws + WS_H1), (const bf16*)(F.ws + WS_MPO), (const float*)(F.ws + WS_MLSE)); DT1(6); GRID_BAR(); }
            if (IN(16)) {
                convert_weight(F, mlp_w1 + (size_t)1 * DM * DFF, DM, DFF, (bf16*)(F.ws + WS_W1B), ln_mlp + 1 * DM);
                convert_weight(F, mlp_w2 + (size_t)1 * DM * DFF, DFF, DM, (bf16*)(F.ws + WS_W2B));
                __syncthreads();
                pg8::Gemm g{(const bf16*)(F.ws + WS_H1), (const bf16*)(F.ws + WS_WOUT_O), T, DM, DM, DM, DM};
                pg8::StaticOrder S; S.init(T, DM, F.G, (int)blockIdx.x);
                pg8::EpiResBf16<false> E{(const bf16*)(F.ws + WS_XB), (bf16*)(F.ws + WS_XB), (float*)(F.ws + WS_SSQ), DM};
                { DT0(2); pg8::gemm_phase(F.lds, g, S, E); DT1(2); }
                GRID_BAR();
            }
    MLP_PHASES(1);
#undef MLP_PHASES
#ifdef DIAG_BARWAIT
    float diag_scale = 1.f;
    { unsigned long long* dw = (unsigned long long*)(ctl + 8000);
      const unsigned long long tot = __hip_atomic_load(dw, __ATOMIC_RELAXED, __HIP_MEMORY_SCOPE_AGENT);
      const float avg_us = floorf((float)tot * 0.01f / (float)F.G / 8.f) * 8.f; diag_scale = 1.f + sqrtf(avg_us * (DIAG_BARWAIT == 2 ? 2e-7f : (DIAG_BARWAIT == 8 ? 1e-7f : (DIAG_BARWAIT >= 20 ? 4e-6f : 1e-6f)))); }
    if (IN(19)) rms_rows_final(F, (const bf16*)(F.ws + WS_XB), (const float*)(F.ws + WS_SSQ), X, ln_final, diag_scale);
#else
    if (IN(19)) rms_rows_final(F, (const bf16*)(F.ws + WS_XB), (const float*)(F.ws + WS_SSQ), X, ln_final);
#endif
#undef IN
#undef GRID_BAR
#undef x_in
#undef ln_mix
#undef ln_mlp
#undef ln_final
#undef e_w_in
#undef e_g_q
#undef e_g_kv
#undef e_w_uq
#undef e_w_ukv
#undef e_w_out
#undef o_w_in
#undef o_w_out
#undef mlp_w1
#undef mlp_w2
}

extern "C" void kernel_launch(void* const* d_in, const int* in_sizes, int n_in, void* d_out, int out_size, void* d_ws, size_t ws_size, hipStream_t stream) {
    static int grid = 0;
    if (grid == 0) {
        if (n_in != 14 || out_size != T * DM || ws_size < WS_END) { fprintf(stderr, "kernel_launch: unexpected shapes (n_in %d out %d ws %zu)\n", n_in, out_size, ws_size); grid = -1; return; }
        int dev = 0, cus = 0, per_cu = 0;
        if (hipGetDevice(&dev) != hipSuccess || hipDeviceGetAttribute(&cus, hipDeviceAttributeMultiprocessorCount, dev) != hipSuccess) { grid = -1; return; }
        if (hipFuncSetAttribute((const void*)fwd_kernel, hipFuncAttributeMaxDynamicSharedMemorySize, LDS_BYTES) != hipSuccess) { fprintf(stderr, "kernel_launch: hipFuncSetAttribute failed\n"); grid = -1; return; }
        if (hipOccupancyMaxActiveBlocksPerMultiprocessor(&per_cu, (const void*)fwd_kernel, NWAVES * 64, LDS_BYTES) != hipSuccess || per_cu < 1)
            fprintf(stderr, "kernel_launch: occupancy query reports %d\n", per_cu);
        (void)hipGetLastError();
        grid = cus;
    }
    if (grid < 0) return;
    (void)hipMemsetAsync((char*)d_ws + WS_CTL, 0, CTL_ZERO_BYTES, stream);
    Args a{};
    for (int i = 0; i < 14; ++i) a.in[i] = (const float*)d_in[i];
    a.out = (float*)d_out; a.ws = (unsigned char*)d_ws; a.ph_lo = 0; a.ph_hi = 64;
    hipLaunchKernelGGL(fwd_kernel, dim3(grid), dim3(NWAVES * 64), LDS_BYTES, stream, a);
}
```

```cpp
#include <hip/hip_runtime.h>
#include <cstdio>
#include <cstdint>

#define GAS __attribute__((address_space(1)))
#define LAS __attribute__((address_space(3)))
typedef unsigned short bf16;
typedef short bf16x8 __attribute__((ext_vector_type(8)));
typedef short s16x4 __attribute__((ext_vector_type(4)));
typedef float f32x4 __attribute__((ext_vector_type(4)));
typedef float f32x2 __attribute__((ext_vector_type(2)));
typedef float f32x16 __attribute__((ext_vector_type(16)));
typedef unsigned u32x4 __attribute__((ext_vector_type(4)));
typedef unsigned u32x2 __attribute__((ext_vector_type(2)));

constexpr int DM = 2048, BATCH = 2, SEQ = 8192, T = BATCH * SEQ, DFF = 8192;
constexpr int EVEN_IN = 5008, EVEN_INP = 5120, ODD_IN = 6144;
constexpr float NORM_EPS = 1e-6f;
constexpr int EC_CQ = 0, EC_CKV = 512, EC_KPE = 768, EC_Q = 832, EC_K = 1856, EC_V = 2880, EC_QI = 3904, EC_KI = 4928, EC_WI = 4992;
constexpr int OC_QC = 0, OC_KC = 1024, OC_VC = 2048, OC_QD = 3072, OC_KD = 4096, OC_VD = 5120;

constexpr size_t MiB = 1u << 20;
constexpr size_t WS_CTL = 0, CTL_ZERO_BYTES = 32768;
constexpr size_t WS_COS128 = 1 * MiB, WS_SIN128 = 3 * MiB, WS_COS64 = 5 * MiB, WS_SIN64 = 6 * MiB;
constexpr size_t WS_KM = 7 * MiB;
constexpr size_t WS_WOUT_O = 8 * MiB, WS_WIN_E = 16 * MiB, WS_WUQ = 36 * MiB, WS_WUKV = 38 * MiB, WS_WOUT_E = 39 * MiB, WS_WIN_O = 47 * MiB;
constexpr size_t WS_BM = 71 * MiB;
constexpr size_t WS_PROJ = 87 * MiB;
constexpr size_t WS_H0 = 247 * MiB;
constexpr size_t WS_SC = 247 * MiB;
constexpr size_t WS_Q = 311 * MiB, WS_KV = 359 * MiB;
constexpr size_t WS_H2 = 87 * MiB, WS_HID = 151 * MiB, WS_W1B = 407 * MiB, WS_W2B = 439 * MiB;
constexpr size_t WS_XB = 87 * MiB;
constexpr size_t WS_PROJ2 = 151 * MiB;
constexpr size_t WS_H1 = 343 * MiB;
constexpr size_t WS_SSQ = 509 * MiB;
constexpr size_t WS_OG = 16 * MiB;
constexpr size_t WS_MPO = 407 * MiB;
constexpr size_t WS_LSE = 503 * MiB;
constexpr size_t WS_MLSE = 505 * MiB;
constexpr size_t WS_SEL = 507 * MiB;
constexpr size_t WS_CNT = 508 * MiB;
constexpr size_t WS_END = 512 * MiB;
constexpr int CW_TMO = 0, CW_BAR = 4096;

constexpr int RING_BYTES = 131072;
constexpr int MISC_OFF = 147200;
constexpr int LDS_BYTES = 147456;
constexpr int NWAVES = 8;

__device__ __forceinline__ unsigned cvt_pk_bf16(float lo, float hi) { unsigned r; asm volatile("v_cvt_pk_bf16_f32 %0, %1, %2" : "=v"(r) : "v"(lo), "v"(hi)); return r; }
__device__ __forceinline__ float bf2f(unsigned short b) { return __builtin_bit_cast(float, ((unsigned)b) << 16); }
__device__ __forceinline__ float wave_sum(float v) {
#pragma unroll
    for (int o = 1; o < 64; o <<= 1) v += __shfl_xor(v, o);
    return v;
}
#define LDS_WAIT() asm volatile("s_waitcnt lgkmcnt(0)" ::: "memory")
#define VM_WAIT() asm volatile("s_waitcnt vmcnt(0)" ::: "memory")

namespace pg8 {
constexpr int BM = 256, BK = 64, HALF = 128, HTB = HALF * BK * 2, STAGE_BYTES = 8 * HTB, NXCD = 8, WGM = 4;
__host__ __device__ __forceinline__ int lds_byte(int r, int c) { const int st = (r >> 4) * 2 + (c >> 5), rr = r & 15, cc = c & 31, ob = rr * 64 + cc * 2; return st * 1024 + (ob ^ (((ob >> 9) & 1) << 5)); }
__host__ __device__ __forceinline__ void stage_rc(int b, int& R, int& C) { const int st = b / 1024, sb = b % 1024, swz = sb ^ (((sb >> 9) & 1) << 5); R = (st >> 1) * 16 + swz / 64; C = (st & 1) * 32 + (swz % 64) / 2; }
__host__ __device__ __forceinline__ int perm32(int rho) { const int n = rho >> 4, i = rho & 15; return 8 * (i >> 2) + 4 * n + (i & 3); }

struct Unit { int pm, pn; };
struct Gemm { const bf16* A; const bf16* Bt; int M, N, K, lda, ldb; };

struct StaticOrder {
    int nM, nN, nwg, G, c, kvbal;
    __host__ __device__ __forceinline__ void init(int M, int N, int G_, int c_) { nM = M / BM; nN = N / BM; nwg = nM * nN; G = G_; c = c_; kvbal = 0; }
    __host__ __device__ __forceinline__ bool next(int i, Unit& u) const {
        long L = (long)i * G + c;
        if (kvbal) {
            if (c < 128) L = i == 0 ? c : nwg; else L = i < 3 ? 128 + 3 * (c - 128) + i : nwg; }
        if (L >= nwg) return false;
        int wgid = (int)L; { const int q = nwg / NXCD, r = nwg % NXCD, xcd = wgid % NXCD, off = wgid / NXCD; wgid = (xcd < r ? xcd * (q + 1) : r * (q + 1) + (xcd - r) * q) + off; }
        const int nig = WGM * nN, gid = wgid / nig, fm = gid * WGM, gsz = (nM - fm) < WGM ? (nM - fm) : WGM;
        u.pm = fm + ((wgid % nig) % gsz); u.pn = (wgid % nig) / gsz; return true;
    }
};

template <int ACT  , bool SCALED = false> struct EpiBf16 {
    static constexpr bool PERM = true;
    static constexpr bool HAS_PRE = SCALED;
    bf16* O; int ldc; const float* ssq;
    __device__ __forceinline__ void pre_issue(const Unit& u, int wr, int wc, int fr, int fq, f32x4 (&raw)[2][2]) const {
        const int row0 = u.pm * BM + wr * 64 + fr + wc * 16;
#pragma unroll
        for (int ai = 0; ai < 2; ++ai) { const float* sp = ssq + (size_t)(row0 + ai * HALF) * 32 + fq * 8; raw[ai][0] = *(const f32x4*)sp; raw[ai][1] = *(const f32x4*)(sp + 4); }
    }
    __device__ __forceinline__ void pre_finish(const f32x4 (&raw)[2][2], float (&rs)[2]) const {
#pragma unroll
        for (int ai = 0; ai < 2; ++ai) { const f32x4 a = raw[ai][0], b = raw[ai][1];
            float s = ((a[0] + a[1]) + (a[2] + a[3])) + ((b[0] + b[1]) + (b[2] + b[3]));
            s += __shfl_xor(s, 16); s += __shfl_xor(s, 32);
            rs[ai] = __builtin_amdgcn_rsqf(s * (1.f / DM) + NORM_EPS); }
    }
    __device__ __forceinline__ void half(const f32x4 (&acc)[2][2][4][2], const Unit& u, int ai, int wr, int wc, int fr, int fq, const float (&rs)[4]) const {
        const int row0 = u.pm * BM + wr * 64 + fr; const int col0 = u.pn * BM + wc * 32 + 8 * fq;
#pragma unroll
        for (int m = 0; m < 4; ++m) { bf16* rowp = O + (size_t)(row0 + ai * HALF + m * 16) * ldc + col0;
#pragma unroll
            for (int bj = 0; bj < 2; ++bj) { f32x4 v0 = acc[ai][bj][m][0], v1 = acc[ai][bj][m][1];
                if constexpr (SCALED) { v0 = v0 * rs[m]; v1 = v1 * rs[m]; }
                if (ACT == 1) {
#pragma unroll
                    for (int j = 0; j < 4; ++j) { const float a = fmaxf(v0[j], 0.f), b = fmaxf(v1[j], 0.f); v0[j] = a * a; v1[j] = b * b; } }
                u32x4 w; w.x = cvt_pk_bf16(v0[0], v0[1]); w.y = cvt_pk_bf16(v0[2], v0[3]); w.z = cvt_pk_bf16(v1[0], v1[1]); w.w = cvt_pk_bf16(v1[2], v1[3]);
                *(u32x4*)(rowp + bj * HALF) = w; } }
    }
};
struct EpiRopeOdd {
    static constexpr bool PERM = true;
    static constexpr bool HAS_PRE = false;
    bf16* O; int ldc; const float* cosT; const float* sinT; float* KMP; const float* ssq;
    __device__ __forceinline__ void operator()(const f32x4 (&acc)[2][2][4][2], const Unit& u, int wr, int wc, int fr, int fq) const {
        const int row0 = u.pm * BM + wr * 64 + fr; const int col0 = u.pn * BM + wc * 32 + 8 * fq;
        const bool roped = (u.pn < 8) || (u.pn >= 12 && u.pn < 20);
        const bool ksum = (u.pn >= 4 && u.pn < 8);
        float colsum[2][2][8];
#pragma unroll
        for (int ai = 0; ai < 2; ++ai)
#pragma unroll
            for (int bj = 0; bj < 2; ++bj)
#pragma unroll
                for (int e = 0; e < 8; ++e) colsum[ai][bj][e] = 0.f;
        struct Ld { f32x4 a, b, cs[2], sn[2]; };
        Ld L[2];
#define ERO_ISSUE(g_, D_) do { const int row_ = row0 + ((g_) >> 2) * HALF + ((g_) & 3) * 16; const float* sp_ = ssq + (size_t)row_ * 32 + fq * 8; D_.a = *(const f32x4*)sp_; D_.b = *(const f32x4*)(sp_ + 4); \
            if (roped) { const int pos_ = row_ & (SEQ - 1); _Pragma("unroll") for (int bj_ = 0; bj_ < 2; ++bj_) { const int i0_ = ((col0 + bj_ * HALF) & 127) >> 1; \
                D_.cs[bj_] = *(const f32x4*)(cosT + (size_t)pos_ * 64 + i0_); D_.sn[bj_] = *(const f32x4*)(sinT + (size_t)pos_ * 64 + i0_); } } } while (0)
        ERO_ISSUE(0, L[0]);
#pragma unroll
        for (int g8 = 0; g8 < 8; ++g8) { const int ai = g8 >> 2, m = g8 & 3; const int row = row0 + ai * HALF + m * 16; bf16* rowp = O + (size_t)row * ldc + col0;
                if (g8 + 1 < 8) ERO_ISSUE(g8 + 1, L[(g8 + 1) & 1]);
                asm volatile("" ::: "memory");
                const Ld& D = L[g8 & 1];
                float rs;
                { const f32x4 a = D.a, b = D.b;
                  float s = ((a[0] + a[1]) + (a[2] + a[3])) + ((b[0] + b[1]) + (b[2] + b[3])); s += __shfl_xor(s, 16); s += __shfl_xor(s, 32);
                  rs = __builtin_amdgcn_rsqf(s * (1.f / DM) + NORM_EPS); }
#pragma unroll
                for (int bj = 0; bj < 2; ++bj) { f32x4 v0 = acc[ai][bj][m][0] * rs, v1 = acc[ai][bj][m][1] * rs;
                    if (roped) { const f32x4 c = D.cs[bj], s = D.sn[bj];
                        const f32x4 r0 = {v0[0] * c[0] - v0[1] * s[0], v0[0] * s[0] + v0[1] * c[0], v0[2] * c[1] - v0[3] * s[1], v0[2] * s[1] + v0[3] * c[1]};
                        const f32x4 r1 = {v1[0] * c[2] - v1[1] * s[2], v1[0] * s[2] + v1[1] * c[2], v1[2] * c[3] - v1[3] * s[3], v1[2] * s[3] + v1[3] * c[3]};
                        v0 = r0; v1 = r1; }
                    if (ksum) {
#pragma unroll
                        for (int e = 0; e < 4; ++e) { colsum[ai][bj][e] += v0[e]; colsum[ai][bj][4 + e] += v1[e]; } }
                    u32x4 w; w.x = cvt_pk_bf16(v0[0], v0[1]); w.y = cvt_pk_bf16(v0[2], v0[3]); w.z = cvt_pk_bf16(v1[0], v1[1]); w.w = cvt_pk_bf16(v1[2], v1[3]);
                    *(u32x4*)(rowp + bj * HALF) = w; } }
#undef ERO_ISSUE
        if (ksum) {
            const int b = u.pm >> 5, jb = u.pm & 31;
#pragma unroll
            for (int ai = 0; ai < 2; ++ai)
#pragma unroll
                for (int bj = 0; bj < 2; ++bj) {
#pragma unroll
                    for (int e = 0; e < 8; ++e) { float s = colsum[ai][bj][e]; s += __shfl_xor(s, 1); s += __shfl_xor(s, 2); s += __shfl_xor(s, 4); s += __shfl_xor(s, 8); colsum[ai][bj][e] = s; }
                    if (fr == 0) { const int col = col0 + bj * HALF - 1024, hh = col >> 7, d = col & 127;
                        float* kp = KMP + ((((size_t)b * 8 + hh) * 32 + jb) * 4 + (ai * 2 + wr)) * 128 + d;
                        *(f32x4*)kp = (f32x4){colsum[ai][bj][0], colsum[ai][bj][1], colsum[ai][bj][2], colsum[ai][bj][3]};
                        *(f32x4*)(kp + 4) = (f32x4){colsum[ai][bj][4], colsum[ai][bj][5], colsum[ai][bj][6], colsum[ai][bj][7]}; } }
        }
    }
};
struct EpiRopeEven {
    static constexpr bool PERM = true;
    static constexpr bool HAS_PRE = false;
    bf16* O; int ldc; const float* c128; const float* s128; const float* c64; const float* s64; float* ssq;
    __device__ __forceinline__ void operator()(const f32x4 (&acc)[2][2][4][2], const Unit& u, int wr, int wc, int fr, int fq) const {
        const int row0 = u.pm * BM + wr * 64 + fr; const int col0 = u.pn * BM + wc * 32 + 8 * fq;
        int cls[2], i0[2];
#pragma unroll
        for (int bj = 0; bj < 2; ++bj) { const int colw = u.pn * BM + bj * HALF + wc * 32, col = col0 + bj * HALF;
            cls[bj] = (colw >= 832 && colw < 2880) ? 1 : (((colw >= 768 && colw < 832) || (colw >= 3904 && colw < 4992)) ? 2 : 0);
            i0[bj] = cls[bj] == 1 ? (((col - 832) & 127) >> 1) : ((col & 63) >> 1); }
        const bool dossq = u.pn < 3;
        struct Ld { f32x4 c[2], s[2]; };
        Ld L[2];
#define ERE_ISSUE(g_, D_) do { const int pos_ = (row0 + ((g_) >> 2) * HALF + ((g_) & 3) * 16) & (SEQ - 1); _Pragma("unroll") for (int bj_ = 0; bj_ < 2; ++bj_) { \
            if (cls[bj_] == 1) { D_.c[bj_] = *(const f32x4*)(c128 + (size_t)pos_ * 64 + i0[bj_]); D_.s[bj_] = *(const f32x4*)(s128 + (size_t)pos_ * 64 + i0[bj_]); } \
            else if (cls[bj_] == 2) { D_.c[bj_] = *(const f32x4*)(c64 + (size_t)pos_ * 32 + i0[bj_]); D_.s[bj_] = *(const f32x4*)(s64 + (size_t)pos_ * 32 + i0[bj_]); } } } while (0)
        ERE_ISSUE(0, L[0]);
#pragma unroll
        for (int g8 = 0; g8 < 8; ++g8) { const int ai = g8 >> 2, m = g8 & 3; const int row = row0 + ai * HALF + m * 16; bf16* rowp = O + (size_t)row * ldc + col0;
                if (g8 + 1 < 8) ERE_ISSUE(g8 + 1, L[(g8 + 1) & 1]);
                asm volatile("" ::: "memory");
                const Ld& D = L[g8 & 1];
                float ss = 0.f;
#pragma unroll
                for (int bj = 0; bj < 2; ++bj) { f32x4 v0 = acc[ai][bj][m][0], v1 = acc[ai][bj][m][1];
                    if (cls[bj] != 0) { const f32x4 c = D.c[bj], s = D.s[bj];
                        const f32x4 r0 = {v0[0] * c[0] - v0[1] * s[0], v0[0] * s[0] + v0[1] * c[0], v0[2] * c[1] - v0[3] * s[1], v0[2] * s[1] + v0[3] * c[1]};
                        const f32x4 r1 = {v1[0] * c[2] - v1[1] * s[2], v1[0] * s[2] + v1[1] * c[2], v1[2] * c[3] - v1[3] * s[3], v1[2] * s[3] + v1[3] * c[3]};
                        v0 = r0; v1 = r1; }
                    if (dossq) ss += ((v0[0] * v0[0] + v0[1] * v0[1]) + (v0[2] * v0[2] + v0[3] * v0[3])) + ((v1[0] * v1[0] + v1[1] * v1[1]) + (v1[2] * v1[2] + v1[3] * v1[3]));
                    u32x4 w; w.x = cvt_pk_bf16(v0[0], v0[1]); w.y = cvt_pk_bf16(v0[2], v0[3]); w.z = cvt_pk_bf16(v1[0], v1[1]); w.w = cvt_pk_bf16(v1[2], v1[3]);
                    *(u32x4*)(rowp + bj * HALF) = w; }
                if (dossq) { ss += __shfl_xor(ss, 16); ss += __shfl_xor(ss, 32); if (fq == 0) ssq[(size_t)row * 16 + u.pn * 4 + wc] = ss; } }
#undef ERE_ISSUE
    }
};
template <int P0, int NP, int NCOL, bool ROPEQ> struct EpiUp {
    static constexpr bool PERM = true;
    static constexpr bool HAS_PRE = false;
    bf16* O; int ldc; const float* ssq; const float* c64; const float* s64;
    __device__ __forceinline__ void operator()(const f32x4 (&acc)[2][2][4][2], const Unit& u, int wr, int wc, int fr, int fq) const {
        const int row0 = u.pm * BM + wr * 64 + fr; const int col0 = u.pn * BM + wc * 32 + 8 * fq;
        bool rp[2]; int i0[2];
#pragma unroll
        for (int bj = 0; bj < 2; ++bj) { const int colw = u.pn * BM + bj * HALF + wc * 32, col = col0 + bj * HALF; const int o = colw % 192;
            rp[bj] = ROPEQ && o >= 128; i0[bj] = ((col % 192) - 128) >> 1; }
        struct Ld { f32x4 p[NP / 4], c[2], sn[2]; };
        Ld L[2];
#define EUP_ISSUE(g_, D_) do { const int row_ = row0 + ((g_) >> 2) * HALF + ((g_) & 3) * 16; const int pos_ = row_ & (SEQ - 1); \
            _Pragma("unroll") for (int q4_ = 0; q4_ < NP / 4; ++q4_) D_.p[q4_] = *(const f32x4*)(ssq + (size_t)row_ * 16 + P0 + 4 * q4_); \
            _Pragma("unroll") for (int bj_ = 0; bj_ < 2; ++bj_) if (rp[bj_]) { D_.c[bj_] = *(const f32x4*)(c64 + (size_t)pos_ * 32 + i0[bj_]); D_.sn[bj_] = *(const f32x4*)(s64 + (size_t)pos_ * 32 + i0[bj_]); } } while (0)
        EUP_ISSUE(0, L[0]);
#pragma unroll
        for (int g8 = 0; g8 < 8; ++g8) { const int ai = g8 >> 2, m = g8 & 3; const int row = row0 + ai * HALF + m * 16; bf16* rowp = O + (size_t)row * ldc + col0;
                if (g8 + 1 < 8) EUP_ISSUE(g8 + 1, L[(g8 + 1) & 1]);
                asm volatile("" ::: "memory");
                const Ld& D = L[g8 & 1];
                float s = 0.f;
#pragma unroll
                for (int q4 = 0; q4 < NP / 4; ++q4) { const f32x4 a = D.p[q4]; s += (a[0] + a[1]) + (a[2] + a[3]); }
                const float rs = __builtin_amdgcn_rsqf(s * (1.f / NCOL) + NORM_EPS);
#pragma unroll
                for (int bj = 0; bj < 2; ++bj) { f32x4 v0 = acc[ai][bj][m][0] * rs, v1 = acc[ai][bj][m][1] * rs;
                    if (rp[bj]) { const f32x4 c = D.c[bj], sn = D.sn[bj];
                        const f32x4 r0 = {v0[0] * c[0] - v0[1] * sn[0], v0[0] * sn[0] + v0[1] * c[0], v0[2] * c[1] - v0[3] * sn[1], v0[2] * sn[1] + v0[3] * c[1]};
                        const f32x4 r1 = {v1[0] * c[2] - v1[1] * sn[2], v1[0] * sn[2] + v1[1] * c[2], v1[2] * c[3] - v1[3] * sn[3], v1[2] * sn[3] + v1[3] * c[3]};
                        v0 = r0; v1 = r1; }
                    u32x4 w; w.x = cvt_pk_bf16(v0[0], v0[1]); w.y = cvt_pk_bf16(v0[2], v0[3]); w.z = cvt_pk_bf16(v1[0], v1[1]); w.w = cvt_pk_bf16(v1[2], v1[3]);
                    *(u32x4*)(rowp + bj * HALF) = w; } }
#undef EUP_ISSUE
    }
};
struct EpiResF32 {
    static constexpr bool PERM = false;
    static constexpr bool HAS_PRE = false;
    const float* base; float* out; int ldc;
    __device__ __forceinline__ void operator()(const f32x4 (&acc)[2][2][4][2], const Unit& u, int wr, int wc, int fr, int fq) const {
        const int row0 = u.pm * BM + wr * 64 + fr, col0 = u.pn * BM + wc * 32 + 4 * fq;
#pragma unroll
        for (int ai = 0; ai < 2; ++ai)
#pragma unroll
            for (int m = 0; m < 4; ++m) { const size_t off = (size_t)(row0 + ai * HALF + m * 16) * ldc + col0;
                f32x4 bs[2][2];
#pragma unroll
                for (int bj = 0; bj < 2; ++bj)
#pragma unroll
                    for (int n = 0; n < 2; ++n) bs[bj][n] = *(const f32x4*)(base + off + bj * HALF + n * 16);
#pragma unroll
                for (int bj = 0; bj < 2; ++bj)
#pragma unroll
                    for (int n = 0; n < 2; ++n) *(f32x4*)(out + off + bj * HALF + n * 16) = acc[ai][bj][m][n] + bs[bj][n];
                asm volatile("" ::: "memory"); }
    }
};

template <bool XB> struct EpiResF32X {
    static constexpr bool PERM = true;
    static constexpr bool HAS_PRE = false;
    const float* base; float* out; bf16* xb; float* ssq; int ldc;
    __device__ __forceinline__ void operator()(const f32x4 (&acc)[2][2][4][2], const Unit& u, int wr, int wc, int fr, int fq) const {
        const int row0 = u.pm * BM + wr * 64 + fr, col0 = u.pn * BM + wc * 32 + 8 * fq;
        f32x4 vn[2][2];
#define ERX_LOAD(g_) do { const size_t off_ = (size_t)(row0 + ((g_) >> 2) * HALF + ((g_) & 3) * 16) * ldc + col0; \
            _Pragma("unroll") for (int bj = 0; bj < 2; ++bj) _Pragma("unroll") for (int n = 0; n < 2; ++n) vn[bj][n] = *(const f32x4*)(base + off_ + bj * HALF + n * 4); } while (0)
        ERX_LOAD(0);
#pragma unroll
        for (int g = 0; g < 8; ++g) { const int ai = g >> 2, m = g & 3; const int row = row0 + ai * HALF + m * 16; const size_t off = (size_t)row * ldc + col0;
            f32x4 v[2][2];
#pragma unroll
            for (int bj = 0; bj < 2; ++bj)
#pragma unroll
                for (int n = 0; n < 2; ++n) v[bj][n] = vn[bj][n];
            if (g < 7) ERX_LOAD(g + 1);
            asm volatile("" ::: "memory");
            float ss = 0.f;
#pragma unroll
            for (int bj = 0; bj < 2; ++bj) { const f32x4 o0 = acc[ai][bj][m][0] + v[bj][0], o1 = acc[ai][bj][m][1] + v[bj][1];
                *(f32x4*)(out + off + bj * HALF) = o0; *(f32x4*)(out + off + bj * HALF + 4) = o1;
                if constexpr (XB) { u32x4 w; w.x = cvt_pk_bf16(o0[0], o0[1]); w.y = cvt_pk_bf16(o0[2], o0[3]); w.z = cvt_pk_bf16(o1[0], o1[1]); w.w = cvt_pk_bf16(o1[2], o1[3]);
                    *(u32x4*)(xb + off + bj * HALF) = w;
                    ss += ((o0[0] * o0[0] + o0[1] * o0[1]) + (o0[2] * o0[2] + o0[3] * o0[3])) + ((o1[0] * o1[0] + o1[1] * o1[1]) + (o1[2] * o1[2] + o1[3] * o1[3])); } }
            if constexpr (XB) { ss += __shfl_xor(ss, 16); ss += __shfl_xor(ss, 32);
                if (fq == 0) ssq[(size_t)row * 32 + u.pn * 4 + wc] = ss; }
        }
#undef ERX_LOAD
    }
};

template <bool BASE_F32> struct EpiResBf16 {
    static constexpr bool PERM = true;
    static constexpr bool HAS_PRE = false;
    const void* base; bf16* xb; float* ssq; int ldc;
    __device__ __forceinline__ void operator()(const f32x4 (&acc)[2][2][4][2], const Unit& u, int wr, int wc, int fr, int fq) const {
        const int row0 = u.pm * BM + wr * 64 + fr, col0 = u.pn * BM + wc * 32 + 8 * fq;
        f32x4 vn[2][2];
#define ERB_LOAD(g_) do { const size_t off_ = (size_t)(row0 + ((g_) >> 2) * HALF + ((g_) & 3) * 16) * ldc + col0; \
            _Pragma("unroll") for (int bj = 0; bj < 2; ++bj) { \
                if constexpr (BASE_F32) { vn[bj][0] = *(const f32x4*)((const float*)base + off_ + bj * HALF); vn[bj][1] = *(const f32x4*)((const float*)base + off_ + bj * HALF + 4); } \
                else { const u32x4 w_ = *(const u32x4*)((const bf16*)base + off_ + bj * HALF); \
                    vn[bj][0] = (f32x4){__uint_as_float(w_.x << 16), __uint_as_float(w_.x & 0xffff0000u), __uint_as_float(w_.y << 16), __uint_as_float(w_.y & 0xffff0000u)}; \
                    vn[bj][1] = (f32x4){__uint_as_float(w_.z << 16), __uint_as_float(w_.z & 0xffff0000u), __uint_as_float(w_.w << 16), __uint_as_float(w_.w & 0xffff0000u)}; } } } while (0)
        ERB_LOAD(0);
#pragma unroll
        for (int g = 0; g < 8; ++g) { const int ai = g >> 2, m = g & 3; const int row = row0 + ai * HALF + m * 16; const size_t off = (size_t)row * ldc + col0;
            f32x4 v[2][2];
#pragma unroll
            for (int bj = 0; bj < 2; ++bj)
#pragma unroll
                for (int n = 0; n < 2; ++n) v[bj][n] = vn[bj][n];
            if (g < 7) ERB_LOAD(g + 1);
            asm volatile("" ::: "memory");
            float ss = 0.f;
#pragma unroll
            for (int bj = 0; bj < 2; ++bj) { const f32x4 o0 = acc[ai][bj][m][0] + v[bj][0], o1 = acc[ai][bj][m][1] + v[bj][1];
                u32x4 w; w.x = cvt_pk_bf16(o0[0], o0[1]); w.y = cvt_pk_bf16(o0[2], o0[3]); w.z = cvt_pk_bf16(o1[0], o1[1]); w.w = cvt_pk_bf16(o1[2], o1[3]);
                *(u32x4*)(xb + off + bj * HALF) = w;
                ss += ((o0[0] * o0[0] + o0[1] * o0[1]) + (o0[2] * o0[2] + o0[3] * o0[3])) + ((o1[0] * o1[0] + o1[1] * o1[1]) + (o1[2] * o1[2] + o1[3] * o1[3])); }
            ss += __shfl_xor(ss, 16); ss += __shfl_xor(ss, 32);
            if (fq == 0) ssq[(size_t)row * 32 + u.pn * 4 + wc] = ss;
        }
#undef ERB_LOAD
    }
};

template <class Epi>
__device__ __forceinline__ void gemm_phase(LAS unsigned char* lds, const Gemm g, const StaticOrder& S, const Epi& E) {
    const int tid = threadIdx.x, wid = __builtin_amdgcn_readfirstlane(tid >> 6), lane = tid & 63, wr = wid >> 2, wc = wid & 3, fr = lane & 15, fq = lane >> 4;
    const int K = g.K, nt = K / BK;
    unsigned voffA[2], voffB[2];
#pragma unroll
    for (int i = 0; i < 2; ++i) { int R, C; stage_rc(tid * 16 + i * 8192, R, C); const int Rb = Epi::PERM ? ((R & ~31) + perm32(R & 31)) : R;
        voffA[i] = (unsigned)(R * g.lda + C) * 2u; voffB[i] = (unsigned)(Rb * g.ldb + C) * 2u; }
    const size_t kstep = (size_t)(BK * 2);
    const size_t hA = (size_t)HALF * g.lda * 2, hB = (size_t)HALF * g.ldb * 2;
    const size_t tA = 2 * hA, tB = 2 * hB;
    const unsigned ldsw = (unsigned)wid * 1024u;
    const int aoff = lds_byte(wr * 64 + fr, fq * 8), boff = lds_byte(wc * 32 + fr, fq * 8);
#define PG8_SA(b, h) (((b) * 2 + (h)) * HTB)
#define PG8_SB(b, h) ((4 + (b) * 2 + (h)) * HTB)
#define PG8_STAGE(bufoff, gbase, voff) do { _Pragma("unroll") for (int _i = 0; _i < 2; ++_i) \
        __builtin_amdgcn_global_load_lds((const unsigned*)((const char*)(gbase) + (voff)[_i]), (LAS unsigned*)(lds + (bufoff) + ldsw + _i * 8192), 16, 0, 0); } while (0)
#define PG8_LDA(dst, b, h) do { _Pragma("unroll") for (int m = 0; m < 4; ++m) _Pragma("unroll") for (int k = 0; k < 2; ++k) dst[m][k] = *(const LAS bf16x8*)(lds + PG8_SA(b, h) + aoff + m * 2048 + k * 1024); } while (0)
#define PG8_LDB(dst, b, h) do { _Pragma("unroll") for (int n = 0; n < 2; ++n) _Pragma("unroll") for (int k = 0; k < 2; ++k) dst[n][k] = *(const LAS bf16x8*)(lds + PG8_SB(b, h) + boff + n * 2048 + k * 1024); } while (0)
#define PG8_MMA(ai, bj, At, Bt) do { __builtin_amdgcn_s_setprio(1); _Pragma("unroll") for (int m = 0; m < 4; ++m) _Pragma("unroll") for (int n = 0; n < 2; ++n) _Pragma("unroll") for (int k = 0; k < 2; ++k) \
        acc[ai][bj][m][n] = __builtin_amdgcn_mfma_f32_16x16x32_bf16(Bt[n][k], At[m][k], acc[ai][bj][m][n], 0, 0, 0); __builtin_amdgcn_s_setprio(0); } while (0)
#define PG8_WAIT_V(n) asm volatile("s_waitcnt vmcnt(" #n ")" ::: "memory")
#define PG8_WAIT_L(n) asm volatile("s_waitcnt lgkmcnt(" #n ")" ::: "memory")
#define PG8_BAR __builtin_amdgcn_s_barrier()
#define PG8_SCHED __builtin_amdgcn_sched_barrier(0)
    Unit cur, nxt; int ui = 0;
    if (!S.next(0, cur)) return;
    f32x4 acc[2][2][4][2];
#pragma unroll
    for (int a = 0; a < 2; ++a)
#pragma unroll
        for (int b = 0; b < 2; ++b)
#pragma unroll
            for (int m = 0; m < 4; ++m)
#pragma unroll
                for (int n = 0; n < 2; ++n) acc[a][b][m][n] = (f32x4){0.f, 0.f, 0.f, 0.f};
    bf16x8 At[4][2], B0[2][2], B1[2][2];
    LAS float* rsl = (LAS float*)(lds + 131072) + wr * 128 + fr;
#define PG8_RS_PUT(buf_, rs_) do { if (fq == 0) { rsl[(buf_) * 256 + wc * 16] = rs_[0]; rsl[(buf_) * 256 + 64 + wc * 16] = rs_[1]; } } while (0)
#define PG8_RS_GET(buf_, ai_, rs_) do { _Pragma("unroll") for (int m_ = 0; m_ < 4; ++m_) rs_[m_] = rsl[(buf_) * 256 + (ai_) * 64 + m_ * 16]; } while (0)
    if constexpr (Epi::HAS_PRE) { f32x4 raw0[2][2]; float r0[2]; E.pre_issue(cur, wr, wc, fr, fq, raw0); E.pre_finish(raw0, r0); PG8_RS_PUT(0, r0); }
    const char* cA = (const char*)g.A + (size_t)cur.pm * tA; const char* cB = (const char*)g.Bt + (size_t)cur.pn * tB;
    PG8_STAGE(PG8_SB(0, 0), cB, voffB); PG8_STAGE(PG8_SB(0, 1), cB + hB, voffB); PG8_STAGE(PG8_SA(0, 0), cA, voffA); PG8_STAGE(PG8_SA(0, 1), cA + hA, voffA);
    if (wr == 1) PG8_BAR;
    PG8_WAIT_V(2); PG8_BAR;
    PG8_STAGE(PG8_SB(1, 0), cB + kstep, voffB); PG8_STAGE(PG8_SA(1, 0), cA + kstep, voffA); PG8_STAGE(PG8_SB(1, 1), cB + hB + kstep, voffB);
    PG8_WAIT_V(6); PG8_BAR;
    for (;;) {
        const bool has_next = S.next(ui + 1, nxt);
        const char* nA = has_next ? (const char*)g.A + (size_t)nxt.pm * tA : cA; const char* nB = has_next ? (const char*)g.Bt + (size_t)nxt.pn * tB : cB;
        for (int t = 0; t < nt; t += 2) {
            const bool last = (t == nt - 2);
            const char* a1 = cA + (size_t)(t + 1) * kstep;
            const char* a2 = last ? nA : cA + (size_t)(t + 2) * kstep; const char* b2 = last ? nB : cB + (size_t)(t + 2) * kstep;
            const char* a3 = a2 + kstep; const char* b3 = b2 + kstep;
            PG8_LDB(B0, 0, 0); PG8_LDB(B1, 0, 1); PG8_SCHED; PG8_LDA(At, 0, 0); PG8_STAGE(PG8_SA(1, 1), a1 + hA, voffA);
            PG8_WAIT_V(8); PG8_WAIT_L(0); PG8_BAR; PG8_MMA(0, 0, At, B0); PG8_MMA(0, 1, At, B1); PG8_BAR; PG8_SCHED;
            PG8_LDA(At, 0, 1); PG8_STAGE(PG8_SB(0, 0), b2, voffB); PG8_STAGE(PG8_SB(0, 1), b2 + hB, voffB); PG8_STAGE(PG8_SA(0, 0), a2, voffA);
            PG8_WAIT_V(8); PG8_WAIT_L(0); PG8_BAR; PG8_MMA(1, 0, At, B0); PG8_MMA(1, 1, At, B1); PG8_BAR; PG8_SCHED;
            PG8_LDB(B0, 1, 0); PG8_LDB(B1, 1, 1); PG8_SCHED; PG8_LDA(At, 1, 0); PG8_STAGE(PG8_SA(0, 1), a2 + hA, voffA);
            PG8_WAIT_V(8); PG8_WAIT_L(0); PG8_BAR; PG8_MMA(0, 0, At, B0); PG8_MMA(0, 1, At, B1); PG8_BAR; PG8_SCHED;
            PG8_LDA(At, 1, 1); PG8_STAGE(PG8_SB(1, 0), b3, voffB); PG8_STAGE(PG8_SB(1, 1), b3 + hB, voffB); PG8_STAGE(PG8_SA(1, 0), a3, voffA);
            PG8_WAIT_V(8); PG8_WAIT_L(0); PG8_BAR; PG8_MMA(1, 0, At, B0); PG8_MMA(1, 1, At, B1); PG8_BAR; PG8_SCHED;
        }
        if (wr == 0) PG8_BAR;
        if constexpr (Epi::HAS_PRE) { f32x4 raw[2][2]; float rc[4], rn[2]; const int buf = ui & 1;
            if (has_next) E.pre_issue(nxt, wr, wc, fr, fq, raw);
            PG8_RS_GET(buf, 0, rc); PG8_SCHED; E.half(acc, cur, 0, wr, wc, fr, fq, rc); PG8_SCHED;
            PG8_RS_GET(buf, 1, rc); PG8_SCHED; E.half(acc, cur, 1, wr, wc, fr, fq, rc); PG8_SCHED;
            if (has_next) { E.pre_finish(raw, rn); PG8_RS_PUT(buf ^ 1, rn); } }
        else E(acc, cur, wr, wc, fr, fq);
        if (!has_next) break;
#pragma unroll
        for (int a = 0; a < 2; ++a)
#pragma unroll
            for (int b = 0; b < 2; ++b)
#pragma unroll
                for (int m = 0; m < 4; ++m)
#pragma unroll
                    for (int n = 0; n < 2; ++n) acc[a][b][m][n] = (f32x4){0.f, 0.f, 0.f, 0.f};
        cur = nxt; cA = nA; cB = nB; ++ui;
        if (wr == 1) PG8_BAR;
    }
    PG8_WAIT_V(0);
    PG8_BAR;
#undef PG8_SA
#undef PG8_SB
#undef PG8_STAGE
#undef PG8_LDA
#undef PG8_LDB
#undef PG8_MMA
#undef PG8_WAIT_V
#undef PG8_WAIT_L
#undef PG8_BAR
#undef PG8_SCHED
#undef PG8_RS_PUT
#undef PG8_RS_GET
}
}

#define XB_TMO      128
#define XB_XCNT(j)  (256  + 64 * (j))
#define XB_XSUB(j)  (1280 + 64 * (j))
#define XB_XGEN(j)  (2304 + 64 * (j))
#define XB_TOP      3328
#define XB_TOPGEN   3392
#define XCD_BAR_WORDS 3456
#define XB_SPIN_CAP (1u << 18)

__device__ __forceinline__ unsigned xb_ld(unsigned* p)              { return __hip_atomic_load(p, __ATOMIC_RELAXED, __HIP_MEMORY_SCOPE_AGENT); }
__device__ __forceinline__ unsigned xb_add(unsigned* p, unsigned v) { return __hip_atomic_fetch_add(p, v, __ATOMIC_RELAXED, __HIP_MEMORY_SCOPE_AGENT); }
__device__ __forceinline__ unsigned xb_xcc_id() { return (unsigned)__builtin_amdgcn_s_getreg((3 << 11) | 20) & 0xFu; }
#define XB_SPIN(cond, bar) do { unsigned _sp = 0; while (cond) { __builtin_amdgcn_s_sleep(1); \
    if ((++_sp & 255u) == 0u) { if (xb_ld(&(bar)[XB_TMO])) break; if (_sp > XB_SPIN_CAP) { atomicAdd(&(bar)[XB_TMO], 1u); break; } } } } while (0)

struct XcdBarrier { unsigned* bar; unsigned x; volatile LAS unsigned* st; };

__device__ __forceinline__ XcdBarrier xcd_barrier_post(unsigned* bar, volatile LAS unsigned* st) {
    XcdBarrier b; b.bar = bar; b.x = xb_xcc_id(); b.st = st;
    if (threadIdx.x == 0) (void)xb_add(&bar[XB_XCNT(b.x)], 1u);
    return b;
}
__device__ __forceinline__ void xcd_barrier_complete(unsigned* bar, unsigned x, unsigned& nloc, unsigned& nx) {
    const unsigned G = gridDim.x * gridDim.y * gridDim.z;
    unsigned sum, cnt, mine, sp = 0u;
    for (;;) {
        sum = 0u; cnt = 0u; mine = 0u;
#pragma unroll
        for (unsigned j = 0; j < 16; ++j) { const unsigned c = xb_ld(&bar[XB_XCNT(j)]); sum += c; cnt += (c > 0u) ? 1u : 0u; mine = (j == x) ? c : mine; }
        if (sum == G) break;
        __builtin_amdgcn_s_sleep(1);
        if ((++sp & 255u) == 0u) { if (xb_ld(&bar[XB_TMO])) break; if (sp > XB_SPIN_CAP) { atomicAdd(&bar[XB_TMO], 1u); break; } }
    }
    nloc = mine > 0u ? mine : 1u; nx = cnt > 0u ? cnt : 1u;
}
__device__ __forceinline__ void xcd_barrier(const XcdBarrier& b) {
    asm volatile("s_waitcnt vmcnt(0)" ::: "memory");
    __syncthreads();
    if (threadIdx.x == 0) {
        unsigned* bar = b.bar;
        __builtin_amdgcn_s_waitcnt(0);
        unsigned nloc = b.st[0], nx = b.st[1];
        if (nloc == 0u) { xcd_barrier_complete(bar, b.x, nloc, nx); b.st[0] = nloc; b.st[1] = nx; }
        const unsigned old = xb_add(&bar[XB_XSUB(b.x)], 1u);
        const unsigned gen = old / nloc;
        if (old + 1u == (gen + 1u) * nloc) {
            __builtin_amdgcn_fence(__ATOMIC_RELEASE, "agent");
            asm volatile("s_waitcnt vmcnt(0)" ::: "memory");
            const unsigned og = xb_add(&bar[XB_TOP], 1u);
            const unsigned tg = og / nx;
            if (og + 1u == (tg + 1u) * nx) xb_add(&bar[XB_TOPGEN], 1u);
            else XB_SPIN(xb_ld(&bar[XB_TOPGEN]) == tg, bar);
            __builtin_amdgcn_fence(__ATOMIC_ACQUIRE, "agent");
            xb_add(&bar[XB_XGEN(b.x)], 1u);
            asm volatile("s_waitcnt vmcnt(0)" ::: "memory");
        } else {
            XB_SPIN(xb_ld(&bar[XB_XGEN(b.x)]) == gen, bar);
            __builtin_amdgcn_fence(__ATOMIC_ACQUIRE, "agent");
            asm volatile("s_waitcnt vmcnt(0)" ::: "memory");
        }
    }
    __syncthreads();
}

struct Args { const float* in[14]; float* out; unsigned char* ws; int ph_lo, ph_hi; };
struct Frame {
    LAS unsigned char* lds;
    int tid, lane, wave, vcu, G;
    unsigned char* ws;
};

__device__ __forceinline__ int rope_colmap(int kind, int n) {
    if (kind == 1) { if (n < 2048 || (n >= 3072 && n < 5120)) { const int o = n & 127; return n - o + 2 * (o & 63) + (o >> 6); } return n; }
    if (kind == 2) {
        if (n >= 832 && n < 2880) { const int o = (n - 832) & 127; return n - o + 2 * (o & 63) + (o >> 6); }
        if ((n >= 768 && n < 832) || (n >= 3904 && n < 4992)) { const int o = n & 63; return n - o + 2 * (o & 31) + (o >> 5); }
        return n; }
    if (kind == 3) { const int o = n % 192; if (o >= 128) { const int p = o - 128; return n - p + 2 * (p & 31) + (p >> 5); } return n; }
    return n;
}
__device__ __forceinline__ void tr_load(const float* W, int K, int N, int item, int lane, const float* gain, float (&v)[32], f32x4& g0, f32x4& g1) {
    const int nblk = (N + 31) / 32, kb = item / nblk, nb = item % nblk, k0 = 64 * kb, n0 = 32 * nb;
    const int nn = n0 + (lane & 31);
    const float* wp = W + (size_t)(k0 + (lane >> 5)) * N + (nn < N ? nn : N - 1);
#pragma unroll
    for (int i = 0; i < 32; ++i) v[i] = __builtin_nontemporal_load(wp + (size_t)(2 * i) * N);
    if (gain) { const f32x4* gp = (const f32x4*)(gain + k0 + 8 * (lane & 7)); g0 = gp[0]; g1 = gp[1]; }
    else { g0 = (f32x4){1.f, 1.f, 1.f, 1.f}; g1 = g0; }
}
__device__ __forceinline__ void tr_store(int K, int N, bf16* WT, LAS float* scr, int item, int lane, const float (&v)[32], const f32x4 g0, const f32x4 g1, int permkind) {
    const int nblk = (N + 31) / 32, kb = item / nblk, nb = item % nblk, k0 = 64 * kb, n0 = 32 * nb;
    const int nn = n0 + (lane & 31);
#pragma unroll
    for (int i = 0; i < 32; ++i) { const int kk = 2 * i + (lane >> 5); scr[kk * 33 + (lane & 31)] = (nn < N) ? v[i] : 0.f; }
    LDS_WAIT(); asm volatile("" ::: "memory");
    const int c = lane & 7;
#pragma unroll
    for (int j = 0; j < 4; ++j) { const int n = (lane >> 3) + 8 * j; const LAS float* s = scr + (8 * c) * 33 + n;
        u32x4 o; o.x = cvt_pk_bf16(s[0 * 33] * g0.x, s[1 * 33] * g0.y); o.y = cvt_pk_bf16(s[2 * 33] * g0.z, s[3 * 33] * g0.w);
        o.z = cvt_pk_bf16(s[4 * 33] * g1.x, s[5 * 33] * g1.y); o.w = cvt_pk_bf16(s[6 * 33] * g1.z, s[7 * 33] * g1.w);
        *(u32x4*)(WT + (size_t)rope_colmap(permkind, n0 + n) * K + k0 + 8 * c) = o; }
    LDS_WAIT(); asm volatile("" ::: "memory");
}
__device__ __forceinline__ void convert_weight(Frame& F, const float* W, int K, int N, bf16* WT, const float* gain = nullptr, int permkind = 0, int* rot = nullptr) {
    LAS float* scr = (LAS float*)(F.lds + F.wave * 16384);
    const int NGW = F.G * NWAVES; int gw = F.vcu * NWAVES + F.wave;
    const int nitems = (K / 64) * ((N + 31) / 32);
    if (rot) { gw -= *rot; if (gw < 0) gw += NGW; *rot = (*rot + nitems) % NGW; }
    float v[32]; f32x4 g0, g1;
    int it = gw;
    if (it < nitems) tr_load(W, K, N, it, F.lane, gain, v, g0, g1);
    for (; it < nitems; it += NGW) {
        float vn[32]; f32x4 gn0 = g0, gn1 = g1; const int itn = it + NGW;
        if (itn < nitems) tr_load(W, K, N, itn, F.lane, gain, vn, gn0, gn1);
        else {
#pragma unroll
            for (int i = 0; i < 32; ++i) vn[i] = 0.f; }
        tr_store(K, N, WT, scr, it, F.lane, v, g0, g1, permkind);
#pragma unroll
        for (int i = 0; i < 32; ++i) v[i] = vn[i];
        g0 = gn0; g1 = gn1;
    }
}
__device__ __forceinline__ void convert_weight_queue(Frame& F, const float* W, int K, int N, bf16* WT, unsigned* ctr) {
    LAS float* scr = (LAS float*)(F.lds + F.wave * 16384);
    const unsigned nitems = (unsigned)((K / 64) * ((N + 31) / 32));
    for (;;) { unsigned c = 0u; if (F.lane == 0) c = __hip_atomic_fetch_add(ctr, 4u, __ATOMIC_RELAXED, __HIP_MEMORY_SCOPE_AGENT);
        c = (unsigned)__builtin_amdgcn_readfirstlane(c);
        if (c >= nitems) break;
        float v[32]; f32x4 g0, g1;
        tr_load(W, K, N, (int)c, F.lane, nullptr, v, g0, g1);
#pragma unroll 1
        for (int q = 0; q < 4; ++q) { float vn[32]; f32x4 gn0 = g0, gn1 = g1;
            if (q < 3) tr_load(W, K, N, (int)c + q + 1, F.lane, nullptr, vn, gn0, gn1);
            else {
#pragma unroll
                for (int i = 0; i < 32; ++i) vn[i] = 0.f; }
            tr_store(K, N, WT, scr, (int)c + q, F.lane, v, g0, g1, 0);
#pragma unroll
            for (int i = 0; i < 32; ++i) v[i] = vn[i];
            g0 = gn0; g1 = gn1; } }
}
__device__ __forceinline__ void rms_row_to_bf16(const float* xrow, const float* g, bf16* orow, int lane) {
    const f32x4* xr = (const f32x4*)xrow + lane; const f32x4* gr = (const f32x4*)g + lane;
    f32x4 v[8]; float s = 0.f;
#pragma unroll
    for (int j = 0; j < 8; ++j) { v[j] = __builtin_nontemporal_load(xr + 64 * j); s += (v[j].x * v[j].x + v[j].y * v[j].y) + (v[j].z * v[j].z + v[j].w * v[j].w); }
    const float rs = 1.0f / sqrtf(wave_sum(s) * (1.f / DM) + NORM_EPS);
    u32x2* o8 = (u32x2*)orow + lane;
#pragma unroll
    for (int j = 0; j < 8; ++j) { const f32x4 gg = gr[64 * j]; u32x2 w; w.x = cvt_pk_bf16(v[j].x * rs * gg.x, v[j].y * rs * gg.y); w.y = cvt_pk_bf16(v[j].z * rs * gg.z, v[j].w * rs * gg.w); o8[64 * j] = w; }
}
__device__ __forceinline__ void rms_rows(Frame& F, const float* X, const float* g, bf16* H) {
    const int gw = F.vcu * NWAVES + F.wave, NGW = F.G * NWAVES;
    for (int m = gw; m < T; m += NGW) rms_row_to_bf16(X + (size_t)m * DM, g, H + (size_t)m * DM, F.lane);
}
__device__ __forceinline__ void rms_rows_final(Frame& F, const bf16* XB, const float* ssq, float* out, const float* g, float oscale = 1.f) {
    const int gw = F.vcu * NWAVES + F.wave, NGW = F.G * NWAVES;
    const f32x4* gr = (const f32x4*)g;
    for (int m = gw; m < T; m += 2 * NGW) {
        const int m1 = m + NGW; const bool two = m1 < T; const int mb = two ? m1 : m;
        const float sva = (F.lane < 32) ? ssq[(size_t)m * 32 + F.lane] : 0.f;
        const float svb = (F.lane < 32) ? ssq[(size_t)mb * 32 + F.lane] : 0.f;
        const u32x4* xa = (const u32x4*)(XB + (size_t)m * DM) + F.lane; const u32x4* xb = (const u32x4*)(XB + (size_t)mb * DM) + F.lane;
        u32x4 wa[4], wb[4];
#pragma unroll
        for (int j = 0; j < 4; ++j) { wa[j] = __builtin_nontemporal_load(xa + 64 * j); wb[j] = __builtin_nontemporal_load(xb + 64 * j); }
        const float rsa = (1.0f / sqrtf(wave_sum(sva) * (1.f / DM) + NORM_EPS)) * oscale;
        const float rsb = (1.0f / sqrtf(wave_sum(svb) * (1.f / DM) + NORM_EPS)) * oscale;
        f32x4* oa = (f32x4*)(out + (size_t)m * DM); f32x4* ob = (f32x4*)(out + (size_t)mb * DM);
#pragma unroll
        for (int j = 0; j < 4; ++j) { const int c4 = (F.lane + 64 * j) * 2;
            const f32x4 g0 = gr[c4], g1 = gr[c4 + 1];
            { const u32x4 w = wa[j];
              const f32x4 a = {__uint_as_float(w.x << 16), __uint_as_float(w.x & 0xffff0000u), __uint_as_float(w.y << 16), __uint_as_float(w.y & 0xffff0000u)};
              const f32x4 b = {__uint_as_float(w.z << 16), __uint_as_float(w.z & 0xffff0000u), __uint_as_float(w.w << 16), __uint_as_float(w.w & 0xffff0000u)};
              oa[c4] = a * rsa * g0; oa[c4 + 1] = b * rsa * g1; }
            if (two) { const u32x4 w = wb[j];
              const f32x4 a = {__uint_as_float(w.x << 16), __uint_as_float(w.x & 0xffff0000u), __uint_as_float(w.y << 16), __uint_as_float(w.y & 0xffff0000u)};
              const f32x4 b = {__uint_as_float(w.z << 16), __uint_as_float(w.z & 0xffff0000u), __uint_as_float(w.w << 16), __uint_as_float(w.w & 0xffff0000u)};
              ob[c4] = a * rsb * g0; ob[c4 + 1] = b * rsb * g1; } }
    }
}
__device__ __forceinline__ void rope_tables(Frame& F) {
    float* c128 = (float*)(F.ws + WS_COS128); float* s128 = (float*)(F.ws + WS_SIN128);
    float* c64 = (float*)(F.ws + WS_COS64); float* s64 = (float*)(F.ws + WS_SIN64);
    const int gt = F.vcu * 512 + F.tid, NT_ = F.G * 512;
    for (int e = gt; e < SEQ * 64 + SEQ * 32; e += NT_) {
        int pos, i, dim; float* cp; float* sp;
        if (e < SEQ * 64) { pos = e >> 6; i = e & 63; dim = 128; cp = c128 + e; sp = s128 + e; }
        else { const int e2 = e - SEQ * 64; pos = e2 >> 5; i = e2 & 31; dim = 64; cp = c64 + e2; sp = s64 + e2; }
        const float ex = (float)(2 * i) / (float)dim;
        const float inv = (float)exp(-(double)ex * 9.210340371976184);
        const float ang = (float)pos * inv;
        const double rev = (double)ang * 0.15915494309189535;
        const double fr = rev - rint(rev);
        const float a = (float)(fr * 6.283185307179586);
        *cp = __cosf(a); *sp = __sinf(a);
    }
}

namespace att {
constexpr int SHM_V = 64 * 128 * 2, SHM_K = 64 * 128 * 2, SHM_PE = 64 * 64 * 2;
constexpr int OFF_V = 0, OFF_K = 2 * SHM_V, OFF_PE = OFF_K + 2 * SHM_K, OFF_WS = OFF_PE + 2 * SHM_PE;
constexpr int OFF_TL = OFF_WS + 2048;
constexpr int OFF_KM = 90112;
constexpr int OFF_LB = OFF_TL + 1024;
constexpr int OFF_QPE = 98304;
enum { MODE_MLA = 0, MODE_DSA = 1, MODE_MOWN = 2, MODE_DIL = 3, MODE_MSEL = 4 };
constexpr float THR = 8.f;

#define KSWZ(row, colB) ((row) * 256 + ((colB) ^ (((row) & 7) << 4)))
#define SBAR() __builtin_amdgcn_sched_barrier(0)
__device__ __forceinline__ int v_st(int k, int c) { const int kk = (k & ~0xC) | ((k & 4) << 1) | ((k & 8) >> 1); return ((kk >> 3) * 4 + (c >> 5)) * 512 + ((kk & 7) * 32 + (c & 31)) * 2; }
__device__ __forceinline__ int v_rd_base(int lane) { return ((lane & 3) << 3) | (((lane >> 2) & 3) << 6) | (((lane >> 4) & 1) << 5) | (((lane >> 5) & 1) << 8); }
constexpr int v_rd_off(int d0, int ks, int half) { return d0 * 512 + ks * 4096 + half * 2048; }
__device__ __forceinline__ int crow(int r, int hi) { return (r & 3) + 8 * (r >> 2) + 4 * hi; }
__device__ __forceinline__ bf16x8 pack8(f32x4 a, f32x4 b) {
    u32x4 w = {cvt_pk_bf16(a[0], a[1]), cvt_pk_bf16(a[2], a[3]), cvt_pk_bf16(b[0], b[1]), cvt_pk_bf16(b[2], b[3])};
    return *reinterpret_cast<bf16x8*>(&w);
}
__device__ __forceinline__ void rope_pair(bf16x8& a, bf16x8& b, const float* cs, const float* sn, float scale = 1.0f) {
    const f32x4 c0 = *(const f32x4*)cs * scale, c1 = *(const f32x4*)(cs + 4) * scale, s0 = *(const f32x4*)sn * scale, s1 = *(const f32x4*)(sn + 4) * scale;
    f32x4 y1a, y1b, y2a, y2b;
#pragma unroll
    for (int j = 0; j < 4; ++j) {
        const float x1 = bf2f((unsigned short)a[j]), x2 = bf2f((unsigned short)b[j]);
        y1a[j] = x1 * c0[j] - x2 * s0[j]; y2a[j] = x1 * s0[j] + x2 * c0[j];
        const float z1 = bf2f((unsigned short)a[4 + j]), z2 = bf2f((unsigned short)b[4 + j]);
        y1b[j] = z1 * c1[j] - z2 * s1[j]; y2b[j] = z1 * s1[j] + z2 * c1[j];
    }
    a = pack8(y1a, y1b); b = pack8(y2a, y2b);
}
__device__ __forceinline__ void mask_tile(f32x16& p0, f32x16& p1, int dq, unsigned W) {
    const float NEG = -__builtin_inff();
#pragma unroll
    for (int r = 0; r < 16; ++r) {
        const int c = (r & 3) + 8 * (r >> 2);
        if ((unsigned)(dq - c) >= W) p0[r] = NEG;
        if ((unsigned)(dq - c - 32) >= W) p1[r] = NEG;
    }
}
__device__ __forceinline__ void mask_bits(f32x16& p0, f32x16& p1, unsigned w0s, unsigned w1s) {
    const float NEG = -__builtin_inff();
#pragma unroll
    for (int r = 0; r < 16; ++r) {
        const int c = (r & 3) + 8 * (r >> 2);
        if (!((w0s >> c) & 1u)) p0[r] = NEG;
        if (!((w1s >> c) & 1u)) p1[r] = NEG;
    }
}
template <int MODE>
__device__ __forceinline__ void partialSM(f32x16& p0, f32x16& p1, float& m_reg, float& mn, float& alpha) {
    constexpr float SCALE = (MODE == MODE_MLA) ? 0.07216878364870322f : 0.08838834764831845f;
    float pmax = p0[0];
#pragma unroll
    for (int r = 1; r < 16; ++r) pmax = fmaxf(pmax, p0[r]);
#pragma unroll
    for (int r = 0; r < 16; ++r) pmax = fmaxf(pmax, p1[r]);
    { auto rr = __builtin_amdgcn_permlane32_swap(__float_as_uint(pmax), __float_as_uint(pmax), false, false);
      pmax = fmaxf(__uint_as_float(rr[0]), __uint_as_float(rr[1])); }
    constexpr float C2 = 1.4426950408889634f * SCALE;
    if (__builtin_expect(__all((pmax - m_reg) * SCALE <= THR), 1)) { mn = m_reg; alpha = 1.f; }
    else { mn = fmaxf(m_reg, pmax); alpha = __builtin_amdgcn_exp2f((m_reg - mn) * C2); m_reg = mn; }
    const float mnL = -mn * C2;
#pragma unroll
    for (int r = 0; r < 16; ++r) p0[r] = fmaf(p0[r], C2, mnL);
#pragma unroll
    for (int r = 0; r < 16; ++r) p1[r] = fmaf(p1[r], C2, mnL);
#pragma unroll
    for (int r = 0; r < 16; ++r) p0[r] = __builtin_amdgcn_exp2f(p0[r]);
}
template <bool BITS>
__device__ __forceinline__ void finishSM(f32x16& p0, f32x16& p1, float alpha, float& l_reg, bf16x8& pa0, bf16x8& pa1, bf16x8& pa2, bf16x8& pa3, unsigned w0s, unsigned w1s) {
#pragma unroll
    for (int r = 0; r < 16; ++r) p1[r] = __builtin_amdgcn_exp2f(p1[r]);
    if constexpr (BITS) {
#pragma unroll
        for (int r = 0; r < 16; ++r) { const int c = (r & 3) + 8 * (r >> 2);
            p0[r] = __uint_as_float(__float_as_uint(p0[r]) & (unsigned)__builtin_amdgcn_sbfe((int)w0s, c, 1));
            p1[r] = __uint_as_float(__float_as_uint(p1[r]) & (unsigned)__builtin_amdgcn_sbfe((int)w1s, c, 1)); } }
    float ps = 0;
#pragma unroll
    for (int r = 0; r < 16; ++r) ps += p0[r];
#pragma unroll
    for (int r = 0; r < 16; ++r) ps += p1[r];
    { auto rr = __builtin_amdgcn_permlane32_swap(__float_as_uint(ps), __float_as_uint(ps), false, false);
      ps = __uint_as_float(rr[0]) + __uint_as_float(rr[1]); }
    l_reg = l_reg * alpha + ps;
#define PK4(P, B_, OUT) do { unsigned a0 = cvt_pk_bf16(P[B_+0], P[B_+1]), a1 = cvt_pk_bf16(P[B_+2], P[B_+3]);                          \
        unsigned b0 = cvt_pk_bf16(P[B_+4], P[B_+5]), b1 = cvt_pk_bf16(P[B_+6], P[B_+7]);                                             \
        auto r0 = __builtin_amdgcn_permlane32_swap(a0, b0, false, false); auto r1 = __builtin_amdgcn_permlane32_swap(a1, b1, false, false); \
        u32x4 w = {r0[0], r1[0], r0[1], r1[1]}; OUT = *reinterpret_cast<bf16x8*>(&w); } while (0)
    PK4(p0, 0, pa0); PK4(p0, 8, pa1); PK4(p1, 0, pa2); PK4(p1, 8, pa3);
#undef PK4
}
template <int KB>
__device__ __forceinline__ void qkt(f32x16& p0, f32x16& p1, LAS const char* K_lds, int r32, int hi, const bf16x8* qr) {
    p0 = f32x16{}; p1 = f32x16{};
    int kb[4];
#pragma unroll
    for (int dd = 0; dd < 4; ++dd) kb[dd] = (int)(unsigned)(uintptr_t)K_lds + KSWZ(r32, (dd * 16 + hi * 8) * 2);
#define KRD(dst, av, off) asm volatile("ds_read_b128 %0, %1 offset:%2" : "=&v"(dst) : "v"(av), "n"(off) : "memory")
#define QKT_LD(X0, X1, d0_) do { KRD(X0, kb[(d0_) & 3], KB * SHM_K + ((d0_) >> 2) * 128); KRD(X1, kb[(d0_) & 3], KB * SHM_K + ((d0_) >> 2) * 128 + 32 * 256); } while (0)
#define QKT_W(n_) do { asm volatile("s_waitcnt lgkmcnt(" #n_ ")" ::: "memory"); SBAR(); } while (0)
#define QKT_MM(X0, X1, d0_) do { p0 = __builtin_amdgcn_mfma_f32_32x32x16_bf16(X0, qr[d0_], p0, 0, 0, 0); p1 = __builtin_amdgcn_mfma_f32_32x32x16_bf16(X1, qr[d0_], p1, 0, 0, 0); SBAR(); } while (0)
    bf16x8 a0, a1, b0, b1, c0, c1;
    QKT_LD(a0, a1, 0); QKT_LD(b0, b1, 1);
    QKT_LD(c0, c1, 2); QKT_W(4); QKT_MM(a0, a1, 0);
    QKT_LD(a0, a1, 3); QKT_W(4); QKT_MM(b0, b1, 1);
    QKT_LD(b0, b1, 4); QKT_W(4); QKT_MM(c0, c1, 2);
    QKT_LD(c0, c1, 5); QKT_W(4); QKT_MM(a0, a1, 3);
    QKT_LD(a0, a1, 6); QKT_W(4); QKT_MM(b0, b1, 4);
    QKT_LD(b0, b1, 7); QKT_W(4); QKT_MM(c0, c1, 5);
    QKT_W(2); QKT_MM(a0, a1, 6);
    QKT_W(0); QKT_MM(b0, b1, 7);
#undef QKT_LD
#undef QKT_MM
#undef QKT_W
#undef KRD
}
template <int KB>
__device__ __forceinline__ void qkt_pe(f32x16& p0, f32x16& p1, LAS const char* PE_lds, int r32, int hi, const bf16x8* qr  ) {
#pragma unroll
    for (int dd = 0; dd < 4; ++dd) { LAS const char* a = PE_lds + KB * SHM_PE + r32 * 128 + ((dd * 32 + hi * 16) ^ ((r32 & 7) << 4));
        bf16x8 b0 = *reinterpret_cast<LAS const bf16x8*>(a);
        bf16x8 b1 = *reinterpret_cast<LAS const bf16x8*>(a + 32 * 128);
        p0 = __builtin_amdgcn_mfma_f32_32x32x16_bf16(b0, qr[dd], p0, 0, 0, 0);
        p1 = __builtin_amdgcn_mfma_f32_32x32x16_bf16(b1, qr[dd], p1, 0, 0, 0); }
}
template <int KB>
__device__ __forceinline__ void qkt_pe_lq(f32x16& p0, f32x16& p1, LAS const char* PE_lds, int r32, int hi, LAS const char* qpe  ) {
#pragma unroll
    for (int dd = 0; dd < 4; ++dd) { LAS const char* a = PE_lds + KB * SHM_PE + r32 * 128 + ((dd * 32 + hi * 16) ^ ((r32 & 7) << 4));
        const bf16x8 q = *reinterpret_cast<LAS const bf16x8*>(qpe + dd * 1024);
        bf16x8 b0 = *reinterpret_cast<LAS const bf16x8*>(a);
        bf16x8 b1 = *reinterpret_cast<LAS const bf16x8*>(a + 32 * 128);
        p0 = __builtin_amdgcn_mfma_f32_32x32x16_bf16(b0, q, p0, 0, 0, 0);
        p1 = __builtin_amdgcn_mfma_f32_32x32x16_bf16(b1, q, p1, 0, 0, 0); }
}
template <int VB>
__device__ __forceinline__ void pv_tile(f32x16* o, int vb0, bf16x8 pa0, bf16x8 pa1, bf16x8 pa2, bf16x8 pa3) {
#define TRRD(dst, off) asm volatile("ds_read_b64_tr_b16 %0, %1 offset:%2" : "=&v"(dst) : "v"(vb0), "i"(off) : "memory")
#define PV_RD(S, d0) do { constexpr int b_ = VB * SHM_V + v_rd_off(d0, 0, 0); \
        TRRD(S[0], b_); TRRD(S[1], b_ + 2048); TRRD(S[2], b_ + 4096); TRRD(S[3], b_ + 6144); TRRD(S[4], b_ + 8192); TRRD(S[5], b_ + 10240); TRRD(S[6], b_ + 12288); TRRD(S[7], b_ + 14336); } while (0)
#define PV_MM(S, d0) do { \
        o[d0] = __builtin_amdgcn_mfma_f32_32x32x16_bf16(pa0, (bf16x8){S[0][0], S[0][1], S[0][2], S[0][3], S[1][0], S[1][1], S[1][2], S[1][3]}, o[d0], 0, 0, 0);   \
        o[d0] = __builtin_amdgcn_mfma_f32_32x32x16_bf16(pa1, (bf16x8){S[2][0], S[2][1], S[2][2], S[2][3], S[3][0], S[3][1], S[3][2], S[3][3]}, o[d0], 0, 0, 0);   \
        o[d0] = __builtin_amdgcn_mfma_f32_32x32x16_bf16(pa2, (bf16x8){S[4][0], S[4][1], S[4][2], S[4][3], S[5][0], S[5][1], S[5][2], S[5][3]}, o[d0], 0, 0, 0);   \
        o[d0] = __builtin_amdgcn_mfma_f32_32x32x16_bf16(pa3, (bf16x8){S[6][0], S[6][1], S[6][2], S[6][3], S[7][0], S[7][1], S[7][2], S[7][3]}, o[d0], 0, 0, 0); } while (0)
    s16x4 sa[8], sb[8];
    PV_RD(sa, 0);
    PV_RD(sb, 1); asm volatile("s_waitcnt lgkmcnt(8)" ::: "memory"); SBAR(); PV_MM(sa, 0); SBAR();
    PV_RD(sa, 2); asm volatile("s_waitcnt lgkmcnt(8)" ::: "memory"); SBAR(); PV_MM(sb, 1); SBAR();
    PV_RD(sb, 3); asm volatile("s_waitcnt lgkmcnt(8)" ::: "memory"); SBAR(); PV_MM(sa, 2); SBAR();
    asm volatile("s_waitcnt lgkmcnt(0)" ::: "memory"); SBAR(); PV_MM(sb, 3);
#undef PV_RD
#undef PV_MM
#undef TRRD
}

struct UnitArgs {
#ifdef DIAG_SEG
    unsigned long long* dacc;
#endif
    const bf16* Q; size_t qpitch;
    const bf16* K; size_t kpitch;
    const bf16* PE; size_t pepitch;
    const bf16* V; size_t vpitch;
    bf16* O; size_t opitch;
    float* LSE; int lse_stride;
    const float* cosT; const float* sinT;
    int pos0, posstride;
    int P0;
    const unsigned* BM;
    const float* KMP;
    int own;
    unsigned* SEL; int* CNT;
    size_t oslot, lslot;
};

__device__ __forceinline__ void attn_preload_msel(LAS char* lds, const UnitArgs& U) {
    int tid_ = threadIdx.x; asm volatile("" : "+v"(tid_));
    const int tid = tid_, wid = __builtin_amdgcn_readfirstlane(tid >> 6), lane = tid & 63;
    LAS char* V_lds = lds + OFF_V; LAS char* K_lds = lds + OFF_K;
    unsigned koff, voff;
    { const int row = 4 * wid + (lane >> 4), colB = ((lane & 15) * 16) ^ ((row & 7) << 4); koff = (unsigned)((row * U.kpitch) * 2 + colB); }
    { const int kk = (wid >> 1) * 8 + ((lane & 31) >> 2), k = (kk & ~0xC) | ((kk & 4) << 1) | ((kk & 8) >> 1), c = (2 * (wid & 1) + (lane >> 5)) * 32 + (lane & 3) * 8;
      voff = (unsigned)((k * U.vpitch + c) * 2); }
    const int kb = U.own * 256;
    const char* kt_ = (const char*)U.K + (size_t)kb * U.kpitch * 2; const char* vt_ = (const char*)U.V + (size_t)kb * U.vpitch * 2;
    __builtin_amdgcn_global_load_lds((const unsigned*)(kt_ + koff), (LAS unsigned*)(K_lds + wid * 1024), 16, 0, 0);
    __builtin_amdgcn_global_load_lds((const unsigned*)(kt_ + (size_t)64 * U.kpitch + koff), (LAS unsigned*)(K_lds + 8192 + wid * 1024), 16, 0, 0);
    __builtin_amdgcn_global_load_lds((const unsigned*)(vt_ + voff), (LAS unsigned*)(V_lds + wid * 1024), 16, 0, 0);
    __builtin_amdgcn_global_load_lds((const unsigned*)(vt_ + (size_t)64 * U.vpitch + voff), (LAS unsigned*)(V_lds + 8192 + wid * 1024), 16, 0, 0);
}
template <int MODE>
__device__ __forceinline__ void attn_unit(LAS char* lds, const UnitArgs& U) {
    constexpr bool MLA = MODE == MODE_MLA, DSA = MODE == MODE_DSA, MOWN = MODE == MODE_MOWN, MSEL = MODE == MODE_MSEL, DIL = MODE == MODE_DIL;
    constexpr float SCALE = MLA ? 0.07216878364870322f : 0.08838834764831845f;
    constexpr float C2 = 1.4426950408889634f * SCALE;
#ifdef DIAG_SEG
    unsigned long long dseg_t = __builtin_amdgcn_s_memrealtime();
#define DSEG(k_) do { const unsigned long long n_ = __builtin_amdgcn_s_memrealtime(); if (DIAG_SEG == (k_) && U.dacc) *U.dacc += n_ - dseg_t; dseg_t = n_; } while (0)
#else
#define DSEG(k_) do { } while (0)
#endif
    int tid_ = threadIdx.x; asm volatile("" : "+v"(tid_));
    const int tid = tid_, wid = __builtin_amdgcn_readfirstlane(tid >> 6), lane = tid & 63, r32 = lane & 31, hi = lane >> 5;
    LAS char* V_lds = lds + OFF_V; LAS char* K_lds = lds + OFF_K; LAS char* PE_lds = lds + OFF_PE;
    LAS float* wsf = (LAS float*)(lds + OFF_WS) + wid * 64; LAS float* li_l = wsf; LAS float* al_l = wsf + 32;
    LAS unsigned* rinfo = (LAS unsigned*)(lds + OFF_TL);
    const int qlo = U.P0 + wid * 32;
    int qrow = qlo + r32; bool rvalid = true;
    if constexpr (MSEL) { const unsigned inf_ = rinfo[wid * 32 + r32]; rvalid = inf_ != 0xFFFFFFFFu; qrow = rvalid ? (int)(inf_ & 0xFFFFu) : 0; }
    const int qm = qrow - 4 * hi;
    constexpr bool PIPE = false;
    int NT = 4, kb_first = 0;
    if constexpr (MLA || DSA) { NT = (U.P0 + 255) / 64 + 1; }
    if constexpr (DIL) { const int lowk = U.P0 - 128; const int j_lo = lowk > 0 ? lowk / 64 : 0; kb_first = j_lo * 64; NT = (U.P0 + 255) / 64 + 1 - j_lo; }
    if constexpr (MOWN || MSEL) { kb_first = U.own * 256; NT = 4; }
    unsigned koff, voff, peoff = 0u;
    { const int row = 4 * wid + (lane >> 4), colB = ((lane & 15) * 16) ^ ((row & 7) << 4); koff = (unsigned)((row * U.kpitch) * 2 + colB); }
    { const int kk = (wid >> 1) * 8 + ((lane & 31) >> 2), k = (kk & ~0xC) | ((kk & 4) << 1) | ((kk & 8) >> 1), c = (2 * (wid & 1) + (lane >> 5)) * 32 + (lane & 3) * 8;
      voff = (unsigned)((k * U.vpitch + c) * 2); }
    if constexpr (MLA) { const int row = 8 * wid + (lane >> 3), colB = ((lane & 7) * 16) ^ ((row & 7) << 4); peoff = (unsigned)((row * U.pepitch) * 2 + colB); }
    const unsigned bmoff = (unsigned)qrow * 1024u;
    const int vb0 = (int)(unsigned)(uintptr_t)V_lds + v_rd_base(lane);
    u32x2 mw_n = (u32x2){0u, 0u}, mw_c = (u32x2){0u, 0u};
#define KBASE(t) (kb_first + (t) * 64)
#define SLOAD(kb_, bf) do { const char* kt_ = (const char*)U.K + (size_t)(kb_) * U.kpitch * 2; const char* vt_ = (const char*)U.V + (size_t)(kb_) * U.vpitch * 2; \
        __builtin_amdgcn_global_load_lds((const unsigned*)(kt_ + koff), (LAS unsigned*)(K_lds + (bf) * SHM_K + wid * 1024), 16, 0, 0); \
        __builtin_amdgcn_global_load_lds((const unsigned*)(kt_ + (size_t)64 * U.kpitch + koff), (LAS unsigned*)(K_lds + (bf) * SHM_K + 8192 + wid * 1024), 16, 0, 0); \
        __builtin_amdgcn_global_load_lds((const unsigned*)(vt_ + voff), (LAS unsigned*)(V_lds + (bf) * SHM_V + wid * 1024), 16, 0, 0); \
        __builtin_amdgcn_global_load_lds((const unsigned*)(vt_ + (size_t)64 * U.vpitch + voff), (LAS unsigned*)(V_lds + (bf) * SHM_V + 8192 + wid * 1024), 16, 0, 0); \
        if constexpr (MLA) __builtin_amdgcn_global_load_lds((const unsigned*)((const char*)U.PE + (size_t)(kb_) * U.pepitch * 2 + peoff), (LAS unsigned*)(PE_lds + (bf) * SHM_PE + wid * 1024), 16, 0, 0); \
        if constexpr (DSA) mw_n = *(const u32x2*)((const char*)U.BM + (size_t)((kb_) >> 5) * 4 + bmoff); } while (0)
    if constexpr (!PIPE && !MSEL) { const int kb0 = KBASE(0); SLOAD(kb0, 0); }
    bf16x8 qr[8];
    LAS const char* qpe = lds + OFF_QPE + wid * 4096 + lane * 16;
    { const bf16* qp = U.Q + (size_t)qrow * U.qpitch + hi * 8;
#pragma unroll
      for (int d0 = 0; d0 < 8; ++d0) qr[d0] = *(const bf16x8*)(qp + d0 * 16);
      if constexpr (MLA) {
#pragma unroll
          for (int dd = 0; dd < 4; ++dd) *(LAS bf16x8*)(lds + OFF_QPE + wid * 4096 + lane * 16 + dd * 1024) = *(const bf16x8*)(qp + (8 + dd) * 16);
          asm volatile("s_waitcnt lgkmcnt(0)" ::: "memory"); }
    }
    if constexpr (MOWN) {
        const int own = U.own;
        LAS char* KM = lds + OFF_KM;
        { const int jb = tid >> 4, d8 = (tid & 15) * 8; const float* kp = U.KMP + (jb * 512 + d8);
          f32x4 a0 = (f32x4){0.f, 0.f, 0.f, 0.f}, a1 = a0;
#pragma unroll
          for (int pq = 0; pq < 4; ++pq) { a0 += *(const f32x4*)(kp + pq * 128); a1 += *(const f32x4*)(kp + pq * 128 + 4); }
          *(LAS bf16x8*)(KM + jb * 256 + d8 * 2) = pack8(a0 * (1.f / 256.f), a1 * (1.f / 256.f)); }
        __syncthreads();
        f32x16 g = f32x16{};
#pragma unroll
        for (int d0 = 0; d0 < 8; ++d0) { const bf16x8 a = *(const LAS bf16x8*)(KM + r32 * 256 + (d0 * 16 + hi * 8) * 2);
            g = __builtin_amdgcn_mfma_f32_32x32x16_bf16(a, qr[d0], g, 0, 0, 0); }
        const float NEG = -__builtin_inff();
#pragma unroll
        for (int r = 0; r < 16; ++r) if (crow(r, hi) >= own) g[r] = NEG;
        unsigned selbits = 0;
#pragma unroll
        for (int round = 0; round < 3; ++round) {
            float bv = NEG; int bi = 64;
#pragma unroll
            for (int r = 0; r < 16; ++r) { const int j = crow(r, hi); if (g[r] > bv) { bv = g[r]; bi = j; } }
            const float ov = __shfl_xor(bv, 32); const int oi = __shfl_xor(bi, 32);
            const bool take_other = (ov > bv) || (ov == bv && oi < bi);
            const float wv = take_other ? ov : bv; const int wi = take_other ? oi : bi;
            if (wv > NEG) { selbits |= 1u << wi;
#pragma unroll
                for (int r = 0; r < 16; ++r) if (crow(r, hi) == wi) g[r] = NEG; }
        }
        const int nsel = __builtin_popcount(selbits);
        if (hi == 0) { U.SEL[qrow] = selbits;
#pragma unroll
            for (int s_ = 0; s_ < 3; ++s_) if (s_ >= nsel) U.LSE[(size_t)s_ * U.lslot + (size_t)qrow * U.lse_stride] = NEG; }
        LAS int* cw = (LAS int*)(lds + OFF_TL);
        { const unsigned sb0 = hi == 0 ? selbits : 0u;
#pragma unroll
          for (int j0 = 0; j0 < 32; j0 += 8) { unsigned long long bq[8];
#pragma unroll
              for (int q = 0; q < 8; ++q) bq[q] = __ballot(((sb0 >> (j0 + q)) & 1u) != 0u);
              __builtin_amdgcn_sched_barrier(0);
              int cq[8];
#pragma unroll
              for (int q = 0; q < 8; ++q) cq[q] = __builtin_popcountll(bq[q]);
              if (lane == 0) { *(LAS u32x4*)(cw + wid * 32 + j0) = (u32x4){(unsigned)cq[0], (unsigned)cq[1], (unsigned)cq[2], (unsigned)cq[3]};
                  *(LAS u32x4*)(cw + wid * 32 + j0 + 4) = (u32x4){(unsigned)cq[4], (unsigned)cq[5], (unsigned)cq[6], (unsigned)cq[7]}; }
              __builtin_amdgcn_sched_barrier(0); } }
        __syncthreads();
        if (tid < 32) { int s_ = 0;
#pragma unroll
            for (int w_ = 0; w_ < 8; ++w_) s_ += cw[w_ * 32 + tid];
            U.CNT[tid] = s_; }
        __syncthreads();
    }
    float m_reg = -1e30f, l_reg = 0.f; f32x16 o[4] = {};
#define RESC(a) do { if (__any((a) < 1.f)) { if (hi == 0) al_l[r32] = (a); asm volatile("s_waitcnt lgkmcnt(0)" ::: "memory"); \
        _Pragma("unroll") for (int d_ = 0; d_ < 4; ++d_) _Pragma("unroll") for (int r = 0; r < 16; ++r) o[d_][r] *= al_l[crow(r, hi)]; } } while (0)
    const bool wact = MSEL ? (bool)__any(rvalid) : true;
#define STEP(t_, B_, NB_) do { const int kb_ = KBASE(t_); const bool more_ = (t_) + 1 < NT; \
        if (more_) { const int kbn_ = KBASE((t_) + 1); SLOAD(kbn_, NB_); } \
        bool act_ = wact; \
        if constexpr (MLA || DSA || MOWN) act_ = kb_ <= qlo + 31; \
        if constexpr (DIL) act_ = (kb_ <= qlo + 31) && (kb_ + 63 >= qlo - 128); \
        if (act_) { f32x16 p0, p1; qkt<B_>(p0, p1, K_lds, r32, hi, qr); \
            if constexpr (MLA) qkt_pe_lq<B_>(p0, p1, PE_lds, r32, hi, qpe); \
            if constexpr (MLA || MOWN) { if (kb_ + 63 > qlo) mask_tile(p0, p1, qm - kb_, 0x7fffffffu); } \
            if constexpr (DIL) { if (kb_ + 63 > qlo || kb_ <= qlo + 31 - 129) mask_tile(p0, p1, qm - kb_, 129u); } \
            float mn_, al_; partialSM<MODE>(p0, p1, m_reg, mn_, al_); RESC(al_); \
            bf16x8 pa0, pa1, pa2, pa3; finishSM<DSA>(p0, p1, al_, l_reg, pa0, pa1, pa2, pa3, mw_c.x >> (4 * hi), mw_c.y >> (4 * hi)); SBAR(); \
            pv_tile<B_>(o, vb0, pa0, pa1, pa2, pa3); } \
        VM_WAIT(); mw_c = mw_n; \
        __syncthreads(); } while (0)
    if (wid >= 4) __builtin_amdgcn_s_setprio(1);
    if constexpr (!PIPE) {
    { VM_WAIT(); mw_c = mw_n; }
    __syncthreads();
    DSEG(1);
    for (int t = 0; t < NT; t += 2) {
        STEP(t, 0, 1);
        if (t + 1 < NT) STEP(t + 1, 1, 0);
    }
    DSEG(2);
    } else {
#define SLOAD_K(kb_, bf) do { const char* kt_ = (const char*)U.K + (size_t)(kb_) * U.kpitch * 2; \
        __builtin_amdgcn_global_load_lds((const unsigned*)(kt_ + koff), (LAS unsigned*)(K_lds + (bf) * SHM_K + wid * 1024), 16, 0, 0); \
        __builtin_amdgcn_global_load_lds((const unsigned*)(kt_ + (size_t)64 * U.kpitch + koff), (LAS unsigned*)(K_lds + (bf) * SHM_K + 8192 + wid * 1024), 16, 0, 0); \
        if constexpr (MLA) __builtin_amdgcn_global_load_lds((const unsigned*)((const char*)U.PE + (size_t)(kb_) * U.pepitch * 2 + peoff), (LAS unsigned*)(PE_lds + (bf) * SHM_PE + wid * 1024), 16, 0, 0); } while (0)
#define SLOAD_V(kb_, bf) do { const char* vt_ = (const char*)U.V + (size_t)(kb_) * U.vpitch * 2; \
        __builtin_amdgcn_global_load_lds((const unsigned*)(vt_ + voff), (LAS unsigned*)(V_lds + (bf) * SHM_V + wid * 1024), 16, 0, 0); \
        __builtin_amdgcn_global_load_lds((const unsigned*)(vt_ + (size_t)64 * U.vpitch + voff), (LAS unsigned*)(V_lds + (bf) * SHM_V + 8192 + wid * 1024), 16, 0, 0); } while (0)
#define LOADMW(kb_) (*(const u32x2*)((const char*)U.BM + (size_t)((kb_) >> 5) * 4 + bmoff))
#define ACT_OF(kb_) ((MLA || DSA) ? ((kb_) <= qlo + 31) : (DIL ? (((kb_) <= qlo + 31) && ((kb_) + 63 >= qlo - 128)) : wact))
#define XPART1(PX0, PX1, KB_) do { qkt<KB_>(PX0, PX1, K_lds, r32, hi, qr); if constexpr (MLA) qkt_pe_lq<KB_>(PX0, PX1, PE_lds, r32, hi, qpe); } while (0)
#define XPART2(PX0, PX1, alX, kbx_) do { \
        if constexpr (MLA) { if ((kbx_) + 63 > qlo) mask_tile(PX0, PX1, qm - (kbx_), 0x7fffffffu); } \
        if constexpr (DIL) { if ((kbx_) + 63 > qlo || (kbx_) <= qlo + 31 - 129) mask_tile(PX0, PX1, qm - (kbx_), 129u); } \
        float mn_; partialSM<MODE>(PX0, PX1, m_reg, mn_, alX); } while (0)
#define HS(PX0, PX1, alX, actX, mwX, PY0, PY1, alY, actY, mwY, t_, KB_, VB_) do { const int kbx_ = KBASE(t_); \
        if ((t_) + 1 < NT) { const int kbn_ = KBASE((t_) + 1); SLOAD_K(kbn_, (KB_) ^ 1); } \
        SLOAD_V(kbx_, KB_); \
        actX = ACT_OF(kbx_); alX = 1.f; \
        bf16x8 pa0, pa1, pa2, pa3; \
        if (actX) XPART1(PX0, PX1, KB_); \
        if (actY) finishSM<DSA>(PY0, PY1, alY, l_reg, pa0, pa1, pa2, pa3, mwY.x >> (4 * hi), mwY.y >> (4 * hi)); \
        if constexpr (DSA) { if ((t_) + 1 < NT) mwY = LOADMW(KBASE((t_) + 1)); } \
        if (actY) { SBAR(); pv_tile<VB_>(o, vb0, pa0, pa1, pa2, pa3); } \
        if (actX) { XPART2(PX0, PX1, alX, kbx_); RESC(alX); } \
        VM_WAIT(); __syncthreads(); } while (0)
    f32x16 pA0, pA1, pB0, pB1; float alA = 1.f, alB = 1.f; bool actA = false, actB = false; u32x2 mwA = (u32x2){0u, 0u}, mwB = mwA;
    { const int kb0 = KBASE(0); SLOAD_K(kb0, 0); if constexpr (DSA) mwA = LOADMW(kb0); VM_WAIT(); }
    __syncthreads();
    {
        const int kb0 = KBASE(0);
        if (NT > 1) { const int kb1 = KBASE(1); SLOAD_K(kb1, 1); if constexpr (DSA) mwB = LOADMW(kb1); }
        SLOAD_V(kb0, 0);
        actA = ACT_OF(kb0);
        if (actA) { XPART1(pA0, pA1, 0); XPART2(pA0, pA1, alA, kb0); }
        VM_WAIT(); __syncthreads();
    }
    for (int t = 1; t < NT; t += 2) {
        HS(pB0, pB1, alB, actB, mwB, pA0, pA1, alA, actA, mwA, t, 1, 0);
        if (t + 1 < NT) HS(pA0, pA1, alA, actA, mwA, pB0, pB1, alB, actB, mwB, t + 1, 0, 1);
    }
    {
        bf16x8 pa0, pa1, pa2, pa3;
        if (NT & 1) { if (actA) { finishSM<DSA>(pA0, pA1, alA, l_reg, pa0, pa1, pa2, pa3, mwA.x >> (4 * hi), mwA.y >> (4 * hi)); SBAR(); pv_tile<0>(o, vb0, pa0, pa1, pa2, pa3); } }
        else { if (actB) { finishSM<DSA>(pB0, pB1, alB, l_reg, pa0, pa1, pa2, pa3, mwB.x >> (4 * hi), mwB.y >> (4 * hi)); SBAR(); pv_tile<1>(o, vb0, pa0, pa1, pa2, pa3); } }
    }
    __syncthreads();
#undef SLOAD_K
#undef SLOAD_V
#undef LOADMW
#undef ACT_OF
#undef XPART1
#undef XPART2
#undef HS
    }
    __builtin_amdgcn_s_setprio(0);
    if (hi == 0) li_l[r32] = l_reg;
    asm volatile("s_waitcnt lgkmcnt(0)" ::: "memory");
    float rli[16];
#pragma unroll
    for (int r = 0; r < 16; ++r) rli[r] = __builtin_amdgcn_rcpf(li_l[crow(r, hi)]);
    const bool oddl = (r32 & 1) != 0; const int pcol = oddl ? 31 + r32 : r32;
    if constexpr (MSEL) {
        if (wact) {
#pragma unroll
            for (int r = 0; r < 16; ++r) { const unsigned inf_ = rinfo[wid * 32 + crow(r, hi)];
                if (inf_ != 0xFFFFFFFFu) { bf16* rb = U.O + (size_t)(inf_ >> 16) * U.oslot + (size_t)(inf_ & 0xFFFFu) * U.opitch;
#pragma unroll
                    for (int dp = 0; dp < 2; ++dp) { const float va = o[2 * dp][r] * rli[r], vb = o[2 * dp + 1][r] * rli[r];
                        const float rv = __shfl_xor(oddl ? va : vb, 1);
                        *(unsigned*)(rb + dp * 64 + pcol) = cvt_pk_bf16(oddl ? rv : va, oddl ? vb : rv); } } }
            if (hi == 0 && rvalid) { const unsigned inf_ = rinfo[wid * 32 + r32];
                U.LSE[(size_t)(inf_ >> 16) * U.lslot + (size_t)(inf_ & 0xFFFFu) * U.lse_stride] = m_reg * C2 + __builtin_amdgcn_logf(l_reg); }
        }
    } else {
      { const unsigned lane_off = (unsigned)((4 * hi * U.opitch + pcol) * 2);
        const char* obase = (const char*)(U.O + (size_t)qlo * U.opitch);
#pragma unroll
        for (int r = 0; r < 16; ++r) { const char* rb = obase + (size_t)((r & 3) + 8 * (r >> 2)) * U.opitch * 2;
#pragma unroll
          for (int dp = 0; dp < 2; ++dp) { const float va = o[2 * dp][r] * rli[r], vb = o[2 * dp + 1][r] * rli[r];
              const float rv = __shfl_xor(oddl ? va : vb, 1);
              *(unsigned*)(rb + dp * 128 + lane_off) = cvt_pk_bf16(oddl ? rv : va, oddl ? vb : rv); } } }
      if constexpr (DIL) { if (hi == 0) U.LSE[(size_t)qrow * U.lse_stride] = m_reg * C2 + __builtin_amdgcn_logf(l_reg); }
      if constexpr (MOWN) { if (hi == 0) U.LSE[(size_t)3 * U.lslot + (size_t)qrow * U.lse_stride] = m_reg * C2 + __builtin_amdgcn_logf(l_reg); }
    }
    __syncthreads();
    DSEG(3);
#undef DSEG
#undef KBASE
#undef SLOAD
#undef RESC
#undef STEP
}
}

__device__ __forceinline__ void rope_row_heads128(bf16* kbase, const float* cs, const float* sn, int lane) {
    const int h = lane >> 3, i0 = (lane & 7) * 8;
    bf16* p = kbase + h * 128 + i0;
    bf16x8 a = *(const bf16x8*)p, b = *(const bf16x8*)(p + 64);
    att::rope_pair(a, b, cs + i0, sn + i0);
    *(bf16x8*)p = a; *(bf16x8*)(p + 64) = b;
}
__device__ __forceinline__ void post_even(Frame& F, const float* g_q, const float* g_kv, size_t ws_off = WS_PROJ) {
    bf16* PROJ = (bf16*)(F.ws + ws_off);
    const float* c128 = (const float*)(F.ws + WS_COS128); const float* s128 = (const float*)(F.ws + WS_SIN128);
    const float* c64 = (const float*)(F.ws + WS_COS64); const float* s64 = (const float*)(F.ws + WS_SIN64);
    const int gw = F.vcu * NWAVES + F.wave, NGW = F.G * NWAVES, lane = F.lane;
    for (int m = gw; m < T; m += NGW) {
        bf16* row = PROJ + (size_t)m * EVEN_INP; const int pos = m & (SEQ - 1);
        {
            bf16x8 v = *(const bf16x8*)(row + EC_CQ + lane * 8); float f[8], s = 0.f;
#pragma unroll
            for (int j = 0; j < 8; ++j) { f[j] = bf2f((unsigned short)v[j]); s += f[j] * f[j]; }
            const float rs = 1.0f / sqrtf(wave_sum(s) * (1.f / 512.f) + NORM_EPS);
            const f32x4 g0 = *(const f32x4*)(g_q + lane * 8), g1 = *(const f32x4*)(g_q + lane * 8 + 4);
            f32x4 o0 = {f[0] * rs * g0[0], f[1] * rs * g0[1], f[2] * rs * g0[2], f[3] * rs * g0[3]}, o1 = {f[4] * rs * g1[0], f[5] * rs * g1[1], f[6] * rs * g1[2], f[7] * rs * g1[3]};
            *(bf16x8*)(row + EC_CQ + lane * 8) = att::pack8(o0, o1); }
        {
            const u32x2 v = *(const u32x2*)(row + EC_CKV + lane * 4);
            const float f0 = bf2f((unsigned short)(v.x & 0xffff)), f1 = bf2f((unsigned short)(v.x >> 16)), f2 = bf2f((unsigned short)(v.y & 0xffff)), f3 = bf2f((unsigned short)(v.y >> 16));
            const float rs = 1.0f / sqrtf(wave_sum(f0 * f0 + f1 * f1 + f2 * f2 + f3 * f3) * (1.f / 256.f) + NORM_EPS);
            const f32x4 g0 = *(const f32x4*)(g_kv + lane * 4);
            u32x2 w; w.x = cvt_pk_bf16(f0 * rs * g0[0], f1 * rs * g0[1]); w.y = cvt_pk_bf16(f2 * rs * g0[2], f3 * rs * g0[3]);
            *(u32x2*)(row + EC_CKV + lane * 4) = w; }
        {
            const int i = lane & 31; bf16* p = row + ((lane < 32) ? EC_KPE : EC_KI) + i;
            const float x1 = bf2f(p[0]), x2 = bf2f(p[32]); const float c = c64[pos * 32 + i], s = s64[pos * 32 + i];
            const unsigned y = cvt_pk_bf16(x1 * c - x2 * s, x1 * s + x2 * c);
            p[0] = (bf16)(y & 0xffff); p[32] = (bf16)(y >> 16); }
        rope_row_heads128(row + EC_K, c128 + (size_t)pos * 64, s128 + (size_t)pos * 64, lane);
    }
}
__device__ __forceinline__ void post_odd(Frame& F) {
    bf16* PROJ = (bf16*)(F.ws + WS_PROJ2);
    const float* c128 = (const float*)(F.ws + WS_COS128); const float* s128 = (const float*)(F.ws + WS_SIN128);
    float* KMP = (float*)(F.ws + WS_KM);
    LAS float* red = (LAS float*)F.lds;
    const int lane = F.lane, h = lane >> 3, i0 = (lane & 7) * 8;
    for (int u = F.vcu; u < T / 64; u += F.G) {
        float sa[8], sb[8];
#pragma unroll
        for (int j = 0; j < 8; ++j) { sa[j] = 0.f; sb[j] = 0.f; }
        for (int rr = 0; rr < 8; ++rr) {
            const int m = u * 64 + F.wave * 8 + rr; const int pos = m & (SEQ - 1);
            bf16* row = PROJ + (size_t)m * ODD_IN;
            const float* cs = c128 + (size_t)pos * 64; const float* sn = s128 + (size_t)pos * 64;
            { bf16* p = row + OC_KC + h * 128 + i0; bf16x8 a = *(const bf16x8*)p, b = *(const bf16x8*)(p + 64);
              const f32x4 c0 = *(const f32x4*)(cs + i0), c1 = *(const f32x4*)(cs + i0 + 4), s0 = *(const f32x4*)(sn + i0), s1 = *(const f32x4*)(sn + i0 + 4);
              f32x4 y1a, y1b, y2a, y2b;
#pragma unroll
              for (int j = 0; j < 4; ++j) { const float x1 = bf2f((unsigned short)a[j]), x2 = bf2f((unsigned short)b[j]); y1a[j] = x1 * c0[j] - x2 * s0[j]; y2a[j] = x1 * s0[j] + x2 * c0[j];
                  const float z1 = bf2f((unsigned short)a[4 + j]), z2 = bf2f((unsigned short)b[4 + j]); y1b[j] = z1 * c1[j] - z2 * s1[j]; y2b[j] = z1 * s1[j] + z2 * c1[j];
                  sa[j] += y1a[j]; sa[4 + j] += y1b[j]; sb[j] += y2a[j]; sb[4 + j] += y2b[j]; }
              *(bf16x8*)p = att::pack8(y1a, y1b); *(bf16x8*)(p + 64) = att::pack8(y2a, y2b); }
            rope_row_heads128(row + OC_KD, cs, sn, lane);
        }
#pragma unroll
        for (int j = 0; j < 8; ++j) { red[F.wave * 1024 + h * 128 + i0 + j] = sa[j]; red[F.wave * 1024 + h * 128 + 64 + i0 + j] = sb[j]; }
        __syncthreads();
        { const int b = u / 128, jq = u % 128, jb = jq >> 2, q4 = jq & 3;
#pragma unroll
          for (int cc = 0; cc < 2; ++cc) { const int col = F.tid + cc * 512; float s = 0.f;
#pragma unroll
              for (int w = 0; w < 8; ++w) s += red[w * 1024 + col];
              const int hh = col >> 7, d = col & 127;
              KMP[((((size_t)b * 8 + hh) * 32 + jb) * 4 + q4) * 128 + d] = s; } }
        __syncthreads();
    }
}

#ifndef REPMASK
#define REPMASK 0ull
#endif
#define IDX_REP_A ((((REPMASK) >> 24) & 1ull) ? 2 : 1)
#define IDX_REP_B ((((REPMASK) >> 25) & 1ull) ? 2 : 1)
__device__ __forceinline__ void indexer_unit(Frame& F, int b, int i) {
    const bf16* PR = (const bf16*)(F.ws + WS_PROJ) + (size_t)b * SEQ * EVEN_INP;
    const float* c64 = (const float*)(F.ws + WS_COS64); const float* s64 = (const float*)(F.ws + WS_SIN64);
    float* SCw = (float*)(F.ws + WS_SC + (size_t)blockIdx.x * MiB);
    unsigned* BMb = (unsigned*)(F.ws + WS_BM) + (size_t)b * SEQ * 256;
    LAS unsigned char* lds = F.lds;
    const int tid = F.tid, wid = F.wave, lane = F.lane, r32 = lane & 31, hi = lane >> 5;
    const int t0 = 32 * i;
    LAS float* sgl = (LAS float*)(lds + 139264);
    {
        const int row = tid & 31, h = tid >> 5; const int pos = t0 + row;
        const float wv = bf2f(PR[(size_t)pos * EVEN_INP + EC_WI + h]) * 0.03125f;
        sgl[h * 32 + row] = wv < 0.f ? -1.f : 1.f;
        const bf16* qp = PR + (size_t)pos * EVEN_INP + EC_QI + h * 64;
        bf16x8 f[8];
#pragma unroll
        for (int p = 0; p < 8; ++p) f[p] = *(const bf16x8*)(qp + p * 8);
        { const float aw = fabsf(wv);
#pragma unroll
          for (int p = 0; p < 8; ++p) { f32x4 lo, hi4;
#pragma unroll
              for (int e = 0; e < 4; ++e) { lo[e] = bf2f((unsigned short)f[p][e]) * aw; hi4[e] = bf2f((unsigned short)f[p][4 + e]) * aw; }
              f[p] = att::pack8(lo, hi4); } }
#pragma unroll
        for (int p = 0; p < 8; ++p) *(LAS bf16x8*)(lds + ((((h * 4 + (p >> 1)) * 2 + (p & 1)) * 32 + row) * 16)) = f[p];
    }
    __syncthreads();
    {
        const int row = tid & 31, dg = tid >> 5, ks = dg >> 2, hi2 = (dg >> 1) & 1, e0 = (dg & 1) * 4;
        float acc4[4] = {0.f, 0.f, 0.f, 0.f};
#pragma unroll
        for (int h = 0; h < 16; ++h) { const u32x2 v = *(const LAS u32x2*)(lds + ((((h * 4 + ks) * 2 + hi2) * 32 + row) * 16) + e0 * 2); const float sg = sgl[h * 32 + row];
            acc4[0] += sg * bf2f((unsigned short)(v.x & 0xffff)); acc4[1] += sg * bf2f((unsigned short)(v.x >> 16));
            acc4[2] += sg * bf2f((unsigned short)(v.y & 0xffff)); acc4[3] += sg * bf2f((unsigned short)(v.y >> 16)); }
        u32x2 o2; o2.x = cvt_pk_bf16(acc4[0], acc4[1]); o2.y = cvt_pk_bf16(acc4[2], acc4[3]);
        *(LAS u32x2*)(lds + ((((16 * 4 + ks) * 2 + hi2) * 32 + row) * 16) + e0 * 2) = o2;
    }
    __syncthreads();
    const int nkeys = 32 * (i + 1), nsteps = (nkeys + 63) / 64;
    {
        const int kz0 = 64 * nsteps, kz1 = (kz0 + 1023) & ~1023, n4 = (kz1 - kz0) >> 2;
        for (int idx = tid; idx < 32 * n4; idx += 512) { const int row = idx / n4, c = idx - row * n4;
            *(u32x4*)(SCw + (size_t)row * 8192 + kz0 + 4 * c) = (u32x4){0u, 0u, 0u, 0u}; } }
    LAS float* tls = (LAS float*)(lds + 69632 + wid * 8704);
    for (int rep_ = 0; rep_ < IDX_REP_A; ++rep_) {
    bf16x8 ka[4], kb[4];
#define IDX_LDK(G_) do { const bf16* kp = PR + (size_t)(64 * (G_) + r32) * EVEN_INP + EC_KI + hi * 8; \
        _Pragma("unroll") for (int ks = 0; ks < 4; ++ks) { ka[ks] = *(const bf16x8*)(kp + ks * 16); kb[ks] = *(const bf16x8*)(kp + (size_t)32 * EVEN_INP + ks * 16); } } while (0)
    if (wid < nsteps) IDX_LDK(wid);
    for (int g = wid; g < nsteps; g += 8) {
        const int k0 = 64 * g;
        f32x16 s0 = f32x16{}, s1 = f32x16{};
        LAS const unsigned char* qb_ = lds + (hi * 32 + r32) * 16;
#define IDX_LDQ(Q, H) do { _Pragma("unroll") for (int ks = 0; ks < 4; ++ks) Q[ks] = *(const LAS bf16x8*)(qb_ + (H) * 4096 + ks * 1024); } while (0)
#define IDX_MMA(A0, A1, Q) do { A0 = f32x16{}; A1 = f32x16{}; _Pragma("unroll") for (int ks = 0; ks < 4; ++ks) { \
            A0 = __builtin_amdgcn_mfma_f32_32x32x16_bf16(ka[ks], Q[ks], A0, 0, 0, 0); A1 = __builtin_amdgcn_mfma_f32_32x32x16_bf16(kb[ks], Q[ks], A1, 0, 0, 0); } } while (0)
#define IDX_ACC(A0, A1, W) do { _Pragma("unroll") for (int r = 0; r < 16; ++r) { s0[r] = fmaf(W, __builtin_fabsf(A0[r]), s0[r]); s1[r] = fmaf(W, __builtin_fabsf(A1[r]), s1[r]); } } while (0)
        f32x16 a0, a1, b0, b1; bf16x8 qx[4], qy[4];
        IDX_LDQ(qx, 0); IDX_LDQ(qy, 1);
        IDX_MMA(a0, a1, qx);
#pragma unroll 1
        for (int h = 0; h < 16; h += 2) {
            const float w0 = sgl[h * 32 + r32], w1 = sgl[(h + 1) * 32 + r32];
            IDX_LDQ(qx, h + 2);
            __builtin_amdgcn_sched_barrier(0);
            IDX_MMA(b0, b1, qy);
            __builtin_amdgcn_sched_barrier(0);
            IDX_ACC(a0, a1, w0);
            __builtin_amdgcn_sched_barrier(0);
            if (h + 3 < 17) IDX_LDQ(qy, h + 3);
            __builtin_amdgcn_sched_barrier(0);
            IDX_MMA(a0, a1, qx);
            __builtin_amdgcn_sched_barrier(0);
            IDX_ACC(b0, b1, w1);
            __builtin_amdgcn_sched_barrier(0);
        }
#undef IDX_LDQ
        __builtin_amdgcn_sched_barrier(0);
        if (g + 8 < nsteps) IDX_LDK(g + 8);
        __builtin_amdgcn_sched_barrier(0);
#undef IDX_LDK
#pragma unroll
        for (int r = 0; r < 16; ++r) { s0[r] = s0[r] + a0[r]; s1[r] = s1[r] + a1[r]; }
#undef IDX_MMA
#undef IDX_ACC
        { float* srw = SCw + (size_t)r32 * 8192 + k0 + 4 * hi; const bool diag = k0 + 63 > t0; const int kq = k0 + 4 * hi - t0 - r32;
#pragma unroll
          for (int q4 = 0; q4 < 4; ++q4) {
#pragma unroll
            for (int hf = 0; hf < 2; ++hf) { u32x4 uu;
#pragma unroll
                for (int e = 0; e < 4; ++e) { const unsigned x = __float_as_uint(hf ? s1[4 * q4 + e] : s0[4 * q4 + e]); uu[e] = x ^ ((unsigned)((int)x >> 31) | 0x80000000u); }
                if (diag) {
#pragma unroll
                    for (int e = 0; e < 4; ++e) uu[e] = (kq + 8 * q4 + 32 * hf + e <= 0) ? uu[e] : 0u; }
                *(u32x4*)(srw + 8 * q4 + 32 * hf) = uu; } } }
    } }
    VM_WAIT();
    __syncthreads();
    __builtin_amdgcn_fence(__ATOMIC_ACQUIRE, "agent");
    VM_WAIT();
    unsigned u[128];
#define SEL_LOADG(g8_, kk_) do { const int rho_ = wid * 4 + (kk_), nch_ = (t0 + rho_ + 1 + 63) >> 6; \
        if ((g8_) * 16 < nch_) { const float* sg0 = SCw + (size_t)rho_ * 8192 + lane + (g8_) * 1024; asm volatile("" : "+v"(sg0));     \
            const GAS unsigned* sg = (const GAS unsigned*)sg0; \
            _Pragma("unroll") for (int jj = 0; jj < 16; ++jj) u[(g8_) * 16 + jj] = sg[64 * jj]; } \
        else { _Pragma("unroll") for (int jj = 0; jj < 16; ++jj) u[(g8_) * 16 + jj] = 0u; } } while (0)
#pragma unroll
    for (int g8 = 0; g8 < 8; ++g8) SEL_LOADG(g8, 0);
    for (int k_ = 0; k_ < 4 * IDX_REP_B; ++k_) { const int k = k_ & 3;
        const int rho = wid * 4 + k, t = t0 + rho, nvalid = t + 1, nch = (nvalid + 63) >> 6;
        const bool more_rows = k_ + 1 < 4 * IDX_REP_B; const int kn = (k_ + 1) & 3;
        unsigned tau = 1u;
#define SEL_COUNT(cand_, cnt_) do { cnt_ = 0; _Pragma("unroll") for (int g8 = 0; g8 < 8; ++g8) if (g8 * 16 < nch) { \
            _Pragma("unroll") for (int h8 = 0; h8 < 2; ++h8) { unsigned long long bq_[8]; \
                _Pragma("unroll") for (int q_ = 0; q_ < 8; ++q_) bq_[q_] = __ballot(u[g8 * 16 + h8 * 8 + q_] >= (cand_)); \
                __builtin_amdgcn_sched_barrier(0); \
                _Pragma("unroll") for (int q_ = 0; q_ < 8; ++q_) cnt_ += __builtin_popcountll(bq_[q_]); \
                __builtin_amdgcn_sched_barrier(0); } } } while (0)
        if (nvalid > 256) {
            unsigned P = 0u; int c1 = 0;
            { const int ksm = (65536 + nvalid - 1) / nvalid;
              unsigned ps = 0u;
              for (int bit = 15; bit >= 0; --bit) { const unsigned cand = ps | (1u << bit); int cnt = 0;
#pragma unroll
                  for (int jj = 0; jj < 4; ++jj) cnt += __builtin_popcountll(__ballot(u[jj] >= (cand << 16)));
                  if (cnt >= ksm) ps = cand; }
              unsigned blo, bhi; int chi = 0, c0; SEL_COUNT(ps << 16, c0);
              if (c0 >= 256) { blo = ps; bhi = 0x10000u; unsigned step = 8u;
                  for (;;) { const unsigned cand = blo + step; if (cand > 0xFFFFu) { bhi = 0x10000u; chi = 0; break; }
                      int cc; SEL_COUNT(cand << 16, cc); if (cc >= 256) { blo = cand; step <<= 1; } else { bhi = cand; chi = cc; break; } }
              } else { bhi = ps; chi = c0; blo = 0u; unsigned step = 8u;
                  for (;;) { const unsigned cand = bhi > step ? bhi - step : 0u; int cc; SEL_COUNT(cand << 16, cc);
                      if (cc >= 256) { blo = cand; break; } else { bhi = cand; chi = cc; step <<= 1; } } }
              while (bhi - blo > 1u) { const unsigned mid = (blo + bhi) >> 1; int cm; SEL_COUNT(mid << 16, cm); if (cm >= 256) blo = mid; else { bhi = mid; chi = cm; } }
              P = blo << 16; c1 = chi; }
            constexpr int LCAP = 1024;
            LAS unsigned* lst = (LAS unsigned*)(lds + wid * (LCAP * 4));
            int c2 = 0;
#pragma unroll
            for (int g8 = 0; g8 < 8; ++g8) if (g8 * 16 < nch) {
#pragma unroll
                for (int h8 = 0; h8 < 2; ++h8) { unsigned long long bq[8];
#pragma unroll
                    for (int q = 0; q < 8; ++q) bq[q] = __ballot((u[g8 * 16 + h8 * 8 + q] ^ P) < 65536u);
                    __builtin_amdgcn_sched_barrier(0);
#pragma unroll
                    for (int q = 0; q < 8; ++q) { const unsigned long long bal = bq[q];
                        if (bal != 0ull) { const unsigned x = u[g8 * 16 + h8 * 8 + q] ^ P; const bool fl = x < 65536u;
                            const int pos = c2 + (int)__builtin_amdgcn_mbcnt_hi((unsigned)(bal >> 32), __builtin_amdgcn_mbcnt_lo((unsigned)bal, 0u));
                            if (fl && pos < LCAP) lst[pos] = x;
                            c2 += __builtin_popcountll(bal); } }
                    __builtin_amdgcn_sched_barrier(0); } }
            const int need = 256 - c1;
            if (c2 <= 256) {
                asm volatile("s_waitcnt lgkmcnt(0)" ::: "memory");
                unsigned lv[4];
#pragma unroll
                for (int q = 0; q < 4; ++q) { const int i = q * 64 + lane; lv[q] = (i < c2) ? lst[i] + 1u : 0u; }
                unsigned L = 0u;
                for (int bit = 15; bit >= 0; --bit) { const unsigned cand = L | (1u << bit); int cnt = 0;
#pragma unroll
                    for (int q = 0; q < 4; ++q) if (q * 64 < c2) cnt += __builtin_popcountll(__ballot(lv[q] > cand));
                    if (cnt >= need) L = cand; }
                tau = P | L;
            } else if (c2 <= LCAP) {
                asm volatile("s_waitcnt lgkmcnt(0)" ::: "memory");
                unsigned L = 0u;
                for (int bit = 15; bit >= 0; --bit) { const unsigned cand = L | (1u << bit); int cnt = 0;
                    for (int i0 = 0; i0 < c2; i0 += 64) { const int i = i0 + lane; cnt += __builtin_popcountll(__ballot(i < c2 && lst[i < c2 ? i : 0] >= cand)); }
                    if (cnt >= need) L = cand; }
                tau = P | L;
            } else {
                tau = P;
                for (int bit = 15; bit >= 0; --bit) { const unsigned cand = tau | (1u << bit); int cnt; SEL_COUNT(cand, cnt); if (cnt >= 256) tau = cand; }
            }
        }
#undef SEL_COUNT
        unsigned* brow = BMb + (size_t)t * 256;
#pragma unroll
        for (int half = 0; half < 2; ++half) { unsigned lo = 0u, hw = 0u;
#pragma unroll
            for (int g4 = 0; g4 < 4; ++g4) { if ((half * 4 + g4) * 16 < nch) {
#pragma unroll
              for (int h8 = 0; h8 < 2; ++h8) { unsigned long long bq[8];
#pragma unroll
                for (int q = 0; q < 8; ++q) bq[q] = __ballot(u[half * 64 + g4 * 16 + h8 * 8 + q] >= tau);
                __builtin_amdgcn_sched_barrier(0);
#pragma unroll
                for (int q = 0; q < 8; ++q) { const unsigned bl_ = (unsigned)bq[q], bh_ = (unsigned)(bq[q] >> 32);
                    if (q == 0) asm volatile("s_nop 1\n\tv_writelane_b32 %0, %2, %4\n\tv_writelane_b32 %1, %3, %4" : "+v"(lo), "+v"(hw) : "s"(bl_), "s"(bh_), "n"(g4 * 16 + h8 * 8 + q));
                    else asm volatile("v_writelane_b32 %0, %2, %4\n\tv_writelane_b32 %1, %3, %4" : "+v"(lo), "+v"(hw) : "s"(bl_), "s"(bh_), "n"(g4 * 16 + h8 * 8 + q)); }
                __builtin_amdgcn_sched_barrier(0); } }
              if (more_rows) SEL_LOADG(half * 4 + g4, kn); }
            *(u32x2*)(brow + (half * 64 + lane) * 2) = (u32x2){lo, hw}; }
    }
#undef SEL_LOADG
    __syncthreads();
}
__device__ __forceinline__ void dil_combine_rows(const float* LSE, bf16* O, const bf16* OG, int ma, int mb, int lane) {
    const int h = lane >> 3;
    int mr[2]; mr[0] = ma; mr[1] = mb;
    float l[2][3]; bf16x8 da[2][3], db[2][3];
#pragma unroll
    for (int q = 0; q < 2; ++q) {
#pragma unroll
        for (int g = 0; g < 3; ++g) { l[q][g] = LSE[((size_t)g * T + mr[q]) * 8 + h];
            const bf16* p = g == 0 ? O + (size_t)mr[q] * DM + 1024 + lane * 16 : OG + ((size_t)(g - 1) * T + mr[q]) * 1024 + lane * 16;
            da[q][g] = *(const bf16x8*)p; db[q][g] = *(const bf16x8*)(p + 8); } }
#pragma unroll
    for (int q = 0; q < 2; ++q) {
        float w[3];
        const float mx = fmaxf(l[q][0], fmaxf(l[q][1], l[q][2]));
        float ssum = 0.f;
#pragma unroll
        for (int g = 0; g < 3; ++g) { w[g] = __builtin_amdgcn_exp2f(l[q][g] - mx); ssum += w[g]; }
        const float inv = 1.f / ssum;
        float acc[16];
#pragma unroll
        for (int g = 0; g < 3; ++g) { const bf16x8 a = da[q][g], b = db[q][g]; const float wg = w[g] * inv;
#pragma unroll
            for (int j = 0; j < 8; ++j) { const float xa = wg * bf2f((unsigned short)a[j]), xb = wg * bf2f((unsigned short)b[j]);
                acc[j] = g == 0 ? xa : acc[j] + xa; acc[8 + j] = g == 0 ? xb : acc[8 + j] + xb; } }
        bf16* op = O + (size_t)mr[q] * DM + 1024 + lane * 16;
        *(bf16x8*)op = att::pack8((f32x4){acc[0], acc[1], acc[2], acc[3]}, (f32x4){acc[4], acc[5], acc[6], acc[7]});
        *(bf16x8*)(op + 8) = att::pack8((f32x4){acc[8], acc[9], acc[10], acc[11]}, (f32x4){acc[12], acc[13], acc[14], acc[15]}); }
}
__device__ __forceinline__ void dil_combine(Frame& F, bf16* O, const bf16* OG, unsigned* ctr) {
    const float* LSE = (const float*)(F.ws + WS_LSE);
    for (;;) { unsigned c = 0u; if (F.lane == 0) c = __hip_atomic_fetch_add(ctr, 1u, __ATOMIC_RELAXED, __HIP_MEMORY_SCOPE_AGENT);
        c = (unsigned)__builtin_amdgcn_readfirstlane(c);
        if (c >= (unsigned)(T / 8)) break;
#pragma unroll 1
        for (int r = 0; r < 8; r += 2) dil_combine_rows(LSE, O, OG, (int)c * 8 + r, (int)c * 8 + r + 1, F.lane); }
}
constexpr int MOBA_LPRE_OFF = 4096;
__device__ __forceinline__ int moba_chunk_table(Frame& F, const int* CNT, LAS int* ctab) {
    LAS int* wt = ctab + 512;
    int v = 0;
    LAS unsigned short* lpre = (LAS unsigned short*)((LAS char*)ctab + MOBA_LPRE_OFF);
    if (F.tid < 496) { const int bh = F.tid / 31, j = F.tid - bh * 31; int n = 0;
        int cvs[32]; cvs[0] = 0;
#pragma unroll
        for (int qb = 1; qb < 32; ++qb) cvs[qb] = CNT[(bh * 32 + qb) * 32 + j];
#pragma unroll
        for (int qb = 0; qb < 32; ++qb) { lpre[F.tid * 33 + qb] = (unsigned short)n; n += (qb > j) ? cvs[qb] : 0; }
        lpre[F.tid * 33 + 32] = (unsigned short)n;
        v = (n + 255) >> 8; }
    int incl = v;
#pragma unroll
    for (int o_ = 1; o_ < 64; o_ <<= 1) { const int x_ = __shfl_up(incl, o_); if (F.lane >= o_) incl += x_; }
    if (F.lane == 63) wt[F.wave] = incl;
    __syncthreads();
    int off = 0;
    for (int w_ = 0; w_ < F.wave; ++w_) off += wt[w_];
    ctab[F.tid] = off + incl - v;
    if (F.tid == 511) ctab[512 + 16] = off + incl;
    __syncthreads();
    return ctab[512 + 16];
}
__device__ __forceinline__ void moba_build_list(Frame& F, const unsigned* SEL, const int* CNT, int bh, int j, int c, LAS unsigned* rinfo, LAS int* wc) {
    const int tid = F.tid, lane = F.lane, wid = F.wave;
    if (tid < 256) rinfo[tid] = 0xFFFFFFFFu;
    __syncthreads();
    const int lo = 256 * c, hi_ = lo + 256;
    const int qbl = lane & 31;
    const LAS unsigned short* lp = (const LAS unsigned short*)((const LAS char*)F.lds + 98304 + MOBA_LPRE_OFF) + (bh * 31 + j) * 33 + qbl;
    const int start = (int)lp[0], cq = (int)lp[1] - start;
    const bool ov = cq > 0 && start < hi_ && start + cq > lo;
    unsigned ovm = (unsigned)__ballot(ov && lane < 32);
    for (int k = 0; ovm != 0u; ++k) {
        const int qb = __builtin_ctz(ovm); ovm &= ovm - 1u;
        if ((k & 7) != wid) continue;
        const int base = __shfl(start, qb);
        const u32x4 w4 = *(const u32x4*)(SEL + (size_t)bh * SEQ + qb * 256 + lane * 4);
        int f[4]; int n = 0;
#pragma unroll
        for (int e = 0; e < 4; ++e) { f[e] = (w4[e] >> j) & 1u; n += f[e]; }
        int inc2 = n;
#pragma unroll
        for (int o_ = 1; o_ < 64; o_ <<= 1) { const int v_ = __shfl_up(inc2, o_); if (lane >= o_) inc2 += v_; }
        int pos = base + inc2 - n;
#pragma unroll
        for (int e = 0; e < 4; ++e) { if (f[e]) { if (pos >= lo && pos < hi_) rinfo[pos - lo] = (unsigned)(qb * 256 + lane * 4 + e) | ((unsigned)__builtin_popcount(w4[e] & ((1u << j) - 1u)) << 16); ++pos; } }
    }
    __syncthreads();
}
__device__ __forceinline__ void moba_combine(Frame& F, bf16* O, const bf16* PO, const float* LSEP) {
    const int gw = F.vcu * NWAVES + F.wave, NGW = F.G * NWAVES, lane = F.lane, h = lane >> 3;
    for (int m0 = gw; m0 < T; m0 += 2 * NGW) {
        int mr[2]; mr[0] = m0; mr[1] = (m0 + NGW < T) ? m0 + NGW : m0; const bool two = m0 + NGW < T;
        float l[2][4]; bf16x8 da[2][4], db[2][4];
#pragma unroll
        for (int q = 0; q < 2; ++q) {
#pragma unroll
            for (int s_ = 0; s_ < 4; ++s_) { l[q][s_] = LSEP[((size_t)s_ * T + mr[q]) * 8 + h];
                const bf16* p = s_ == 3 ? O + (size_t)mr[q] * DM + lane * 16 : PO + ((size_t)s_ * T + mr[q]) * 1024 + lane * 16;
                da[q][s_] = *(const bf16x8*)p; db[q][s_] = *(const bf16x8*)(p + 8); } }
#pragma unroll
        for (int q = 0; q < 2; ++q) { if (q == 1 && !two) break;
            float w[4];
            const float mx = fmaxf(fmaxf(l[q][0], l[q][1]), fmaxf(l[q][2], l[q][3]));
            float ssum = 0.f;
#pragma unroll
            for (int s_ = 0; s_ < 4; ++s_) { w[s_] = __builtin_amdgcn_exp2f(l[q][s_] - mx); ssum += w[s_]; }
            const float inv = 1.f / ssum;
            float acc[16];
            { const bf16x8 a = da[q][3], b = db[q][3]; const float wg = w[3] * inv;
#pragma unroll
              for (int j = 0; j < 8; ++j) { acc[j] = wg * bf2f((unsigned short)a[j]); acc[8 + j] = wg * bf2f((unsigned short)b[j]); } }
#pragma unroll
            for (int s_ = 0; s_ < 3; ++s_) { const bool on = w[s_] > 0.f; const bf16x8 a = da[q][s_], b = db[q][s_]; const float wg = w[s_] * inv;
#pragma unroll
                for (int j = 0; j < 8; ++j) { const float xa = wg * bf2f((unsigned short)a[j]), xb = wg * bf2f((unsigned short)b[j]);
                    acc[j] += on ? xa : 0.f; acc[8 + j] += on ? xb : 0.f; } }
            bf16* op = O + (size_t)mr[q] * DM + lane * 16;
            *(bf16x8*)op = att::pack8((f32x4){acc[0], acc[1], acc[2], acc[3]}, (f32x4){acc[4], acc[5], acc[6], acc[7]});
            *(bf16x8*)(op + 8) = att::pack8((f32x4){acc[8], acc[9], acc[10], acc[11]}, (f32x4){acc[12], acc[13], acc[14], acc[15]}); }
    }
}
__global__ void __launch_bounds__(NWAVES * 64, 2) __attribute__((target("no-packed-fp32-ops"))) fwd_kernel(Args args) {
    extern __shared__ __attribute__((aligned(16))) unsigned char lds_raw[];
    Frame F;
    F.lds = (LAS unsigned char*)lds_raw;
    F.tid = threadIdx.x; F.lane = F.tid & 63; F.wave = __builtin_amdgcn_readfirstlane(F.tid >> 6);
    F.G = gridDim.x; { const int bx = blockIdx.x; F.vcu = (F.G % 8 == 0) ? (bx % 8) * (F.G / 8) + bx / 8 : bx; }
    F.ws = args.ws;
    volatile LAS unsigned* MISC = (volatile LAS unsigned*)(F.lds + MISC_OFF);
    for (int u = F.tid; u < (LDS_BYTES - MISC_OFF) / 4; u += NWAVES * 64) ((LAS unsigned*)(F.lds + MISC_OFF))[u] = 0u;
    __syncthreads();
    unsigned* ctl = (unsigned*)(F.ws + WS_CTL);
    XcdBarrier bar = xcd_barrier_post(ctl + CW_BAR, MISC + 8);
    const int lo = args.ph_lo, hi = args.ph_hi;
#ifndef REPMASK
#define REPMASK 0ull
#endif
#define REP(k) ((((REPMASK) >> (k)) & 1ull) ? 2 : 1)
#ifndef ONLY_MODE
#define ONLY_MODE (-1)
#endif
#ifndef PHMASK
#define PHMASK 0xFFFFFFFFull
#endif
#define IN(k) ((((PHMASK) >> (k)) & 1ull) && lo <= (k) && (k) < hi)
#ifdef DIAG_BARWAIT
    unsigned long long diag_acc = 0ull, diag_t0 = 0ull;
#define GRID_BAR() do { const unsigned long long t0_ = __builtin_amdgcn_s_memrealtime(); xcd_barrier(bar); if (DIAG_BARWAIT == 1) diag_acc += __builtin_amdgcn_s_memrealtime() - t0_; } while (0)
#define DT0(m_) do { if (DIAG_BARWAIT == (m_)) diag_t0 = __builtin_amdgcn_s_memrealtime(); } while (0)
#define DT1(m_) do { if (DIAG_BARWAIT == (m_)) diag_acc += __builtin_amdgcn_s_memrealtime() - diag_t0; } while (0)
#else
#define DT0(m_) do { } while (0)
#define DT1(m_) do { } while (0)
#define GRID_BAR() do { xcd_barrier(bar); if (REP(30) == 2) { xcd_barrier(bar); xcd_barrier(bar); } } while (0)
#endif

#define x_in     (args.in[0])
#define ln_mix   (args.in[1])
#define ln_mlp   (args.in[2])
#define ln_final (args.in[3])
#define e_w_in   (args.in[4])
#define e_g_q    (args.in[5])
#define e_g_kv   (args.in[6])
#define e_w_uq   (args.in[7])
#define e_w_ukv  (args.in[8])
#define e_w_out  (args.in[9])
#define o_w_in   (args.in[10])
#define o_w_out  (args.in[11])
#define mlp_w1   (args.in[12])
#define mlp_w2   (args.in[13])
    float* X = args.out;
    bf16* PROJ = (bf16*)(F.ws + WS_PROJ); bf16* PROJ2 = (bf16*)(F.ws + WS_PROJ2);
    const float* c128 = (const float*)(F.ws + WS_COS128); const float* s128 = (const float*)(F.ws + WS_SIN128);
    const float* c64 = (const float*)(F.ws + WS_COS64); const float* s64 = (const float*)(F.ws + WS_SIN64);

    DT0(8);
#ifdef SPIN_TICKS
    { const unsigned long long t0_ = __builtin_amdgcn_s_memrealtime(); while (__builtin_amdgcn_s_memrealtime() - t0_ < (unsigned long long)(SPIN_TICKS)) __builtin_amdgcn_s_sleep(8); }
#endif
    if (IN(0)) { for (int rep = 0; rep < REP(0); ++rep) {
        int crot = 0;
        convert_weight(F, e_w_in, DM, EVEN_IN, (bf16*)(F.ws + WS_WIN_E), nullptr, 2, &crot);
        convert_weight(F, e_w_uq, 512, 1536, (bf16*)(F.ws + WS_WUQ), e_g_q, 3, &crot);
        convert_weight(F, e_w_ukv, 256, 2048, (bf16*)(F.ws + WS_WUKV), e_g_kv, 0, &crot);
        convert_weight(F, e_w_out, DM, DM, (bf16*)(F.ws + WS_WOUT_E), nullptr, 0, &crot);
        convert_weight(F, o_w_in, DM, ODD_IN, (bf16*)(F.ws + WS_WIN_O), ln_mix + DM, 1, &crot);
        convert_weight(F, o_w_out, DM, DM, (bf16*)(F.ws + WS_WOUT_O), nullptr, 0, &crot);
        { u32x4* z = (u32x4*)((bf16*)(F.ws + WS_WIN_E) + (size_t)5024 * DM); const int n16 = 96 * DM * 2 / 16;
            for (int i = F.vcu * 512 + F.tid; i < n16; i += F.G * 512) z[i] = (u32x4){0u, 0u, 0u, 0u}; }
        rope_tables(F);
        rms_rows(F, x_in, ln_mix, (bf16*)(F.ws + WS_H0)); }
        GRID_BAR();
    }
    if (IN(1)) {
        pg8::Gemm g{(const bf16*)(F.ws + WS_H0), (const bf16*)(F.ws + WS_WIN_E), T, EVEN_INP, DM, DM, DM};
        pg8::StaticOrder S; S.init(T, EVEN_INP, F.G, (int)blockIdx.x);
        pg8::EpiRopeEven E{PROJ, EVEN_INP, c128, s128, c64, s64, (float*)(F.ws + WS_SSQ)};
        for (int rep = 0; rep < REP(1); ++rep) { DT0(2); pg8::gemm_phase(F.lds, g, S, E); DT1(2); }
        GRID_BAR();
    }
    if (IN(3)) {
        DT0(4);
        for (int rep = 0; rep < REP(3); ++rep)
        for (int it = blockIdx.x; it < 256; it += F.G) { const int b = it >> 7, p = it & 127;
            indexer_unit(F, b, 255 - p); indexer_unit(F, b, p); }
        DT1(4);
        GRID_BAR();
    }
    if (IN(4)) {
        { pg8::Gemm g{PROJ + EC_CQ, (const bf16*)(F.ws + WS_WUQ), T, 1536, 512, EVEN_INP, 512};
          pg8::StaticOrder S; S.init(T, 1536, F.G, (int)blockIdx.x);
          pg8::EpiUp<0, 8, 512, true> E{(bf16*)(F.ws + WS_Q), 1536, (const float*)(F.ws + WS_SSQ), c64, s64};
          { DT0(2); pg8::gemm_phase(F.lds, g, S, E); DT1(2); } }
        { pg8::Gemm g{PROJ + EC_CKV, (const bf16*)(F.ws + WS_WUKV), T, 2048, 256, EVEN_INP, 256};
          pg8::StaticOrder S; S.init(T, 2048, F.G, (int)blockIdx.x); S.kvbal = (F.G == 256);
          pg8::EpiUp<8, 4, 256, false> E{(bf16*)(F.ws + WS_KV), 2048, (const float*)(F.ws + WS_SSQ), c64, s64};
          { DT0(2); pg8::gemm_phase(F.lds, g, S, E); DT1(2); } }
        GRID_BAR();
    }
    if (IN(5)) { DT0(3);
        bf16* O = (bf16*)(F.ws + WS_H0);
        for (int it = F.vcu; it < 256; it += F.G) { const int bh = it >> 4, pi = it & 15, b = bh >> 3, h = bh & 7;
            const size_t r0 = (size_t)b * SEQ;
            for (int pass = 0; pass < 2 * REP(20); ++pass) { const int qb = (pass & 1) ? pi : 31 - pi;
                att::UnitArgs U{};
                U.Q = (const bf16*)(F.ws + WS_Q) + r0 * 1536 + h * 192; U.qpitch = 1536;
                U.K = (const bf16*)(F.ws + WS_KV) + r0 * 2048 + h * 256; U.kpitch = 2048;
                U.V = U.K + 128; U.vpitch = 2048;
                U.PE = PROJ + r0 * EVEN_INP + EC_KPE; U.pepitch = EVEN_INP;
                U.O = O + r0 * DM + h * 128; U.opitch = DM;
                U.cosT = c64; U.sinT = s64; U.pos0 = 0; U.posstride = 1; U.P0 = qb * 256;
                if (ONLY_MODE < 0 || ONLY_MODE == 0) att::attn_unit<att::MODE_MLA>((LAS char*)F.lds, U); }
            for (int pass = 0; pass < 2 * REP(21); ++pass) { const int qb = (pass & 1) ? pi : 31 - pi;
                att::UnitArgs U{};
                U.Q = PROJ + r0 * EVEN_INP + EC_Q + h * 128; U.qpitch = EVEN_INP;
                U.K = PROJ + r0 * EVEN_INP + EC_K + h * 128; U.kpitch = EVEN_INP;
                U.V = PROJ + r0 * EVEN_INP + EC_V + h * 128; U.vpitch = EVEN_INP;
                U.O = O + r0 * DM + 1024 + h * 128; U.opitch = DM;
                U.cosT = c128; U.sinT = s128; U.pos0 = 0; U.posstride = 1; U.P0 = qb * 256;
                U.BM = (const unsigned*)(F.ws + WS_BM) + r0 * 256;

#if defined(DIAG_SEG) && DIAG_UNITS == 4
                    U.dacc = &diag_acc;
#endif
                    if (ONLY_MODE < 0 || ONLY_MODE == 1) att::attn_unit<att::MODE_DSA>((LAS char*)F.lds, U); }
        }
        convert_weight_queue(F, mlp_w2 + (size_t)0 * DM * DFF, DFF, DM, (bf16*)(F.ws + WS_W2B), ctl + 7864);
        DT1(3);
        GRID_BAR();
    }
    if (IN(6)) {
        convert_weight(F, mlp_w1 + (size_t)0 * DM * DFF, DM, DFF, (bf16*)(F.ws + WS_W1B), ln_mlp + 0 * DM);
        __syncthreads();
        pg8::Gemm g{(const bf16*)(F.ws + WS_H0), (const bf16*)(F.ws + WS_WOUT_E), T, DM, DM, DM, DM};
        pg8::StaticOrder S; S.init(T, DM, F.G, (int)blockIdx.x);
        pg8::EpiResBf16<true> E{x_in, (bf16*)(F.ws + WS_XB), (float*)(F.ws + WS_SSQ), DM};
        for (int rep = 0; rep < REP(6); ++rep) { DT0(2); pg8::gemm_phase(F.lds, g, S, E); DT1(2); }
        GRID_BAR();
    }
#ifdef DIAG_BARWAIT
#define DIAG_PUBLISH(L_) do { if ((L_) == 1) DT1(8); if ((L_) == 1 && F.tid == 0) __hip_atomic_fetch_add((unsigned long long*)(ctl + 8000), diag_acc, __ATOMIC_RELAXED, __HIP_MEMORY_SCOPE_AGENT); } while (0)
#else
#define DIAG_PUBLISH(L_) do { } while (0)
#endif
#define MLP_PHASES(LAYER) do { \
        if (IN(9)) { \
            pg8::Gemm g{(const bf16*)(F.ws + WS_XB), (const bf16*)(F.ws + WS_W1B), T, DFF, DM, DM, DM}; \
            pg8::StaticOrder S; S.init(T, DFF, F.G, (int)blockIdx.x); \
            pg8::EpiBf16<1, true> E{(bf16*)(F.ws + WS_HID), DFF, (const float*)(F.ws + WS_SSQ)}; \
            for (int rep = 0; rep < REP(9); ++rep) { DT0(2); pg8::gemm_phase(F.lds, g, S, E); DT1(2); } \
            GRID_BAR(); \
        } \
        if (IN(10)) { \
            pg8::Gemm g{(const bf16*)(F.ws + WS_HID), (const bf16*)(F.ws + WS_W2B), T, DM, DFF, DFF, DFF}; \
            pg8::StaticOrder S; S.init(T, DM, F.G, (int)blockIdx.x); \
            pg8::EpiResBf16<false> E{(const bf16*)(F.ws + WS_XB), (bf16*)(F.ws + WS_XB), (float*)(F.ws + WS_SSQ), DM}; \
            { DT0(2); pg8::gemm_phase(F.lds, g, S, E); DT1(2); } \
            DIAG_PUBLISH(LAYER); \
            GRID_BAR(); \
        } \
    } while (0)
    MLP_PHASES(0);
            if (IN(12)) {
                pg8::Gemm g{(const bf16*)(F.ws + WS_XB), (const bf16*)(F.ws + WS_WIN_O), T, ODD_IN, DM, DM, DM};
                pg8::StaticOrder S; S.init(T, ODD_IN, F.G, (int)blockIdx.x);
                pg8::EpiRopeOdd E{PROJ2, ODD_IN, c128, s128, (float*)(F.ws + WS_KM), (const float*)(F.ws + WS_SSQ)};
                for (int rep = 0; rep < REP(12); ++rep) { DT0(2); pg8::gemm_phase(F.lds, g, S, E); DT1(2); }
                GRID_BAR();
            }
            if (IN(14)) { DT0(5);
                bf16* O = (bf16*)(F.ws + WS_H1);
                for (int it = F.vcu; it < 256; it += F.G) { const int bh = it >> 4, pi = it & 15, b = bh >> 3, h = bh & 7;
                    const size_t r0 = (size_t)b * SEQ;
                    for (int pass = 0; pass < 2 * (REP(22) == 2 ? 5 : 1); ++pass) { const int qb = (pass & 1) ? pi : 31 - pi;
                        att::UnitArgs U{};
                        U.Q = PROJ2 + r0 * ODD_IN + OC_QC + h * 128; U.qpitch = ODD_IN;
                        U.K = PROJ2 + r0 * ODD_IN + OC_KC + h * 128; U.kpitch = ODD_IN;
                        U.V = PROJ2 + r0 * ODD_IN + OC_VC + h * 128; U.vpitch = ODD_IN;
                        U.O = O + r0 * DM + h * 128; U.opitch = DM;
                        U.cosT = c128; U.sinT = s128; U.pos0 = 0; U.posstride = 1; U.P0 = qb * 256; U.own = qb;
                        U.KMP = (const float*)(F.ws + WS_KM) + (size_t)bh * 32 * 512;
                        U.LSE = (float*)(F.ws + WS_MLSE) + r0 * 8 + h; U.lse_stride = 8; U.lslot = (size_t)T * 8;
                        U.SEL = (unsigned*)(F.ws + WS_SEL) + (size_t)bh * SEQ; U.CNT = (int*)(F.ws + WS_CNT) + (bh * 32 + qb) * 32;

#if defined(DIAG_SEG) && DIAG_UNITS == 3
                    U.dacc = &diag_acc;
#endif
                    if (ONLY_MODE < 0 || ONLY_MODE == 2) att::attn_unit<att::MODE_MOWN>((LAS char*)F.lds, U); }
                    for (int k6 = 0; k6 < 6 * REP(23); ++k6) { const int k = k6 % 6; const int w = k * 16 + pi, gi = w >> 5, u = w & 31;
                        const int d = gi == 0 ? 1 : (gi == 1 ? 4 : 16);
                        const int r = gi == 0 ? 0 : (gi == 1 ? (u >> 3) : (u >> 1)), qb = gi == 0 ? u : (gi == 1 ? (u & 7) : (u & 1));
                        att::UnitArgs U{};
                        const bf16* base = PROJ2 + (r0 + r) * ODD_IN + h * 128;
                        U.Q = base + OC_QD; U.K = base + OC_KD; U.V = base + OC_VD; U.qpitch = U.kpitch = U.vpitch = (size_t)d * ODD_IN;
                        if (gi == 0) { U.O = O + r0 * DM + 1024 + h * 128; U.opitch = DM; }
                        else { U.O = (bf16*)(F.ws + WS_OG) + ((size_t)(gi - 1) * T + r0 + r) * 1024 + h * 128; U.opitch = (size_t)d * 1024; }
                        U.LSE = (float*)(F.ws + WS_LSE) + ((size_t)gi * T + r0 + r) * 8 + h; U.lse_stride = d * 8;
                        U.cosT = c128; U.sinT = s128; U.pos0 = r; U.posstride = d; U.P0 = qb * 256;

#if defined(DIAG_SEG) && DIAG_UNITS == 2
                    U.dacc = &diag_acc;
#endif
                    if (ONLY_MODE < 0 || ONLY_MODE == 3) att::attn_unit<att::MODE_DIL>((LAS char*)F.lds, U); }
                }
                DT1(5);
                GRID_BAR();
            }
            if (IN(17)) { DT0(7);
                const unsigned* SEL = (const unsigned*)(F.ws + WS_SEL); const int* CNT = (const int*)(F.ws + WS_CNT);
                LAS int* ctab = (LAS int*)(F.lds + 98304);
                LAS unsigned* rinfo = (LAS unsigned*)(F.lds + att::OFF_TL); LAS int* wc = (LAS int*)(F.lds + att::OFF_LB);
                for (int rep = 0; rep < REP(17); ++rep) {
                DT0(21); const int total = moba_chunk_table(F, CNT, ctab); DT1(21);
                for (int id = F.vcu; id < total; id += F.G) {
                    DT0(22);
                    int lo_ = 0, hi_ = 496;
                    while (hi_ - lo_ > 1) { const int mid = (lo_ + hi_) >> 1; if (ctab[mid] <= id) lo_ = mid; else hi_ = mid; }
                    const int li = lo_, c = id - ctab[li], bh = li / 31, j = li - bh * 31, b = bh >> 3, h = bh & 7;
                    const size_t r0 = (size_t)b * SEQ;
                    att::UnitArgs U{};
                    U.Q = PROJ2 + r0 * ODD_IN + OC_QC + h * 128; U.qpitch = ODD_IN;
                    U.K = PROJ2 + r0 * ODD_IN + OC_KC + h * 128; U.kpitch = ODD_IN;
                    U.V = PROJ2 + r0 * ODD_IN + OC_VC + h * 128; U.vpitch = ODD_IN;
                    U.O = (bf16*)(F.ws + WS_MPO) + r0 * 1024 + h * 128; U.opitch = 1024; U.oslot = (size_t)T * 1024;
                    U.LSE = (float*)(F.ws + WS_MLSE) + r0 * 8 + h; U.lse_stride = 8; U.lslot = (size_t)T * 8;
                    U.cosT = c128; U.sinT = s128; U.pos0 = 0; U.posstride = 1; U.P0 = 0; U.own = j;

#if defined(DIAG_SEG) && DIAG_UNITS == 1
                    U.dacc = &diag_acc;
#endif
                    att::attn_preload_msel((LAS char*)F.lds, U);
                    moba_build_list(F, SEL, CNT, bh, j, c, rinfo, wc);
                    DT1(22);
                    att::attn_unit<att::MODE_MSEL>((LAS char*)F.lds, U);
                } }
                dil_combine(F, (bf16*)(F.ws + WS_H1), (const bf16*)(F.ws + WS_OG), ctl + 7800);
                DT1(7);
                GRID_BAR();
            }
            if (IN(15)) { DT0(6); moba_combine(F, (bf16*)(F.ws + WS_H1), (const bf16*)(F.ws + WS_MPO), (const float*)(F.ws + WS_MLSE)); DT1(6); GRID_BAR(); }
            if (IN(16)) {
                convert_weight(F, mlp_w1 + (size_t)1 * DM * DFF, DM, DFF, (bf16*)(F.ws + WS_W1B), ln_mlp + 1 * DM);
                convert_weight(F, mlp_w2 + (size_t)1 * DM * DFF, DFF, DM, (bf16*)(F.ws + WS_W2B));
                __syncthreads();
                pg8::Gemm g{(const bf16*)(F.ws + WS_H1), (const bf16*)(F.ws + WS_WOUT_O), T, DM, DM, DM, DM};
                pg8::StaticOrder S; S.init(T, DM, F.G, (int)blockIdx.x);
                pg8::EpiResBf16<false> E{(const bf16*)(F.ws + WS_XB), (bf16*)(F.ws + WS_XB), (float*)(F.ws + WS_SSQ), DM};
                { DT0(2); pg8::gemm_phase(F.lds, g, S, E); DT1(2); }
                GRID_BAR();
            }
    MLP_PHASES(1);
#undef MLP_PHASES
#ifdef DIAG_BARWAIT
    float diag_scale = 1.f;
    { unsigned long long* dw = (unsigned long long*)(ctl + 8000);
      const unsigned long long tot = __hip_atomic_load(dw, __ATOMIC_RELAXED, __HIP_MEMORY_SCOPE_AGENT);
      const float avg_us = floorf((float)tot * 0.01f / (float)F.G / 8.f) * 8.f; diag_scale = 1.f + sqrtf(avg_us * (DIAG_BARWAIT == 2 ? 2e-7f : (DIAG_BARWAIT == 8 ? 1e-7f : (DIAG_BARWAIT >= 20 ? 4e-6f : 1e-6f)))); }
    if (IN(19)) rms_rows_final(F, (const bf16*)(F.ws + WS_XB), (const float*)(F.ws + WS_SSQ), X, ln_final, diag_scale);
#else
    if (IN(19)) rms_rows_final(F, (const bf16*)(F.ws + WS_XB), (const float*)(F.ws + WS_SSQ), X, ln_final);
#endif
#undef IN
#undef GRID_BAR
#undef x_in
#undef ln_mix
#undef ln_mlp
#undef ln_final
#undef e_w_in
#undef e_g_q
#undef e_g_kv
#undef e_w_uq
#undef e_w_ukv
#undef e_w_out
#undef o_w_in
#undef o_w_out
#undef mlp_w1
#undef mlp_w2
}

extern "C" void kernel_launch(void* const* d_in, const int* in_sizes, int n_in, void* d_out, int out_size, void* d_ws, size_t ws_size, hipStream_t stream) {
    static int grid = 0;
    if (grid == 0) {
        if (n_in != 14 || out_size != T * DM || ws_size < WS_END) { fprintf(stderr, "kernel_launch: unexpected shapes (n_in %d out %d ws %zu)\n", n_in, out_size, ws_size); grid = -1; return; }
        int dev = 0, cus = 0, per_cu = 0;
        if (hipGetDevice(&dev) != hipSuccess || hipDeviceGetAttribute(&cus, hipDeviceAttributeMultiprocessorCount, dev) != hipSuccess) { grid = -1; return; }
        if (hipFuncSetAttribute((const void*)fwd_kernel, hipFuncAttributeMaxDynamicSharedMemorySize, LDS_BYTES) != hipSuccess) { fprintf(stderr, "kernel_launch: hipFuncSetAttribute failed\n"); grid = -1; return; }
        if (hipOccupancyMaxActiveBlocksPerMultiprocessor(&per_cu, (const void*)fwd_kernel, NWAVES * 64, LDS_BYTES) != hipSuccess || per_cu < 1)
            fprintf(stderr, "kernel_launch: occupancy query reports %d\n", per_cu);
        (void)hipGetLastError();
        grid = cus;
    }
    if (grid < 0) return;
    (void)hipMemsetAsync((char*)d_ws + WS_CTL, 0, CTL_ZERO_BYTES, stream);
    Args a{};
    for (int i = 0; i < 14; ++i) a.in[i] = (const float*)d_in[i];
    a.out = (float*)d_out; a.ws = (unsigned char*)d_ws; a.ph_lo = 0; a.ph_hi = 64;
    hipLaunchKernelGGL(fwd_kernel, dim3(grid), dim3(NWAVES * 64), LDS_BYTES, stream, a);
}
```
